# Optimizing an MI355X kernel written in HIP

```python
import jax, jax.numpy as jnp
from jax import lax
import numpy as np

D_MODEL = 1024
BATCH = 2
SEQ = 8192
DEPTH = 1

D_CONV = D_MODEL // 2
CONV_W = 3
D_RWKV = D_MODEL // 2
HEAD_SIZE = 64
N_HEADS = D_RWKV // HEAD_SIZE
DECAY_LORA = 64
ICLR_LORA = 64
GATE_LORA = 128
GN_EPS = 64e-5
D_FF = 2816
RMS_EPS = 1e-6

COLS_A = 3 * D_CONV
COLS_B = 3 * D_RWKV + DECAY_LORA + ICLR_LORA + GATE_LORA
COLS_G = 2 * D_MODEL
COLS_IN = COLS_A + COLS_B + COLS_G
SPLIT_B = [D_RWKV, 2 * D_RWKV, 3 * D_RWKV, 3 * D_RWKV + DECAY_LORA, 3 * D_RWKV + DECAY_LORA + ICLR_LORA]

kernel_name = "hybrid_shortconv_rwkv7_macaron"


def rms_norm(x, g):
    xf = x.astype(jnp.float32)
    y = xf * lax.rsqrt(jnp.mean(xf * xf, axis=-1, keepdims=True) + RMS_EPS)
    return (y * g.astype(jnp.float32)).astype(x.dtype)


def swiglu(x, w_gate, w_up, w_down):
    return (jax.nn.silu(x @ w_gate) * (x @ w_up)) @ w_down


def token_shift(p):
    return jnp.pad(p, ((0, 0), (1, 0), (0, 0)))[:, :-1]


def causal_dwconv(u, w):
    return lax.conv_general_dilated(
        u, w[:, None, :].astype(u.dtype), window_strides=(1,),
        padding=[(CONV_W - 1, 0)], dimension_numbers=("NWC", "WIO", "NWC"),
        feature_group_count=u.shape[-1])


def wkv7_scan(r, w, k, v, a, b):
    bsz, _, h, n = r.shape

    def step(S, inp):
        r_t, w_t, k_t, v_t, a_t, b_t = inp
        sa = jnp.einsum("bhvk,bhk->bhv", S, a_t)
        S = S * w_t[:, :, None, :] + sa[..., None] * b_t[:, :, None, :] + v_t[..., None] * k_t[:, :, None, :]
        y = jnp.einsum("bhvk,bhk->bhv", S, r_t)
        return S, y

    xs = tuple(jnp.moveaxis(t, 1, 0) for t in (r, w, k, v, a, b))
    S0 = jnp.zeros((bsz, h, n, n), jnp.float32)
    _, ys = lax.scan(step, S0, xs)
    return jnp.moveaxis(ys, 0, 1)


def setup_inputs(seed: int = 0) -> dict:
    key = jax.random.key(seed)
    ks = iter(jax.random.split(key, 40))
    f32 = jnp.float32

    def nrm(shape, scale):
        return jax.random.normal(next(ks), shape, f32) * scale

    def gain(shape):
        return 1.0 + 0.01 * jax.random.normal(next(ks), shape, f32)

    L = DEPTH
    return {
        "x": jax.random.normal(next(ks), (BATCH, SEQ, D_MODEL), f32),
        "ffn1_norm": gain((L, D_MODEL)),
        "ffn1_w_gate": nrm((L, D_MODEL, D_FF), D_MODEL ** -0.5),
        "ffn1_w_up": nrm((L, D_MODEL, D_FF), D_MODEL ** -0.5),
        "ffn1_w_down": nrm((L, D_FF, D_MODEL), D_FF ** -0.5),
        "mix_norm": gain((L, D_MODEL)),
        "w_in": nrm((L, D_MODEL, COLS_IN), D_MODEL ** -0.5),
        "conv_w": nrm((L, CONV_W, D_CONV), CONV_W ** -0.5),
        "w_out_a": nrm((L, D_CONV, D_MODEL), D_CONV ** -0.5),
        "mu_b": jax.random.uniform(next(ks), (L, COLS_B), f32),
        "w0": nrm((L, D_RWKV), 0.5) - 0.5,
        "w_decay_up": nrm((L, DECAY_LORA, D_RWKV), 0.5 * DECAY_LORA ** -0.5),
        "a0": nrm((L, D_RWKV), 0.1),
        "w_iclr_up": nrm((L, ICLR_LORA, D_RWKV), ICLR_LORA ** -0.5),
        "w_gate_up": nrm((L, GATE_LORA, D_RWKV), GATE_LORA ** -0.5),
        "k_k": 0.85 + nrm((L, D_RWKV), 0.05),
        "k_a": 1.0 + nrm((L, D_RWKV), 0.05),
        "r_k": nrm((L, N_HEADS, HEAD_SIZE), 0.1),
        "ln_x_w": gain((L, D_RWKV)),
        "ln_x_b": nrm((L, D_RWKV), 0.01),
        "w_out_b": nrm((L, D_RWKV, D_MODEL), D_RWKV ** -0.5),
        "w_o": nrm((L, D_MODEL, D_MODEL), D_MODEL ** -0.5),
        "ffn2_norm": gain((L, D_MODEL)),
        "ffn2_w_gate": nrm((L, D_MODEL, D_FF), D_MODEL ** -0.5),
        "ffn2_w_up": nrm((L, D_MODEL, D_FF), D_MODEL ** -0.5),
        "ffn2_w_down": nrm((L, D_FF, D_MODEL), D_FF ** -0.5),
        "final_norm": gain((D_MODEL,)),
    }


def token_mixer(h, w_in, conv_w, w_out_a, mu_b, w0, w_decay_up, a0, w_iclr_up,
                w_gate_up, k_k, k_a, r_k, ln_x_w, ln_x_b, w_out_b, w_o):
    bsz, t, _ = h.shape
    f32 = jnp.float32
    p = h @ w_in
    pa, pb, pg = jnp.split(p, [COLS_A, COLS_A + COLS_B], axis=-1)

    b_gate, c_gate, u = jnp.split(pa, 3, axis=-1)
    y_a = (b_gate * causal_dwconv(c_gate * u, conv_w)) @ w_out_a

    pb = pb + (token_shift(pb) - pb) * mu_b
    r, k, v, xw, xa, xg = jnp.split(pb, SPLIT_B, axis=-1)
    w_log = -jax.nn.softplus(-(w0 + jnp.tanh(xw) @ w_decay_up)) - 0.5
    decay = jnp.exp(-jnp.exp(w_log.astype(f32)))
    iclr = jax.nn.sigmoid(a0 + xa @ w_iclr_up)
    g = jax.nn.sigmoid(xg) @ w_gate_up

    def heads(z):
        return z.astype(f32).reshape(bsz, t, N_HEADS, HEAD_SIZE)

    kk = heads(k * k_k)
    kk = kk / jnp.maximum(jnp.sqrt(jnp.sum(kk * kk, axis=-1, keepdims=True)), 1e-12)
    k = k * (1.0 + (iclr - 1.0) * k_a)
    rh, kh, vh, ah = heads(r), heads(k), heads(v), heads(iclr)
    y = wkv7_scan(rh, heads(decay), kh, vh, -kk, kk * ah)

    mu = jnp.mean(y, axis=-1, keepdims=True)
    var = jnp.mean(jnp.square(y - mu), axis=-1, keepdims=True)
    y = (y - mu) * lax.rsqrt(var + GN_EPS)
    y = (y * ln_x_w.astype(f32).reshape(N_HEADS, HEAD_SIZE)
         + ln_x_b.astype(f32).reshape(N_HEADS, HEAD_SIZE))
    y = y + jnp.sum(rh * kh * r_k.astype(f32), axis=-1, keepdims=True) * vh
    y = y.reshape(bsz, t, D_RWKV).astype(h.dtype)
    y_b = (y * g) @ w_out_b

    g_a, g_b = jnp.split(pg, 2, axis=-1)
    merged = jax.nn.sigmoid(g_a) * y_a + jax.nn.sigmoid(g_b) * y_b
    return merged @ w_o


def reference(x, ffn1_norm, ffn1_w_gate, ffn1_w_up, ffn1_w_down, mix_norm, w_in,
              conv_w, w_out_a, mu_b, w0, w_decay_up, a0, w_iclr_up, w_gate_up,
              k_k, k_a, r_k, ln_x_w, ln_x_b, w_out_b, w_o, ffn2_norm,
              ffn2_w_gate, ffn2_w_up, ffn2_w_down, final_norm):
    for l in range(DEPTH):
        x = x + 0.5 * swiglu(rms_norm(x, ffn1_norm[l]), ffn1_w_gate[l], ffn1_w_up[l], ffn1_w_down[l])
        x = x + token_mixer(rms_norm(x, mix_norm[l]), w_in[l], conv_w[l], w_out_a[l], mu_b[l],
                            w0[l], w_decay_up[l], a0[l], w_iclr_up[l], w_gate_up[l],
                            k_k[l], k_a[l], r_k[l], ln_x_w[l], ln_x_b[l], w_out_b[l], w_o[l])
        x = x + 0.5 * swiglu(rms_norm(x, ffn2_norm[l]), ffn2_w_gate[l], ffn2_w_up[l], ffn2_w_down[l])
    return rms_norm(x, final_norm)
```

```cpp
#include <hip/hip_runtime.h>
#include <hip/hip_cooperative_groups.h>
#include <cstdio>
#include <cstdint>
namespace cg = cooperative_groups;

#ifndef MK_PER_PHASE
#define MK_PER_PHASE 1
#endif
constexpr int NWAVES = 8;
constexpr int T = 8192, D = 1024, M = 16384, FF = 2816, NPH = 16;
constexpr size_t MiB = 1u << 20;
constexpr size_t WS_W1GU = 1 * MiB, WS_W1D = 12 * MiB, WS_W2GU = 17 * MiB + MiB / 2, WS_W2D = 28 * MiB + MiB / 2, WS_WIN = 34 * MiB, WS_WOA = 44 * MiB + MiB / 2,
                 WS_WOB = 45 * MiB + MiB / 2, WS_WO = 46 * MiB + MiB / 2, WS_WL = 48 * MiB + MiB / 2;
constexpr size_t WS_XB = 50 * MiB, WS_SSQ0 = 82 * MiB, WS_SSQ1 = 83 * MiB, WS_SSQ2 = 84 * MiB, WS_R = 85 * MiB;
constexpr size_t WS_HID = WS_R, WS_PA = WS_R, WS_PB = WS_R + 48 * MiB, WS_ZA = WS_R + 104 * MiB, WS_LIN = WS_R + 120 * MiB, WS_NS = WS_R + 128 * MiB, WS_ZB = WS_R + 144 * MiB;
constexpr size_t WS_LOGW = WS_R, WS_ICLR = WS_R + 16 * MiB, WS_GG = WS_R + 32 * MiB;
constexpr size_t WS_PC = WS_W1GU;
constexpr size_t WS_SG = WS_R, WS_MRG = WS_R + 64 * MiB;
constexpr size_t WS_END = WS_R + 160 * MiB;
static_assert(WS_END <= 256 * MiB, "workspace map");
constexpr int LDS_BYTES = 147456;
constexpr int SCAN_WAVE_FLOATS = 3712;

#define LAS __attribute__((address_space(3)))
typedef unsigned short bf16;
typedef unsigned v4u __attribute__((ext_vector_type(4)));
typedef float f32x4 __attribute__((ext_vector_type(4)));
typedef float f32x16 __attribute__((ext_vector_type(16)));
#define LDS_WAIT() asm volatile("s_waitcnt lgkmcnt(0)" ::: "memory")
__device__ __forceinline__ unsigned f2bf(float f) { unsigned u = __builtin_bit_cast(unsigned, f); return (u + 0x7fffu + ((u >> 16) & 1u)) >> 16; }
__device__ __forceinline__ unsigned pk2(float lo, float hi) { return f2bf(lo) | (f2bf(hi) << 16); }
__device__ __forceinline__ float bf2f(bf16 h) { return __uint_as_float((unsigned)h << 16); }
__device__ __forceinline__ float wave_sum(float v) {
#pragma unroll
    for (int o = 1; o < 64; o <<= 1) v += __shfl_xor(v, o);
    return v;
}
__device__ __forceinline__ float dppf(float x, int ctrl_is_xor2) {
    const int xi = __builtin_bit_cast(int, x);
    const int r = ctrl_is_xor2 ? __builtin_amdgcn_update_dpp(xi, xi, 0x4E, 0xF, 0xF, false) : __builtin_amdgcn_update_dpp(xi, xi, 0xB1, 0xF, 0xF, false);
    return __builtin_bit_cast(float, r);
}
__device__ __forceinline__ float quad_sum(float x) { x += dppf(x, 0); x += dppf(x, 1); return x; }
__device__ __forceinline__ float sigmf(float x) { return __builtin_amdgcn_rcpf(1.0f + __expf(-x)); }
__device__ __forceinline__ float tanhf_(float x) { return 1.0f - 2.0f * __builtin_amdgcn_rcpf(1.0f + __expf(2.0f * x)); }

constexpr int TAB_OFF = 131072 + 1024;
typedef LAS const unsigned long long* tab_t;
__device__ __forceinline__ unsigned long long ldptr_(tab_t tab, int i) {
    const unsigned long long v = tab[i];
    const unsigned lo = __builtin_amdgcn_readfirstlane((unsigned)v), hi = __builtin_amdgcn_readfirstlane((unsigned)(v >> 32));
    return ((unsigned long long)hi << 32) | lo;
}
#define INP(i) ((const float*)ldptr_(tab, (i)))
#define OUTP() ((float*)ldptr_(tab, 27))
#define WSP() ((unsigned char*)ldptr_(tab, 28))
namespace pg8 {
#define PG8_LAS __attribute__((address_space(3)))
typedef unsigned short bf16_t;
typedef short bf16x8 __attribute__((ext_vector_type(8)));
typedef float f32x4 __attribute__((ext_vector_type(4)));
typedef unsigned u32x4 __attribute__((ext_vector_type(4)));
constexpr int BM = 256, BK = 64, HALF = 128, HTB = HALF * BK * 2  , STAGE_BYTES = 8 * HTB, NXCD = 8, WGM = 8;

__host__ __device__ __forceinline__ int lds_byte(int r, int c) { const int st = (r >> 4) * 2 + (c >> 5), rr = r & 15, cc = c & 31, ob = rr * 64 + cc * 2; return st * 1024 + (ob ^ (((ob >> 9) & 1) << 5)); }
__host__ __device__ __forceinline__ void stage_rc(int b, int& R, int& C) { const int st = b / 1024, sb = b % 1024, swz = sb ^ (((sb >> 9) & 1) << 5); R = (st >> 1) * 16 + swz / 64; C = (st & 1) * 32 + (swz % 64) / 2; }
__host__ __device__ __forceinline__ int perm32(int rho) { const int n = rho >> 4, i = rho & 15; return 8 * (i >> 2) + 4 * n + (i & 3); }

struct Unit { int pm, pn; };
struct Gemm { const bf16_t* A; const bf16_t* Bt; int M, N, K; };

struct StaticOrder {
    int nM, nN, nwg, G, c;
    __host__ __device__ void init(int M, int N, int G_, int c_) { nM = M / BM; nN = N / BM; nwg = nM * nN; G = G_; c = c_; }
    __host__ __device__ bool next(int i, Unit& u) const {
        const long L = (long)i * G + c; if (L >= nwg) return false;
        int wgid = (int)L; { const int q = nwg / NXCD, r = nwg % NXCD, xcd = wgid % NXCD, off = wgid / NXCD; wgid = (xcd < r ? xcd * (q + 1) : r * (q + 1) + (xcd - r) * q) + off; }
        const int nig = WGM * nN, gid = wgid / nig, fm = gid * WGM, gsz = (nM - fm) < WGM ? (nM - fm) : WGM;
        u.pm = fm + ((wgid % nig) % gsz); u.pn = (wgid % nig) / gsz; return true;
    }
    __device__ __forceinline__ void a_ready(const Unit&) const {}
    __device__ __forceinline__ void done(const Unit&) const {}
};
__device__ __forceinline__ unsigned cvt_pk_bf16(float lo, float hi) { unsigned r; asm volatile("v_cvt_pk_bf16_f32 %0, %1, %2" : "=v"(r) : "v"(lo), "v"(hi)); return r; }
__device__ __forceinline__ float sigm(float x) { return __builtin_amdgcn_rcpf(1.0f + __expf(-x)); }
__device__ __forceinline__ void store8(bf16_t* p, f32x4 a, f32x4 b) {
    u32x4 w; w.x = cvt_pk_bf16(a[0], a[1]); w.y = cvt_pk_bf16(a[2], a[3]); w.z = cvt_pk_bf16(b[0], b[1]); w.w = cvt_pk_bf16(b[2], b[3]);
    *(u32x4*)p = w;
}
__device__ __forceinline__ void load8(const bf16_t* p, f32x4& a, f32x4& b) {
    const u32x4 w = *(const u32x4*)p;
    a[0] = __uint_as_float(w.x << 16); a[1] = __uint_as_float(w.x & 0xffff0000u); a[2] = __uint_as_float(w.y << 16); a[3] = __uint_as_float(w.y & 0xffff0000u);
    b[0] = __uint_as_float(w.z << 16); b[1] = __uint_as_float(w.z & 0xffff0000u); b[2] = __uint_as_float(w.w << 16); b[3] = __uint_as_float(w.w & 0xffff0000u);
}
enum { EM_SWIGLU = 0, EM_RESID = 1, EM_PAB = 2, EM_LORA = 3, EM_GATES = 4, EM_MERGE1 = 5, EM_MERGE2 = 6 };
struct Epi {
    static constexpr bool PERM = true, AFTER_DRAIN = false;
    int p; tab_t tab;
    __device__ __forceinline__ void operator()(const f32x4 (&acc)[2][2][4][2], const Unit& u, int wr, int wc, int fr, int fq) const {
        unsigned char* ws = WSP();
        const int mode = (p == 1 || p == 13) ? EM_SWIGLU : (p == 2 || p == 12 || p == 14) ? EM_RESID : (p == 3) ? EM_PAB : (p == 5) ? EM_LORA : (p == 9) ? EM_GATES : (p == 10) ? EM_MERGE1 : EM_MERGE2;
        const float* ssq = (const float*)(ws + (p == 1 ? WS_SSQ0 : (p == 13 ? WS_SSQ2 : WS_SSQ1)));
        bf16_t* o0 = nullptr; bf16_t* o1 = nullptr; bf16_t* o2 = nullptr; const float* base = nullptr; float* outf = nullptr; float* ssq_out = nullptr; float scale = 1.f;
        const bf16_t* sg = (const bf16_t*)(ws + WS_SG); const float* q0 = nullptr; const float* q1 = nullptr;
        if (mode == EM_SWIGLU) o0 = (bf16_t*)(ws + WS_HID);
        else if (mode == EM_RESID) { outf = OUTP(); base = (p == 2) ? INP(0) : (const float*)outf; o0 = (p == 14) ? nullptr : (bf16_t*)(ws + WS_XB);
                                     ssq_out = (p == 14) ? nullptr : (float*)(ws + (p == 2 ? WS_SSQ1 : WS_SSQ2)); scale = (p == 12) ? 1.0f : 0.5f; }
        else if (mode == EM_PAB) { o0 = (bf16_t*)(ws + WS_PA); o1 = (bf16_t*)(ws + WS_PB); }
        else if (mode == EM_LORA) { o0 = (bf16_t*)(ws + WS_LOGW); o1 = (bf16_t*)(ws + WS_ICLR); o2 = (bf16_t*)(ws + WS_GG); q0 = INP(10); q1 = INP(12); }
        else if (mode == EM_GATES) o0 = (bf16_t*)(ws + WS_SG);
        else o0 = (bf16_t*)(ws + WS_MRG);
        const int rowb = u.pm * BM + wr * 64 + fr;
        const int cw = wc * 32 + 8 * fq;
#pragma unroll
        for (int ai = 0; ai < 2; ++ai)
#pragma unroll
            for (int m = 0; m < 4; ++m) {
                const size_t row = (size_t)(rowb + ai * HALF + m * 16);
                float s = 1.f;
                if (mode == EM_SWIGLU || mode == EM_PAB || mode == EM_GATES) {
                    const f32x4* q = (const f32x4*)(ssq + row * 16);
                    const f32x4 a = q[0], b = q[1], c = q[2], d = q[3];
                    const f32x4 t = (a + b) + (c + d);
                    s = rsqrtf(((t[0] + t[1]) + (t[2] + t[3])) * (1.0f / 1024.0f) + 1e-6f);
                }
                if (mode == EM_SWIGLU) {
                    f32x4 h0, h1;
#pragma unroll
                    for (int j = 0; j < 4; ++j) {
                        const float g0 = acc[ai][0][m][0][j] * s, u0 = acc[ai][1][m][0][j] * s;
                        const float g1 = acc[ai][0][m][1][j] * s, u1 = acc[ai][1][m][1][j] * s;
                        h0[j] = g0 * sigm(g0) * u0; h1[j] = g1 * sigm(g1) * u1;
                    }
                    store8(o0 + row * 2816 + u.pn * 128 + cw, h0, h1);
                } else if (mode == EM_RESID) {
                    float part = 0.f;
#pragma unroll
                    for (int bj = 0; bj < 2; ++bj) {
                        const size_t off = row * 1024 + u.pn * 256 + bj * HALF + cw;
                        const f32x4 b0 = *(const f32x4*)(base + off), b1 = *(const f32x4*)(base + off + 4);
                        const f32x4 v0 = b0 + acc[ai][bj][m][0] * scale, v1 = b1 + acc[ai][bj][m][1] * scale;
                        *(f32x4*)(outf + off) = v0; *(f32x4*)(outf + off + 4) = v1;
                        if (o0) store8(o0 + off, v0, v1);
                        part += (v0[0] * v0[0] + v0[1] * v0[1]) + (v0[2] * v0[2] + v0[3] * v0[3]) + (v1[0] * v1[0] + v1[1] * v1[1]) + (v1[2] * v1[2] + v1[3] * v1[3]);
                    }
                    if (ssq_out) { part += __shfl_xor(part, 16); part += __shfl_xor(part, 32); if (fq == 0) ssq_out[row * 16 + u.pn * 4 + wc] = part; }
                } else {
#pragma unroll
                    for (int bj = 0; bj < 2; ++bj) {
                        const int col = u.pn * 256 + bj * HALF + cw;
                        f32x4 v0 = acc[ai][bj][m][0], v1 = acc[ai][bj][m][1];
                        if (mode == EM_PAB) {
                            v0 = v0 * s; v1 = v1 * s;
                            if (u.pn < 6) store8(o0 + row * 1536 + col, v0, v1); else store8(o1 + row * 1792 + (col - 1536), v0, v1);
                        } else if (mode == EM_LORA) {
                            const int sel = u.pn >> 1, c = col & 511;
                            if (sel == 0) {
                                const f32x4 p0 = *(const f32x4*)(q0 + c), p1 = *(const f32x4*)(q0 + c + 4);
#pragma unroll
                                for (int j = 0; j < 4; ++j) { v0[j] = -0.6065306597f * sigm(p0[j] + v0[j]); v1[j] = -0.6065306597f * sigm(p1[j] + v1[j]); }
                                store8(o0 + row * 512 + c, v0, v1);
                            } else if (sel == 1) {
                                const f32x4 p0 = *(const f32x4*)(q1 + c), p1 = *(const f32x4*)(q1 + c + 4);
#pragma unroll
                                for (int j = 0; j < 4; ++j) { v0[j] = sigm(p0[j] + v0[j]); v1[j] = sigm(p1[j] + v1[j]); }
                                store8(o1 + row * 512 + c, v0, v1);
                            } else store8(o2 + row * 512 + c, v0, v1);
                        } else if (mode == EM_GATES) {
#pragma unroll
                            for (int j = 0; j < 4; ++j) { v0[j] = sigm(v0[j] * s); v1[j] = sigm(v1[j] * s); }
                            store8(o0 + row * 2048 + col, v0, v1);
                        } else if (mode == EM_MERGE1) {
                            f32x4 g0, g1; load8(sg + row * 2048 + col, g0, g1);
                            store8(o0 + row * 1024 + col, g0 * v0, g1 * v1);
                        } else {
                            f32x4 g0, g1, m0, m1; load8(sg + row * 2048 + 1024 + col, g0, g1); load8(o0 + row * 1024 + col, m0, m1);
                            store8(o0 + row * 1024 + col, m0 + g0 * v0, m1 + g1 * v1);
                        }
                    }
                }
            }
    }
};

template <class Epi, class Sched, bool ALIGN_EPI = false, bool SP2 = false>
__device__ __forceinline__ void gemm_phase(PG8_LAS unsigned char* lds, const Gemm g, const Sched& S, const Epi& E) {
    const int tid = threadIdx.x, wid = __builtin_amdgcn_readfirstlane(tid >> 6), lane = tid & 63, wr = wid >> 2, wc = wid & 3, fr = lane & 15, fq = lane >> 4;
    const int K = g.K, nt = K / BK;
    unsigned voffA[2], voffB[2];
#pragma unroll
    for (int i = 0; i < 2; ++i) { int R, C; stage_rc(tid * 16 + i * 8192, R, C); const int Rb = Epi::PERM ? ((R & ~31) + perm32(R & 31)) : R;
        voffA[i] = (unsigned)(R * K + C) * 2u; voffB[i] = (unsigned)(Rb * K + C) * 2u; }
    const size_t kstep = (size_t)(BK * 2);
    const size_t hstep = (size_t)HALF * K * 2;
    const size_t tstep = 2 * hstep;
    const unsigned ldsw = (unsigned)wid * 1024u;
    const int aoff = lds_byte(wr * 64 + fr, fq * 8), boff = lds_byte(wc * 32 + fr, fq * 8);
#define PG8_SA(b, h) (((b) * 2 + (h)) * HTB)
#define PG8_SB(b, h) ((4 + (b) * 2 + (h)) * HTB)
#define PG8_STAGE(bufoff, gbase, voff) do { _Pragma("unroll") for (int _i = 0; _i < 2; ++_i) \
        __builtin_amdgcn_global_load_lds((const unsigned*)((const char*)(gbase) + (voff)[_i]), (PG8_LAS unsigned*)(lds + (bufoff) + ldsw + _i * 8192), 16, 0, 0); } while (0)
#define PG8_LDA(dst, b, h) do { _Pragma("unroll") for (int m = 0; m < 4; ++m) _Pragma("unroll") for (int k = 0; k < 2; ++k) dst[m][k] = *(const PG8_LAS bf16x8*)(lds + PG8_SA(b, h) + aoff + m * 2048 + k * 1024); } while (0)
#define PG8_LDB(dst, b, h) do { _Pragma("unroll") for (int n = 0; n < 2; ++n) _Pragma("unroll") for (int k = 0; k < 2; ++k) dst[n][k] = *(const PG8_LAS bf16x8*)(lds + PG8_SB(b, h) + boff + n * 2048 + k * 1024); } while (0)
#define PG8_MMA(ai, bj, At, Bt) do { __builtin_amdgcn_s_setprio(1); _Pragma("unroll") for (int m = 0; m < 4; ++m) _Pragma("unroll") for (int n = 0; n < 2; ++n) _Pragma("unroll") for (int k = 0; k < 2; ++k) \
        acc[ai][bj][m][n] = __builtin_amdgcn_mfma_f32_16x16x32_bf16(Bt[n][k], At[m][k], acc[ai][bj][m][n], 0, 0, 0); __builtin_amdgcn_s_setprio(0); } while (0)
#define PG8_WAIT_V(n) asm volatile("s_waitcnt vmcnt(" #n ")" ::: "memory")
#define PG8_WAIT_L(n) asm volatile("s_waitcnt lgkmcnt(" #n ")" ::: "memory")
#define PG8_BAR __builtin_amdgcn_s_barrier()
#define PG8_SCHED __builtin_amdgcn_sched_barrier(0)
    Unit cur, nxt; int ui = 0;
    if (!S.next(0, cur)) return;
    f32x4 acc[2][2][4][2];
#pragma unroll
    for (int a = 0; a < 2; ++a)
#pragma unroll
        for (int b = 0; b < 2; ++b)
#pragma unroll
            for (int m = 0; m < 4; ++m)
#pragma unroll
                for (int n = 0; n < 2; ++n) acc[a][b][m][n] = (f32x4){0.f, 0.f, 0.f, 0.f};
    bf16x8 At[4][2], B0[2][2], B1[2][2];
    const char* cA = (const char*)g.A + (size_t)cur.pm * tstep; const char* cB = (const char*)g.Bt + (size_t)cur.pn * tstep;
    S.a_ready(cur);
    if constexpr (SP2) {
        PG8_STAGE(PG8_SB(0, 0), cB, voffB); PG8_STAGE(PG8_SB(0, 1), cB + hstep, voffB); PG8_STAGE(PG8_SA(0, 0), cA, voffA); PG8_STAGE(PG8_SA(0, 1), cA + hstep, voffA);
        if (wr == 1) PG8_BAR;
        PG8_WAIT_V(2); PG8_BAR;
        PG8_STAGE(PG8_SB(1, 0), cB + kstep, voffB); PG8_STAGE(PG8_SA(1, 0), cA + kstep, voffA); PG8_STAGE(PG8_SB(1, 1), cB + hstep + kstep, voffB);
        PG8_WAIT_V(6); PG8_BAR;
    } else {
        PG8_STAGE(PG8_SB(0, 0), cB, voffB); PG8_STAGE(PG8_SA(0, 0), cA, voffA); PG8_STAGE(PG8_SB(0, 1), cB + hstep, voffB); PG8_STAGE(PG8_SA(0, 1), cA + hstep, voffA);
        if (wr == 1) PG8_BAR;
        PG8_WAIT_V(4); PG8_BAR;
        PG8_STAGE(PG8_SB(1, 0), cB + kstep, voffB); PG8_STAGE(PG8_SA(1, 0), cA + kstep, voffA); PG8_STAGE(PG8_SB(1, 1), cB + hstep + kstep, voffB);
        PG8_WAIT_V(6); PG8_BAR;
    }
    for (;;) {
        const bool has_next = S.next(ui + 1, nxt);
        const char* nA = has_next ? (const char*)g.A + (size_t)nxt.pm * tstep : cA; const char* nB = has_next ? (const char*)g.Bt + (size_t)nxt.pn * tstep : cB;
        for (int t = 0; t < nt; t += 2) {
            const bool last = (t == nt - 2);
            const char* a1 = cA + (size_t)(t + 1) * kstep;
            const char* a2 = last ? nA : cA + (size_t)(t + 2) * kstep; const char* b2 = last ? nB : cB + (size_t)(t + 2) * kstep;
            const char* a3 = a2 + kstep; const char* b3 = b2 + kstep;
            if (last && has_next) S.a_ready(nxt);
            if constexpr (SP2) {
            PG8_LDB(B0, 0, 0); PG8_LDB(B1, 0, 1); PG8_SCHED; PG8_LDA(At, 0, 0); PG8_STAGE(PG8_SA(1, 1), a1 + hstep, voffA);
            PG8_WAIT_V(8); PG8_WAIT_L(0); PG8_BAR; PG8_MMA(0, 0, At, B0); PG8_MMA(0, 1, At, B1); PG8_BAR; PG8_SCHED;
            PG8_LDA(At, 0, 1); PG8_STAGE(PG8_SB(0, 0), b2, voffB); PG8_STAGE(PG8_SB(0, 1), b2 + hstep, voffB); PG8_STAGE(PG8_SA(0, 0), a2, voffA);
            PG8_WAIT_V(8); PG8_WAIT_L(0); PG8_BAR; PG8_MMA(1, 0, At, B0); PG8_MMA(1, 1, At, B1); PG8_BAR; PG8_SCHED;
            PG8_LDB(B0, 1, 0); PG8_LDB(B1, 1, 1); PG8_SCHED; PG8_LDA(At, 1, 0); PG8_STAGE(PG8_SA(0, 1), a2 + hstep, voffA);
            PG8_WAIT_V(8); PG8_WAIT_L(0); PG8_BAR; PG8_MMA(0, 0, At, B0); PG8_MMA(0, 1, At, B1); PG8_BAR; PG8_SCHED;
            PG8_LDA(At, 1, 1); PG8_STAGE(PG8_SB(1, 0), b3, voffB); PG8_STAGE(PG8_SB(1, 1), b3 + hstep, voffB); PG8_STAGE(PG8_SA(1, 0), a3, voffA);
            PG8_WAIT_V(8); PG8_WAIT_L(0); PG8_BAR; PG8_MMA(1, 0, At, B0); PG8_MMA(1, 1, At, B1); PG8_BAR; PG8_SCHED;
            } else {
            PG8_LDB(B0, 0, 0); PG8_SCHED; PG8_LDA(At, 0, 0); PG8_STAGE(PG8_SA(1, 1), a1 + hstep, voffA);
            PG8_WAIT_L(8); PG8_BAR; PG8_WAIT_L(0); PG8_MMA(0, 0, At, B0); PG8_BAR; PG8_SCHED;
            PG8_LDB(B1, 0, 1); PG8_STAGE(PG8_SB(0, 0), b2, voffB);
            PG8_BAR; PG8_WAIT_L(0); PG8_MMA(0, 1, At, B1); PG8_BAR;
            PG8_LDA(At, 0, 1); PG8_STAGE(PG8_SA(0, 0), a2, voffA);
            PG8_BAR; PG8_WAIT_L(0); PG8_MMA(1, 0, At, B0); PG8_BAR; PG8_SCHED;
            PG8_STAGE(PG8_SB(0, 1), b2 + hstep, voffB);
            PG8_WAIT_V(6); PG8_BAR; PG8_MMA(1, 1, At, B1); PG8_BAR;
            PG8_LDB(B0, 1, 0); PG8_SCHED; PG8_LDA(At, 1, 0); PG8_STAGE(PG8_SA(0, 1), a2 + hstep, voffA);
            PG8_WAIT_L(8); PG8_BAR; PG8_WAIT_L(0); PG8_MMA(0, 0, At, B0); PG8_BAR; PG8_SCHED;
            PG8_LDB(B1, 1, 1); PG8_STAGE(PG8_SB(1, 0), b3, voffB);
            PG8_BAR; PG8_WAIT_L(0); PG8_MMA(0, 1, At, B1); PG8_BAR;
            PG8_LDA(At, 1, 1); PG8_STAGE(PG8_SA(1, 0), a3, voffA);
            PG8_BAR; PG8_WAIT_L(0); PG8_MMA(1, 0, At, B0); PG8_BAR; PG8_SCHED;
            PG8_STAGE(PG8_SB(1, 1), b3 + hstep, voffB);
            PG8_WAIT_V(6); PG8_BAR; PG8_MMA(1, 1, At, B1); PG8_BAR;
            }
        }
        if constexpr (ALIGN_EPI) { if (wr == 0) PG8_BAR; }
        if constexpr (!Epi::AFTER_DRAIN) { E(acc, cur, wr, wc, fr, fq); S.done(cur); }
        if (!has_next) break;
#pragma unroll
        for (int a = 0; a < 2; ++a)
#pragma unroll
            for (int b = 0; b < 2; ++b)
#pragma unroll
                for (int m = 0; m < 4; ++m)
#pragma unroll
                    for (int n = 0; n < 2; ++n) acc[a][b][m][n] = (f32x4){0.f, 0.f, 0.f, 0.f};
        cur = nxt; cA = nA; cB = nB; ++ui;
        if constexpr (ALIGN_EPI) { if (wr == 1) PG8_BAR; }
    }
    PG8_WAIT_V(0);
    if constexpr (!ALIGN_EPI) { if (wr == 0) PG8_BAR; }
    PG8_BAR;
    if constexpr (Epi::AFTER_DRAIN) { E.fused(acc, cur, wr, wc, fr, fq, lds, wid, lane); S.done(cur); }
#undef PG8_SA
#undef PG8_SB
#undef PG8_STAGE
#undef PG8_LDA
#undef PG8_LDB
#undef PG8_MMA
#undef PG8_WAIT_V
#undef PG8_WAIT_L
#undef PG8_BAR
#undef PG8_SCHED
}
}
struct Args { const float* in[27]; float* out; unsigned char* ws; int ph_lo, ph_hi; };

__device__ __forceinline__ void transpose_item(const float* W, int K, int N, bf16* WT, const float* gain, int il, LAS float* scr, int item, int lane) {
    const int nblk = N / 32, kb = item / nblk, nb = item % nblk, k0 = 64 * kb, n0 = 32 * nb;
#pragma unroll 8
    for (int i = 0; i < 32; ++i) { const int kk = 2 * i + (lane >> 5); float v = W[(size_t)(k0 + kk) * N + n0 + (lane & 31)]; if (gain) v *= gain[k0 + kk]; scr[kk * 33 + (lane & 31)] = v; }
    LDS_WAIT(); asm volatile("" ::: "memory");
    const int drow0 = il ? (((n0 >> 7) << 8) + (n0 & 127) + (il == 2 ? 128 : 0)) : n0;
    const int c = lane & 7;
#pragma unroll
    for (int j = 0; j < 4; ++j) { const int n = (lane >> 3) + 8 * j; const LAS float* s = scr + (8 * c) * 33 + n;
        v4u o; o.x = pk2(s[0 * 33], s[1 * 33]); o.y = pk2(s[2 * 33], s[3 * 33]); o.z = pk2(s[4 * 33], s[5 * 33]); o.w = pk2(s[6 * 33], s[7 * 33]);
        *(v4u*)(WT + (size_t)(drow0 + n) * K + k0 + 8 * c) = o; }
    LDS_WAIT(); asm volatile("" ::: "memory");
}
__device__ __forceinline__ void phase_prologue(tab_t tab, LAS unsigned char* lds, int tid, int lane, int wave) {
    asm volatile("" : "+v"(lane), "+v"(tid));
    unsigned char* ws = WSP();
    LAS float* scr = (LAS float*)(lds + wave * 16384);
    const int G = gridDim.x, gw = blockIdx.x * NWAVES + wave, NGW = G * NWAVES;
    constexpr int I_GU = (D / 64) * (FF / 32), I_DN = (FF / 64) * (D / 32), I_IN = (D / 64) * (5376 / 32), I_OA = (512 / 64) * (D / 32), I_O = (D / 64) * (D / 32);
    constexpr int NITEMS = 4 * I_GU + 2 * I_DN + I_IN + 2 * I_OA + I_O;
    for (int it = gw; it < NITEMS; it += NGW) {
        int r = it;
        if (r < I_GU) { transpose_item(INP(2), D, FF, (bf16*)(ws + WS_W1GU), INP(1), 1, scr, r, lane); continue; } r -= I_GU;
        if (r < I_GU) { transpose_item(INP(3), D, FF, (bf16*)(ws + WS_W1GU), INP(1), 2, scr, r, lane); continue; } r -= I_GU;
        if (r < I_DN) { transpose_item(INP(4), FF, D, (bf16*)(ws + WS_W1D), nullptr, 0, scr, r, lane); continue; } r -= I_DN;
        if (r < I_GU) { transpose_item(INP(23), D, FF, (bf16*)(ws + WS_W2GU), INP(22), 1, scr, r, lane); continue; } r -= I_GU;
        if (r < I_GU) { transpose_item(INP(24), D, FF, (bf16*)(ws + WS_W2GU), INP(22), 2, scr, r, lane); continue; } r -= I_GU;
        if (r < I_DN) { transpose_item(INP(25), FF, D, (bf16*)(ws + WS_W2D), nullptr, 0, scr, r, lane); continue; } r -= I_DN;
        if (r < I_IN) { transpose_item(INP(6), D, 5376, (bf16*)(ws + WS_WIN), INP(5), 0, scr, r, lane); continue; } r -= I_IN;
        if (r < I_OA) { transpose_item(INP(8), 512, D, (bf16*)(ws + WS_WOA), nullptr, 0, scr, r, lane); continue; } r -= I_OA;
        if (r < I_OA) { transpose_item(INP(20), 512, D, (bf16*)(ws + WS_WOB), nullptr, 0, scr, r, lane); continue; } r -= I_OA;
        transpose_item(INP(21), D, D, (bf16*)(ws + WS_WO), nullptr, 0, scr, r, lane);
    }
    { bf16* WL = (bf16*)(ws + WS_WL); const float* wdu = INP(11); const float* wiu = INP(13); const float* wgu = INP(14);
      for (int idx = blockIdx.x * 512 + tid; idx < 1536 * 256; idx += G * 512) {
          const int n = idx >> 8, kc = idx & 255; float v = 0.f;
          if (n < 512) { if (kc < 64) v = wdu[kc * 512 + n]; }
          else if (n < 1024) { if (kc >= 64 && kc < 128) v = wiu[(kc - 64) * 512 + (n - 512)]; }
          else { if (kc >= 128) v = wgu[(kc - 128) * 512 + (n - 1024)]; }
          WL[idx] = (bf16)f2bf(v); } }
    { const float* x = INP(0); bf16* xb = (bf16*)(ws + WS_XB); float* ssq0 = (float*)(ws + WS_SSQ0);
      for (int m = gw; m < M; m += NGW) {
          const f32x4* xr = (const f32x4*)(x + (size_t)m * D) + lane; f32x4 v[4]; float s = 0.f;
#pragma unroll
          for (int j = 0; j < 4; ++j) { v[j] = xr[64 * j]; s += (v[j][0] * v[j][0] + v[j][1] * v[j][1]) + (v[j][2] * v[j][2] + v[j][3] * v[j][3]); }
          s = wave_sum(s);
          unsigned long long* o8 = (unsigned long long*)(xb + (size_t)m * D) + lane;
#pragma unroll
          for (int j = 0; j < 4; ++j) o8[64 * j] = (unsigned long long)pk2(v[j][0], v[j][1]) | ((unsigned long long)pk2(v[j][2], v[j][3]) << 32);
          if (lane < 16) ssq0[(size_t)m * 16 + lane] = (lane == 0) ? s : 0.f;
      } }
}

__device__ __forceinline__ void ld8(const bf16* p, float (&v)[8]) {
    const v4u w = *(const v4u*)p;
    v[0] = __uint_as_float(w.x << 16); v[1] = __uint_as_float(w.x & 0xffff0000u); v[2] = __uint_as_float(w.y << 16); v[3] = __uint_as_float(w.y & 0xffff0000u);
    v[4] = __uint_as_float(w.z << 16); v[5] = __uint_as_float(w.z & 0xffff0000u); v[6] = __uint_as_float(w.w << 16); v[7] = __uint_as_float(w.w & 0xffff0000u);
}
__device__ __forceinline__ void st8(bf16* p, const float (&v)[8]) {
    v4u w; w.x = pk2(v[0], v[1]); w.y = pk2(v[2], v[3]); w.z = pk2(v[4], v[5]); w.w = pk2(v[6], v[7]); *(v4u*)p = w;
}
__device__ __forceinline__ void phase_prep(tab_t tab, int tid) {
    asm volatile("" : "+v"(tid));
    unsigned char* ws = WSP();
    const bf16* PA = (const bf16*)(ws + WS_PA); const bf16* PB = (const bf16*)(ws + WS_PB);
    bf16* ZA = (bf16*)(ws + WS_ZA); bf16* LIN = (bf16*)(ws + WS_LIN);
    const float* cw = INP(7); const float* mu = INP(9);
    const int gt = blockIdx.x * 512 + tid, NT = gridDim.x * 512;
    for (int it = gt; it < M * 64; it += NT) {
        const int m = it >> 6, c0 = (it & 63) * 8, t = m & (T - 1);
        float bb[8], c_[8], u_[8], acc[8], w0[8], w1[8], w2[8];
#pragma unroll
        for (int j = 0; j < 8; ++j) { w0[j] = cw[c0 + j]; w1[j] = cw[512 + c0 + j]; w2[j] = cw[1024 + c0 + j]; }
        const bf16* row = PA + (size_t)m * 1536;
        ld8(row + c0, bb); ld8(row + 512 + c0, c_); ld8(row + 1024 + c0, u_);
#pragma unroll
        for (int j = 0; j < 8; ++j) acc[j] = w2[j] * (c_[j] * u_[j]);
        if (t >= 1) { ld8(row - 1536 + 512 + c0, c_); ld8(row - 1536 + 1024 + c0, u_);
#pragma unroll
            for (int j = 0; j < 8; ++j) acc[j] += w1[j] * (c_[j] * u_[j]); }
        if (t >= 2) { ld8(row - 3072 + 512 + c0, c_); ld8(row - 3072 + 1024 + c0, u_);
#pragma unroll
            for (int j = 0; j < 8; ++j) acc[j] += w0[j] * (c_[j] * u_[j]); }
#pragma unroll
        for (int j = 0; j < 8; ++j) acc[j] *= bb[j];
        st8(ZA + (size_t)m * 512 + c0, acc);
    }
    for (int it = gt; it < M * 32; it += NT) {
        const int m = it >> 5, c0 = (it & 31) * 8, t = m & (T - 1);
        float x[8], xp[8];
        const bf16* row = PB + (size_t)m * 1792 + 1536 + c0;
        ld8(row, x);
        if (t >= 1) ld8(row - 1792, xp); else {
#pragma unroll
            for (int j = 0; j < 8; ++j) xp[j] = 0.f; }
#pragma unroll
        for (int j = 0; j < 8; ++j) { float v = x[j] + (xp[j] - x[j]) * mu[1536 + c0 + j]; x[j] = (c0 < 64) ? tanhf_(v) : ((c0 < 128) ? v : sigmf(v)); }
        st8(LIN + (size_t)m * 256 + c0, x);
    }
}

struct ScanCtx {
    const bf16* PB; const bf16* LOGW; const bf16* ICLR; const bf16* GG; bf16* ZB; float* PC; float* NS;
    const float* mu; const float* k_k; const float* k_a; const float* r_k; const float* lnw; const float* lnb;
};
template <int MODE>
__device__ __forceinline__ void scan_task(const ScanCtx& X, int cid, LAS float* wl, int lane) {
    asm volatile("" : "+v"(lane));
    const int bh = cid >> 6, c = cid & 63, b = bh >> 3, h = bh & 7;
    const int m0 = b * T + c * 128;
    const int rg = lane >> 2, ks = lane & 3;
    const int hc = h * 64 + lane;
    float S[4][16];
#pragma unroll
    for (int i = 0; i < 4; ++i)
#pragma unroll
        for (int e = 0; e < 16; ++e) S[i][e] = (MODE == 0 && (rg * 4 + i) == (ks * 16 + e)) ? 1.f : 0.f;
    if (MODE == 2 && c > 0) {
        const float* src = X.NS + (size_t)(cid - 1) * 4096;
#pragma unroll
        for (int i = 0; i < 4; ++i)
#pragma unroll
            for (int q = 0; q < 4; ++q) { const f32x4 v = *(const f32x4*)(src + (rg * 4 + i) * 64 + ks * 16 + q * 4); S[i][4 * q] = v[0]; S[i][4 * q + 1] = v[1]; S[i][4 * q + 2] = v[2]; S[i][4 * q + 3] = v[3]; }
    }
    const float mu_r = X.mu[hc], mu_k = X.mu[512 + hc], mu_v = X.mu[1024 + hc];
    const float kk_c = X.k_k[hc], ka_c = X.k_a[hc], rk_c = X.r_k[hc], lnw = X.lnw[hc], lnb = X.lnb[hc];
    LAS float* LA = wl; LAS float* LW = wl + 512; LAS float* LB = wl + 1024; LAS float* LK = wl + 1536; LAS float* LR = wl + 2048; LAS float* LV = wl + 2560; LAS float* LY = wl + 3072; LAS float* LBon = wl + 3584;
    for (int sub = 0; sub < 16; ++sub) {
        const int mb = m0 + sub * 8;
#pragma unroll 4
        for (int s = 0; s < 8; ++s) {
            const int m = mb + s; const bool first = ((m & (T - 1)) == 0);
            const bf16* row = X.PB + (size_t)m * 1792;
            const float rc = bf2f(row[hc]), kc = bf2f(row[512 + hc]), vc = bf2f(row[1024 + hc]);
            float rp = 0.f, kp = 0.f, vp = 0.f;
            if (!first) { rp = bf2f(row[hc - 1792]); kp = bf2f(row[512 + hc - 1792]); vp = bf2f(row[1024 + hc - 1792]); }
            const float r = rc + (rp - rc) * mu_r, k = kc + (kp - kc) * mu_k, v = vc + (vp - vc) * mu_v;
            const float lw = bf2f(X.LOGW[(size_t)m * 512 + hc]), ic = bf2f(X.ICLR[(size_t)m * 512 + hc]);
            float kk = k * kk_c; const float n2 = wave_sum(kk * kk); kk = kk / fmaxf(sqrtf(n2), 1e-12f);
            const float k2 = k * (1.0f + (ic - 1.0f) * ka_c);
            LA[s * 64 + lane] = -kk; LW[s * 64 + lane] = __expf(lw); LB[s * 64 + lane] = kk * ic;
            if (MODE >= 1) { LK[s * 64 + lane] = k2; LV[s * 64 + lane] = v; }
            if (MODE == 2) { LR[s * 64 + lane] = r; const float bon = wave_sum(r * k2 * rk_c); if (lane == 0) LBon[s] = bon; }
        }
        LDS_WAIT(); __builtin_amdgcn_wave_barrier(); asm volatile("" ::: "memory");
        for (int s = 0; s < 8; ++s) {
            f32x4 a4[4], w4[4], b4[4], k4[4], r4[4]; f32x4 vv = (f32x4){0.f, 0.f, 0.f, 0.f};
#pragma unroll
            for (int q = 0; q < 4; ++q) { a4[q] = *(const LAS f32x4*)(LA + s * 64 + ks * 16 + 4 * q); w4[q] = *(const LAS f32x4*)(LW + s * 64 + ks * 16 + 4 * q); b4[q] = *(const LAS f32x4*)(LB + s * 64 + ks * 16 + 4 * q); }
            if (MODE >= 1) {
#pragma unroll
                for (int q = 0; q < 4; ++q) k4[q] = *(const LAS f32x4*)(LK + s * 64 + ks * 16 + 4 * q);
                vv = *(const LAS f32x4*)(LV + s * 64 + rg * 4);
            }
            if (MODE == 2) {
#pragma unroll
                for (int q = 0; q < 4; ++q) r4[q] = *(const LAS f32x4*)(LR + s * 64 + ks * 16 + 4 * q);
            }
            float sa[4];
#pragma unroll
            for (int i = 0; i < 4; ++i) {
                float p[4];
#pragma unroll
                for (int q = 0; q < 4; ++q) p[q] = (S[i][4 * q] * a4[q][0] + S[i][4 * q + 1] * a4[q][1]) + (S[i][4 * q + 2] * a4[q][2] + S[i][4 * q + 3] * a4[q][3]);
                sa[i] = quad_sum((p[0] + p[1]) + (p[2] + p[3]));
            }
#pragma unroll
            for (int i = 0; i < 4; ++i)
#pragma unroll
                for (int q = 0; q < 4; ++q)
#pragma unroll
                    for (int j = 0; j < 4; ++j) {
                        float t = S[i][4 * q + j] * w4[q][j] + sa[i] * b4[q][j];
                        if (MODE >= 1) t += vv[i] * k4[q][j];
                        S[i][4 * q + j] = t;
                    }
            if (MODE == 2) {
                f32x4 y;
#pragma unroll
                for (int i = 0; i < 4; ++i) {
                    float p[4];
#pragma unroll
                    for (int q = 0; q < 4; ++q) p[q] = (S[i][4 * q] * r4[q][0] + S[i][4 * q + 1] * r4[q][1]) + (S[i][4 * q + 2] * r4[q][2] + S[i][4 * q + 3] * r4[q][3]);
                    y[i] = quad_sum((p[0] + p[1]) + (p[2] + p[3]));
                }
                if (ks == 0) *(LAS f32x4*)(LY + s * 64 + rg * 4) = y;
            }
        }
        if (MODE == 2) {
            LDS_WAIT(); __builtin_amdgcn_wave_barrier(); asm volatile("" ::: "memory");
#pragma unroll 4
            for (int s = 0; s < 8; ++s) {
                const int m = mb + s;
                const float y = LY[s * 64 + lane];
                const float mean = wave_sum(y) * (1.0f / 64.0f); const float d = y - mean; const float var = wave_sum(d * d) * (1.0f / 64.0f);
                float yn = d * rsqrtf(var + 64e-5f) * lnw + lnb;
                yn += LBon[s] * LV[s * 64 + lane];
                const float g = bf2f(X.GG[(size_t)m * 512 + hc]);
                X.ZB[(size_t)m * 512 + hc] = (bf16)f2bf(yn * g);
            }
        }
        LDS_WAIT(); __builtin_amdgcn_wave_barrier(); asm volatile("" ::: "memory");
    }
    if (MODE <= 1) {
        float* dst = (MODE == 0 ? X.PC : X.NS) + (size_t)cid * 4096;
#pragma unroll
        for (int i = 0; i < 4; ++i)
#pragma unroll
            for (int q = 0; q < 4; ++q) *(f32x4*)(dst + (rg * 4 + i) * 64 + ks * 16 + q * 4) = (f32x4){S[i][4 * q], S[i][4 * q + 1], S[i][4 * q + 2], S[i][4 * q + 3]};
    }
}
__device__ __forceinline__ void scan_pass_b(const ScanCtx& X, LAS unsigned char* lds, int bh, int tid, int lane, int wave) {
    asm volatile("" : "+v"(lane), "+v"(tid));
    LAS float* Ss = (LAS float*)lds;
    for (int i = tid; i < 64 * 65; i += 512) Ss[i] = 0.f;
    __syncthreads();
    const int bi = (wave >> 1) & 1, bj = wave & 1, l32 = lane & 31, lh = lane >> 5;
    for (int c = 0; c < 63; ++c) {
        const float* P = X.PC + (size_t)(bh * 64 + c) * 4096; float* N = X.NS + (size_t)(bh * 64 + c) * 4096;
        f32x16 acc;
        if (wave < 4) {
#pragma unroll
            for (int r = 0; r < 16; ++r) acc[r] = N[(32 * bi + 8 * (r >> 2) + 4 * lh + (r & 3)) * 64 + 32 * bj + l32];
#pragma unroll 8
            for (int kk = 0; kk < 32; ++kk) {
                const float av = Ss[(32 * bi + l32) * 65 + 2 * kk + lh];
                const float bv = P[(2 * kk + lh) * 64 + 32 * bj + l32];
                acc = __builtin_amdgcn_mfma_f32_32x32x2f32(av, bv, acc, 0, 0, 0);
            }
        }
        __syncthreads();
        if (wave < 4) {
#pragma unroll
            for (int r = 0; r < 16; ++r) { const int row = 32 * bi + 8 * (r >> 2) + 4 * lh + (r & 3), col = 32 * bj + l32; Ss[row * 65 + col] = acc[r]; N[row * 64 + col] = acc[r]; }
        }
        __syncthreads();
    }
}

__device__ __forceinline__ void phase_final(tab_t tab, int lane, int wave) {
    asm volatile("" : "+v"(lane));
    float* out = OUTP(); const float* g = INP(26);
    const int gw = blockIdx.x * NWAVES + wave, NGW = gridDim.x * NWAVES;
    f32x4 gv[4];
#pragma unroll
    for (int j = 0; j < 4; ++j) gv[j] = ((const f32x4*)g)[lane + 64 * j];
    for (int m = gw; m < M; m += NGW) {
        f32x4* xr = (f32x4*)(out + (size_t)m * D) + lane; f32x4 v[4]; float s = 0.f;
#pragma unroll
        for (int j = 0; j < 4; ++j) { v[j] = xr[64 * j]; s += (v[j][0] * v[j][0] + v[j][1] * v[j][1]) + (v[j][2] * v[j][2] + v[j][3] * v[j][3]); }
        const float rs = rsqrtf(wave_sum(s) * (1.0f / D) + 1e-6f);
#pragma unroll
        for (int j = 0; j < 4; ++j) xr[64 * j] = v[j] * rs * gv[j];
    }
}

__device__ __forceinline__ ScanCtx make_scan_ctx(tab_t tab) {
    unsigned char* ws = WSP();
    ScanCtx X; X.PB = (const bf16*)(ws + WS_PB); X.LOGW = (const bf16*)(ws + WS_LOGW); X.ICLR = (const bf16*)(ws + WS_ICLR); X.GG = (const bf16*)(ws + WS_GG); X.ZB = (bf16*)(ws + WS_ZB);
    X.PC = (float*)(ws + WS_PC); X.NS = (float*)(ws + WS_NS); X.mu = INP(9); X.k_k = INP(15); X.k_a = INP(16); X.r_k = INP(17); X.lnw = INP(18); X.lnb = INP(19);
    return X;
}
__global__ void __launch_bounds__(NWAVES * 64, 2) fwd(Args a) {
    extern __shared__ __attribute__((aligned(16))) unsigned char lds_raw[];
    LAS unsigned char* lds = (LAS unsigned char*)lds_raw;
    const int tid = threadIdx.x, lane = tid & 63, wave = __builtin_amdgcn_readfirstlane(tid >> 6);
    const int G = gridDim.x;
    { LAS unsigned long long* tw = (LAS unsigned long long*)(lds + TAB_OFF);
      if (tid == 0) {
#pragma unroll
          for (int i = 0; i < 27; ++i) tw[i] = (unsigned long long)a.in[i];
          tw[27] = (unsigned long long)a.out; tw[28] = (unsigned long long)a.ws; }
      __syncthreads(); }
    const tab_t tab = (tab_t)(lds + TAB_OFF);
    const int ph_lo = a.ph_lo, ph_hi = a.ph_hi;

    for (int p = ph_lo; p < ph_hi; ++p) {
        pg8::Gemm g{nullptr, nullptr, M, 0, 0}; bool isg = false;
        switch (p) {
        case 0: phase_prologue(tab, lds, tid, lane, wave); break;
        case 4: phase_prep(tab, tid); break;
        case 6: { const ScanCtx X = make_scan_ctx(tab); LAS float* wl = (LAS float*)lds + wave * SCAN_WAVE_FLOATS;
                  for (int task = wave * G + (int)blockIdx.x; task < 2048; task += NWAVES * G) { if (task < 1024) scan_task<0>(X, task, wl, lane); else scan_task<1>(X, task - 1024, wl, lane); } } break;
        case 7: if (blockIdx.x < 16) { const ScanCtx X = make_scan_ctx(tab); scan_pass_b(X, lds, (int)blockIdx.x, tid, lane, wave); } break;
        case 8: { const ScanCtx X = make_scan_ctx(tab); LAS float* wl = (LAS float*)lds + wave * SCAN_WAVE_FLOATS;
                  for (int task = wave * G + (int)blockIdx.x; task < 1024; task += NWAVES * G) scan_task<2>(X, task, wl, lane); } break;
        case 15: phase_final(tab, lane, wave); break;
        default: {
            unsigned char* ws = WSP(); isg = true;
            const size_t aoff = (p == 2 || p == 14) ? WS_HID : (p == 5) ? WS_LIN : (p == 10) ? WS_ZA : (p == 11) ? WS_ZB : (p == 12) ? WS_MRG : WS_XB;
            const size_t boff = (p == 1) ? WS_W1GU : (p == 2) ? WS_W1D : (p == 3) ? WS_WIN : (p == 5) ? WS_WL : (p == 9) ? (WS_WIN + (size_t)3328 * D * 2) : (p == 10) ? WS_WOA : (p == 11) ? WS_WOB : (p == 12) ? WS_WO : (p == 13) ? WS_W2GU : WS_W2D;
            const int N = (p == 1 || p == 13) ? 2 * FF : (p == 3) ? 3328 : (p == 5) ? 1536 : (p == 9) ? 2048 : D;
            const int K = (p == 2 || p == 14) ? FF : (p == 5) ? 256 : (p == 10 || p == 11) ? 512 : D;
            g = pg8::Gemm{(const bf16*)(ws + aoff), (const bf16*)(ws + boff), M, N, K}; } break;
        }
        if (isg) { pg8::Epi E{p, tab}; pg8::StaticOrder S; S.init(M, g.N, G, (int)blockIdx.x); pg8::gemm_phase<pg8::Epi, pg8::StaticOrder, true, true>(lds, g, S, E); }
        if (p + 1 < ph_hi) { __syncthreads(); cg::this_grid().sync(); }
    }
}

extern "C" void kernel_launch(void* const* d_in, const int* in_sizes, int n_in, void* d_out, int out_size, void* d_ws, size_t ws_size, hipStream_t stream) {
    static int grid = 0;
    if (grid == 0) {
        if (n_in != 27 || in_sizes[0] != M * D || out_size != M * D || ws_size < WS_END) { fprintf(stderr, "kernel_launch: unexpected shapes (n_in %d, in0 %d, out %d, ws %zu)\n", n_in, n_in > 0 ? in_sizes[0] : -1, out_size, ws_size); grid = -1; return; }
        int dev = 0, cus = 0, per_cu = 0;
        if (hipGetDevice(&dev) != hipSuccess || hipDeviceGetAttribute(&cus, hipDeviceAttributeMultiprocessorCount, dev) != hipSuccess) { grid = -1; return; }
        if (hipFuncSetAttribute((const void*)fwd, hipFuncAttributeMaxDynamicSharedMemorySize, LDS_BYTES) != hipSuccess) { fprintf(stderr, "kernel_launch: hipFuncSetAttribute failed\n"); grid = -1; return; }
        if (hipOccupancyMaxActiveBlocksPerMultiprocessor(&per_cu, (const void*)fwd, NWAVES * 64, LDS_BYTES) != hipSuccess || per_cu < 1) { fprintf(stderr, "kernel_launch: occupancy query says %d blocks per CU\n", per_cu); per_cu = 1; }
        (void)hipGetLastError();
        grid = cus * 1;
    }
    if (grid < 0) return;
    Args a{};
    for (int i = 0; i < 27; ++i) a.in[i] = (const float*)d_in[i];
    a.out = (float*)d_out; a.ws = (unsigned char*)d_ws;
#if MK_PER_PHASE
    for (int p = 0; p < NPH; ++p) { a.ph_lo = p; a.ph_hi = p + 1; hipLaunchKernelGGL(fwd, dim3(grid), dim3(NWAVES * 64), LDS_BYTES, stream, a); }
#else
    a.ph_lo = 0; a.ph_hi = NPH;
    void* args[] = {&a};
    hipError_t e = hipLaunchCooperativeKernel((const void*)fwd, dim3(grid), dim3(NWAVES * 64), args, LDS_BYTES, stream);
    if (e != hipSuccess) fprintf(stderr, "kernel_launch: cooperative launch failed: %s (grid %d)\n", hipGetErrorString(e), grid);
#endif
}
```

```cpp
#include <hip/hip_runtime.h>
#include <hip/hip_cooperative_groups.h>
#include <cstdio>
#include <cstdint>
namespace cg = cooperative_groups;

#ifndef MK_PER_PHASE
#define MK_PER_PHASE 0
#endif
constexpr int NWAVES = 8;
constexpr int T = 8192, D = 1024, M = 16384, FF = 2816, NPH = 16;
constexpr size_t MiB = 1u << 20;
constexpr size_t WS_W1GU = 1 * MiB, WS_W1D = 12 * MiB, WS_W2GU = 17 * MiB + MiB / 2, WS_W2D = 28 * MiB + MiB / 2, WS_WIN = 34 * MiB, WS_WOA = 44 * MiB + MiB / 2,
                 WS_WOB = 45 * MiB + MiB / 2, WS_WO = 46 * MiB + MiB / 2, WS_WL = 48 * MiB + MiB / 2;
constexpr size_t WS_XB = 50 * MiB, WS_SSQ0 = 82 * MiB, WS_SSQ1 = 83 * MiB, WS_SSQ2 = 84 * MiB, WS_R = 85 * MiB;
constexpr size_t WS_HID = WS_R, WS_PA = WS_R, WS_PB = WS_R + 48 * MiB, WS_ZA = WS_R + 104 * MiB, WS_LIN = WS_R + 120 * MiB, WS_NS = WS_R + 128 * MiB, WS_ZB = WS_R + 144 * MiB;
constexpr size_t WS_LOGW = WS_R, WS_ICLR = WS_R + 16 * MiB, WS_GG = WS_R + 32 * MiB;
constexpr size_t WS_PC = WS_W1GU;
constexpr size_t WS_SG = WS_R, WS_MRG = WS_R + 64 * MiB;
constexpr size_t WS_END = WS_R + 160 * MiB;
static_assert(WS_END <= 256 * MiB, "workspace map");
constexpr int LDS_BYTES = 147456;
constexpr int SCAN_WAVE_FLOATS = 3712;

#define LAS __attribute__((address_space(3)))
typedef unsigned short bf16;
typedef unsigned v4u __attribute__((ext_vector_type(4)));
typedef float f32x4 __attribute__((ext_vector_type(4)));
typedef float f32x16 __attribute__((ext_vector_type(16)));
#define LDS_WAIT() asm volatile("s_waitcnt lgkmcnt(0)" ::: "memory")
__device__ __forceinline__ unsigned f2bf(float f) { unsigned u = __builtin_bit_cast(unsigned, f); return (u + 0x7fffu + ((u >> 16) & 1u)) >> 16; }
__device__ __forceinline__ unsigned pk2(float lo, float hi) { return f2bf(lo) | (f2bf(hi) << 16); }
__device__ __forceinline__ float bf2f(bf16 h) { return __uint_as_float((unsigned)h << 16); }
__device__ __forceinline__ float wave_sum(float v) {
#pragma unroll
    for (int o = 1; o < 64; o <<= 1) v += __shfl_xor(v, o);
    return v;
}
__device__ __forceinline__ float dppf(float x, int ctrl_is_xor2) {
    const int xi = __builtin_bit_cast(int, x);
    const int r = ctrl_is_xor2 ? __builtin_amdgcn_update_dpp(xi, xi, 0x4E, 0xF, 0xF, false) : __builtin_amdgcn_update_dpp(xi, xi, 0xB1, 0xF, 0xF, false);
    return __builtin_bit_cast(float, r);
}
__device__ __forceinline__ float quad_sum(float x) { x += dppf(x, 0); x += dppf(x, 1); return x; }
__device__ __forceinline__ float sigmf(float x) { return __builtin_amdgcn_rcpf(1.0f + __expf(-x)); }
__device__ __forceinline__ float tanhf_(float x) { return 1.0f - 2.0f * __builtin_amdgcn_rcpf(1.0f + __expf(2.0f * x)); }

constexpr int TAB_OFF = 131072 + 1024;
typedef LAS const unsigned long long* tab_t;
__device__ __forceinline__ unsigned long long ldptr_(tab_t tab, int i) {
    const unsigned long long v = tab[i];
    const unsigned lo = __builtin_amdgcn_readfirstlane((unsigned)v), hi = __builtin_amdgcn_readfirstlane((unsigned)(v >> 32));
    return ((unsigned long long)hi << 32) | lo;
}
#define INP(i) ((const float*)ldptr_(tab, (i)))
#define OUTP() ((float*)ldptr_(tab, 27))
#define WSP() ((unsigned char*)ldptr_(tab, 28))
namespace pg8 {
#define PG8_LAS __attribute__((address_space(3)))
typedef unsigned short bf16_t;
typedef short bf16x8 __attribute__((ext_vector_type(8)));
typedef float f32x4 __attribute__((ext_vector_type(4)));
typedef unsigned u32x4 __attribute__((ext_vector_type(4)));
constexpr int BM = 256, BK = 64, HALF = 128, HTB = HALF * BK * 2  , STAGE_BYTES = 8 * HTB, NXCD = 8, WGM = 8;

__host__ __device__ __forceinline__ int lds_byte(int r, int c) { const int st = (r >> 4) * 2 + (c >> 5), rr = r & 15, cc = c & 31, ob = rr * 64 + cc * 2; return st * 1024 + (ob ^ (((ob >> 9) & 1) << 5)); }
__host__ __device__ __forceinline__ void stage_rc(int b, int& R, int& C) { const int st = b / 1024, sb = b % 1024, swz = sb ^ (((sb >> 9) & 1) << 5); R = (st >> 1) * 16 + swz / 64; C = (st & 1) * 32 + (swz % 64) / 2; }
__host__ __device__ __forceinline__ int perm32(int rho) { const int n = rho >> 4, i = rho & 15; return 8 * (i >> 2) + 4 * n + (i & 3); }

struct Unit { int pm, pn; };
struct Gemm { const bf16_t* A; const bf16_t* Bt; int M, N, K; };

struct StaticOrder {
    int nM, nN, nwg, G, c;
    __host__ __device__ void init(int M, int N, int G_, int c_) { nM = M / BM; nN = N / BM; nwg = nM * nN; G = G_; c = c_; }
    __host__ __device__ bool next(int i, Unit& u) const {
        const long L = (long)i * G + c; if (L >= nwg) return false;
        int wgid = (int)L; { const int q = nwg / NXCD, r = nwg % NXCD, xcd = wgid % NXCD, off = wgid / NXCD; wgid = (xcd < r ? xcd * (q + 1) : r * (q + 1) + (xcd - r) * q) + off; }
        const int nig = WGM * nN, gid = wgid / nig, fm = gid * WGM, gsz = (nM - fm) < WGM ? (nM - fm) : WGM;
        u.pm = fm + ((wgid % nig) % gsz); u.pn = (wgid % nig) / gsz; return true;
    }
    __device__ __forceinline__ void a_ready(const Unit&) const {}
    __device__ __forceinline__ void done(const Unit&) const {}
};
__device__ __forceinline__ unsigned cvt_pk_bf16(float lo, float hi) { unsigned r; asm volatile("v_cvt_pk_bf16_f32 %0, %1, %2" : "=v"(r) : "v"(lo), "v"(hi)); return r; }
__device__ __forceinline__ float sigm(float x) { return __builtin_amdgcn_rcpf(1.0f + __expf(-x)); }
__device__ __forceinline__ void store8(bf16_t* p, f32x4 a, f32x4 b) {
    u32x4 w; w.x = cvt_pk_bf16(a[0], a[1]); w.y = cvt_pk_bf16(a[2], a[3]); w.z = cvt_pk_bf16(b[0], b[1]); w.w = cvt_pk_bf16(b[2], b[3]);
    *(u32x4*)p = w;
}
__device__ __forceinline__ void load8(const bf16_t* p, f32x4& a, f32x4& b) {
    const u32x4 w = *(const u32x4*)p;
    a[0] = __uint_as_float(w.x << 16); a[1] = __uint_as_float(w.x & 0xffff0000u); a[2] = __uint_as_float(w.y << 16); a[3] = __uint_as_float(w.y & 0xffff0000u);
    b[0] = __uint_as_float(w.z << 16); b[1] = __uint_as_float(w.z & 0xffff0000u); b[2] = __uint_as_float(w.w << 16); b[3] = __uint_as_float(w.w & 0xffff0000u);
}
enum { EM_SWIGLU = 0, EM_RESID = 1, EM_PAB = 2, EM_LORA = 3, EM_GATES = 4, EM_MERGE1 = 5, EM_MERGE2 = 6 };
struct Epi {
    static constexpr bool PERM = true, AFTER_DRAIN = false;
    int p; tab_t tab;
    __device__ __forceinline__ void operator()(const f32x4 (&acc)[2][2][4][2], const Unit& u, int wr, int wc, int fr, int fq) const {
        unsigned char* ws = WSP();
        const int mode = (p == 1 || p == 13) ? EM_SWIGLU : (p == 2 || p == 12 || p == 14) ? EM_RESID : (p == 3) ? EM_PAB : (p == 5) ? EM_LORA : (p == 9) ? EM_GATES : (p == 10) ? EM_MERGE1 : EM_MERGE2;
        const float* ssq = (const float*)(ws + (p == 1 ? WS_SSQ0 : (p == 13 ? WS_SSQ2 : WS_SSQ1)));
        bf16_t* o0 = nullptr; bf16_t* o1 = nullptr; bf16_t* o2 = nullptr; const float* base = nullptr; float* outf = nullptr; float* ssq_out = nullptr; float scale = 1.f;
        const bf16_t* sg = (const bf16_t*)(ws + WS_SG); const float* q0 = nullptr; const float* q1 = nullptr;
        if (mode == EM_SWIGLU) o0 = (bf16_t*)(ws + WS_HID);
        else if (mode == EM_RESID) { outf = OUTP(); base = (p == 2) ? INP(0) : (const float*)outf; o0 = (p == 14) ? nullptr : (bf16_t*)(ws + WS_XB);
                                     ssq_out = (p == 14) ? nullptr : (float*)(ws + (p == 2 ? WS_SSQ1 : WS_SSQ2)); scale = (p == 12) ? 1.0f : 0.5f; }
        else if (mode == EM_PAB) { o0 = (bf16_t*)(ws + WS_PA); o1 = (bf16_t*)(ws + WS_PB); }
        else if (mode == EM_LORA) { o0 = (bf16_t*)(ws + WS_LOGW); o1 = (bf16_t*)(ws + WS_ICLR); o2 = (bf16_t*)(ws + WS_GG); q0 = INP(10); q1 = INP(12); }
        else if (mode == EM_GATES) o0 = (bf16_t*)(ws + WS_SG);
        else o0 = (bf16_t*)(ws + WS_MRG);
        const int rowb = u.pm * BM + wr * 64 + fr;
        const int cw = wc * 32 + 8 * fq;
#pragma unroll
        for (int ai = 0; ai < 2; ++ai)
#pragma unroll
            for (int m = 0; m < 4; ++m) {
                const size_t row = (size_t)(rowb + ai * HALF + m * 16);
                float s = 1.f;
                if (mode == EM_SWIGLU || mode == EM_PAB || mode == EM_GATES) {
                    const f32x4* q = (const f32x4*)(ssq + row * 16);
                    const f32x4 a = q[0], b = q[1], c = q[2], d = q[3];
                    const f32x4 t = (a + b) + (c + d);
                    s = rsqrtf(((t[0] + t[1]) + (t[2] + t[3])) * (1.0f / 1024.0f) + 1e-6f);
                }
                if (mode == EM_SWIGLU) {
                    f32x4 h0, h1;
#pragma unroll
                    for (int j = 0; j < 4; ++j) {
                        const float g0 = acc[ai][0][m][0][j] * s, u0 = acc[ai][1][m][0][j] * s;
                        const float g1 = acc[ai][0][m][1][j] * s, u1 = acc[ai][1][m][1][j] * s;
                        h0[j] = g0 * sigm(g0) * u0; h1[j] = g1 * sigm(g1) * u1;
                    }
                    store8(o0 + row * 2816 + u.pn * 128 + cw, h0, h1);
                } else if (mode == EM_RESID) {
                    float part = 0.f;
#pragma unroll
                    for (int bj = 0; bj < 2; ++bj) {
                        const size_t off = row * 1024 + u.pn * 256 + bj * HALF + cw;
                        const f32x4 b0 = *(const f32x4*)(base + off), b1 = *(const f32x4*)(base + off + 4);
                        const f32x4 v0 = b0 + acc[ai][bj][m][0] * scale, v1 = b1 + acc[ai][bj][m][1] * scale;
                        *(f32x4*)(outf + off) = v0; *(f32x4*)(outf + off + 4) = v1;
                        if (o0) store8(o0 + off, v0, v1);
                        part += (v0[0] * v0[0] + v0[1] * v0[1]) + (v0[2] * v0[2] + v0[3] * v0[3]) + (v1[0] * v1[0] + v1[1] * v1[1]) + (v1[2] * v1[2] + v1[3] * v1[3]);
                    }
                    if (ssq_out) { part += __shfl_xor(part, 16); part += __shfl_xor(part, 32); if (fq == 0) ssq_out[row * 16 + u.pn * 4 + wc] = part; }
                } else {
#pragma unroll
                    for (int bj = 0; bj < 2; ++bj) {
                        const int col = u.pn * 256 + bj * HALF + cw;
                        f32x4 v0 = acc[ai][bj][m][0], v1 = acc[ai][bj][m][1];
                        if (mode == EM_PAB) {
                            v0 = v0 * s; v1 = v1 * s;
                            if (u.pn < 6) store8(o0 + row * 1536 + col, v0, v1); else store8(o1 + row * 1792 + (col - 1536), v0, v1);
                        } else if (mode == EM_LORA) {
                            const int sel = u.pn >> 1, c = col & 511;
                            if (sel == 0) {
                                const f32x4 p0 = *(const f32x4*)(q0 + c), p1 = *(const f32x4*)(q0 + c + 4);
#pragma unroll
                                for (int j = 0; j < 4; ++j) { v0[j] = -0.6065306597f * sigm(p0[j] + v0[j]); v1[j] = -0.6065306597f * sigm(p1[j] + v1[j]); }
                                store8(o0 + row * 512 + c, v0, v1);
                            } else if (sel == 1) {
                                const f32x4 p0 = *(const f32x4*)(q1 + c), p1 = *(const f32x4*)(q1 + c + 4);
#pragma unroll
                                for (int j = 0; j < 4; ++j) { v0[j] = sigm(p0[j] + v0[j]); v1[j] = sigm(p1[j] + v1[j]); }
                                store8(o1 + row * 512 + c, v0, v1);
                            } else store8(o2 + row * 512 + c, v0, v1);
                        } else if (mode == EM_GATES) {
#pragma unroll
                            for (int j = 0; j < 4; ++j) { v0[j] = sigm(v0[j] * s); v1[j] = sigm(v1[j] * s); }
                            store8(o0 + row * 2048 + col, v0, v1);
                        } else if (mode == EM_MERGE1) {
                            f32x4 g0, g1; load8(sg + row * 2048 + col, g0, g1);
                            store8(o0 + row * 1024 + col, g0 * v0, g1 * v1);
                        } else {
                            f32x4 g0, g1, m0, m1; load8(sg + row * 2048 + 1024 + col, g0, g1); load8(o0 + row * 1024 + col, m0, m1);
                            store8(o0 + row * 1024 + col, m0 + g0 * v0, m1 + g1 * v1);
                        }
                    }
                }
            }
    }
};

template <class Epi, class Sched, bool ALIGN_EPI = false, bool SP2 = false>
__device__ __forceinline__ void gemm_phase(PG8_LAS unsigned char* lds, const Gemm g, const Sched& S, const Epi& E) {
    const int tid = threadIdx.x, wid = __builtin_amdgcn_readfirstlane(tid >> 6), lane = tid & 63, wr = wid >> 2, wc = wid & 3, fr = lane & 15, fq = lane >> 4;
    const int K = g.K, nt = K / BK;
    unsigned voffA[2], voffB[2];
#pragma unroll
    for (int i = 0; i < 2; ++i) { int R, C; stage_rc(tid * 16 + i * 8192, R, C); const int Rb = Epi::PERM ? ((R & ~31) + perm32(R & 31)) : R;
        voffA[i] = (unsigned)(R * K + C) * 2u; voffB[i] = (unsigned)(Rb * K + C) * 2u; }
    const size_t kstep = (size_t)(BK * 2);
    const size_t hstep = (size_t)HALF * K * 2;
    const size_t tstep = 2 * hstep;
    const unsigned ldsw = (unsigned)wid * 1024u;
    const int aoff = lds_byte(wr * 64 + fr, fq * 8), boff = lds_byte(wc * 32 + fr, fq * 8);
#define PG8_SA(b, h) (((b) * 2 + (h)) * HTB)
#define PG8_SB(b, h) ((4 + (b) * 2 + (h)) * HTB)
#define PG8_STAGE(bufoff, gbase, voff) do { _Pragma("unroll") for (int _i = 0; _i < 2; ++_i) \
        __builtin_amdgcn_global_load_lds((const unsigned*)((const char*)(gbase) + (voff)[_i]), (PG8_LAS unsigned*)(lds + (bufoff) + ldsw + _i * 8192), 16, 0, 0); } while (0)
#define PG8_LDA(dst, b, h) do { _Pragma("unroll") for (int m = 0; m < 4; ++m) _Pragma("unroll") for (int k = 0; k < 2; ++k) dst[m][k] = *(const PG8_LAS bf16x8*)(lds + PG8_SA(b, h) + aoff + m * 2048 + k * 1024); } while (0)
#define PG8_LDB(dst, b, h) do { _Pragma("unroll") for (int n = 0; n < 2; ++n) _Pragma("unroll") for (int k = 0; k < 2; ++k) dst[n][k] = *(const PG8_LAS bf16x8*)(lds + PG8_SB(b, h) + boff + n * 2048 + k * 1024); } while (0)
#define PG8_MMA(ai, bj, At, Bt) do { __builtin_amdgcn_s_setprio(1); _Pragma("unroll") for (int m = 0; m < 4; ++m) _Pragma("unroll") for (int n = 0; n < 2; ++n) _Pragma("unroll") for (int k = 0; k < 2; ++k) \
        acc[ai][bj][m][n] = __builtin_amdgcn_mfma_f32_16x16x32_bf16(Bt[n][k], At[m][k], acc[ai][bj][m][n], 0, 0, 0); __builtin_amdgcn_s_setprio(0); } while (0)
#define PG8_WAIT_V(n) asm volatile("s_waitcnt vmcnt(" #n ")" ::: "memory")
#define PG8_WAIT_L(n) asm volatile("s_waitcnt lgkmcnt(" #n ")" ::: "memory")
#define PG8_BAR __builtin_amdgcn_s_barrier()
#define PG8_SCHED __builtin_amdgcn_sched_barrier(0)
    Unit cur, nxt; int ui = 0;
    if (!S.next(0, cur)) return;
    f32x4 acc[2][2][4][2];
#pragma unroll
    for (int a = 0; a < 2; ++a)
#pragma unroll
        for (int b = 0; b < 2; ++b)
#pragma unroll
            for (int m = 0; m < 4; ++m)
#pragma unroll
                for (int n = 0; n < 2; ++n) acc[a][b][m][n] = (f32x4){0.f, 0.f, 0.f, 0.f};
    bf16x8 At[4][2], B0[2][2], B1[2][2];
    const char* cA = (const char*)g.A + (size_t)cur.pm * tstep; const char* cB = (const char*)g.Bt + (size_t)cur.pn * tstep;
    S.a_ready(cur);
    if constexpr (SP2) {
        PG8_STAGE(PG8_SB(0, 0), cB, voffB); PG8_STAGE(PG8_SB(0, 1), cB + hstep, voffB); PG8_STAGE(PG8_SA(0, 0), cA, voffA); PG8_STAGE(PG8_SA(0, 1), cA + hstep, voffA);
        if (wr == 1) PG8_BAR;
        PG8_WAIT_V(2); PG8_BAR;
        PG8_STAGE(PG8_SB(1, 0), cB + kstep, voffB); PG8_STAGE(PG8_SA(1, 0), cA + kstep, voffA); PG8_STAGE(PG8_SB(1, 1), cB + hstep + kstep, voffB);
        PG8_WAIT_V(6); PG8_BAR;
    } else {
        PG8_STAGE(PG8_SB(0, 0), cB, voffB); PG8_STAGE(PG8_SA(0, 0), cA, voffA); PG8_STAGE(PG8_SB(0, 1), cB + hstep, voffB); PG8_STAGE(PG8_SA(0, 1), cA + hstep, voffA);
        if (wr == 1) PG8_BAR;
        PG8_WAIT_V(4); PG8_BAR;
        PG8_STAGE(PG8_SB(1, 0), cB + kstep, voffB); PG8_STAGE(PG8_SA(1, 0), cA + kstep, voffA); PG8_STAGE(PG8_SB(1, 1), cB + hstep + kstep, voffB);
        PG8_WAIT_V(6); PG8_BAR;
    }
    for (;;) {
        const bool has_next = S.next(ui + 1, nxt);
        const char* nA = has_next ? (const char*)g.A + (size_t)nxt.pm * tstep : cA; const char* nB = has_next ? (const char*)g.Bt + (size_t)nxt.pn * tstep : cB;
        for (int t = 0; t < nt; t += 2) {
            const bool last = (t == nt - 2);
            const char* a1 = cA + (size_t)(t + 1) * kstep;
            const char* a2 = last ? nA : cA + (size_t)(t + 2) * kstep; const char* b2 = last ? nB : cB + (size_t)(t + 2) * kstep;
            const char* a3 = a2 + kstep; const char* b3 = b2 + kstep;
            if (last && has_next) S.a_ready(nxt);
            if constexpr (SP2) {
            PG8_LDB(B0, 0, 0); PG8_LDB(B1, 0, 1); PG8_SCHED; PG8_LDA(At, 0, 0); PG8_STAGE(PG8_SA(1, 1), a1 + hstep, voffA);
            PG8_WAIT_V(8); PG8_WAIT_L(0); PG8_BAR; PG8_MMA(0, 0, At, B0); PG8_MMA(0, 1, At, B1); PG8_BAR; PG8_SCHED;
            PG8_LDA(At, 0, 1); PG8_STAGE(PG8_SB(0, 0), b2, voffB); PG8_STAGE(PG8_SB(0, 1), b2 + hstep, voffB); PG8_STAGE(PG8_SA(0, 0), a2, voffA);
            PG8_WAIT_V(8); PG8_WAIT_L(0); PG8_BAR; PG8_MMA(1, 0, At, B0); PG8_MMA(1, 1, At, B1); PG8_BAR; PG8_SCHED;
            PG8_LDB(B0, 1, 0); PG8_LDB(B1, 1, 1); PG8_SCHED; PG8_LDA(At, 1, 0); PG8_STAGE(PG8_SA(0, 1), a2 + hstep, voffA);
            PG8_WAIT_V(8); PG8_WAIT_L(0); PG8_BAR; PG8_MMA(0, 0, At, B0); PG8_MMA(0, 1, At, B1); PG8_BAR; PG8_SCHED;
            PG8_LDA(At, 1, 1); PG8_STAGE(PG8_SB(1, 0), b3, voffB); PG8_STAGE(PG8_SB(1, 1), b3 + hstep, voffB); PG8_STAGE(PG8_SA(1, 0), a3, voffA);
            PG8_WAIT_V(8); PG8_WAIT_L(0); PG8_BAR; PG8_MMA(1, 0, At, B0); PG8_MMA(1, 1, At, B1); PG8_BAR; PG8_SCHED;
            } else {
            PG8_LDB(B0, 0, 0); PG8_SCHED; PG8_LDA(At, 0, 0); PG8_STAGE(PG8_SA(1, 1), a1 + hstep, voffA);
            PG8_WAIT_L(8); PG8_BAR; PG8_WAIT_L(0); PG8_MMA(0, 0, At, B0); PG8_BAR; PG8_SCHED;
            PG8_LDB(B1, 0, 1); PG8_STAGE(PG8_SB(0, 0), b2, voffB);
            PG8_BAR; PG8_WAIT_L(0); PG8_MMA(0, 1, At, B1); PG8_BAR;
            PG8_LDA(At, 0, 1); PG8_STAGE(PG8_SA(0, 0), a2, voffA);
            PG8_BAR; PG8_WAIT_L(0); PG8_MMA(1, 0, At, B0); PG8_BAR; PG8_SCHED;
            PG8_STAGE(PG8_SB(0, 1), b2 + hstep, voffB);
            PG8_WAIT_V(6); PG8_BAR; PG8_MMA(1, 1, At, B1); PG8_BAR;
            PG8_LDB(B0, 1, 0); PG8_SCHED; PG8_LDA(At, 1, 0); PG8_STAGE(PG8_SA(0, 1), a2 + hstep, voffA);
            PG8_WAIT_L(8); PG8_BAR; PG8_WAIT_L(0); PG8_MMA(0, 0, At, B0); PG8_BAR; PG8_SCHED;
            PG8_LDB(B1, 1, 1); PG8_STAGE(PG8_SB(1, 0), b3, voffB);
            PG8_BAR; PG8_WAIT_L(0); PG8_MMA(0, 1, At, B1); PG8_BAR;
            PG8_LDA(At, 1, 1); PG8_STAGE(PG8_SA(1, 0), a3, voffA);
            PG8_BAR; PG8_WAIT_L(0); PG8_MMA(1, 0, At, B0); PG8_BAR; PG8_SCHED;
            PG8_STAGE(PG8_SB(1, 1), b3 + hstep, voffB);
            PG8_WAIT_V(6); PG8_BAR; PG8_MMA(1, 1, At, B1); PG8_BAR;
            }
        }
        if constexpr (ALIGN_EPI) { if (wr == 0) PG8_BAR; }
        if constexpr (!Epi::AFTER_DRAIN) { E(acc, cur, wr, wc, fr, fq); S.done(cur); }
        if (!has_next) break;
#pragma unroll
        for (int a = 0; a < 2; ++a)
#pragma unroll
            for (int b = 0; b < 2; ++b)
#pragma unroll
                for (int m = 0; m < 4; ++m)
#pragma unroll
                    for (int n = 0; n < 2; ++n) acc[a][b][m][n] = (f32x4){0.f, 0.f, 0.f, 0.f};
        cur = nxt; cA = nA; cB = nB; ++ui;
        if constexpr (ALIGN_EPI) { if (wr == 1) PG8_BAR; }
    }
    PG8_WAIT_V(0);
    if constexpr (!ALIGN_EPI) { if (wr == 0) PG8_BAR; }
    PG8_BAR;
    if constexpr (Epi::AFTER_DRAIN) { E.fused(acc, cur, wr, wc, fr, fq, lds, wid, lane); S.done(cur); }
#undef PG8_SA
#undef PG8_SB
#undef PG8_STAGE
#undef PG8_LDA
#undef PG8_LDB
#undef PG8_MMA
#undef PG8_WAIT_V
#undef PG8_WAIT_L
#undef PG8_BAR
#undef PG8_SCHED
}
}
struct Args { const float* in[27]; float* out; unsigned char* ws; int ph_lo, ph_hi; };

__device__ __forceinline__ void transpose_item(const float* W, int K, int N, bf16* WT, const float* gain, int il, LAS float* scr, int item, int lane) {
    const int nblk = N / 32, kb = item / nblk, nb = item % nblk, k0 = 64 * kb, n0 = 32 * nb;
#pragma unroll 8
    for (int i = 0; i < 32; ++i) { const int kk = 2 * i + (lane >> 5); float v = W[(size_t)(k0 + kk) * N + n0 + (lane & 31)]; if (gain) v *= gain[k0 + kk]; scr[kk * 33 + (lane & 31)] = v; }
    LDS_WAIT(); asm volatile("" ::: "memory");
    const int drow0 = il ? (((n0 >> 7) << 8) + (n0 & 127) + (il == 2 ? 128 : 0)) : n0;
    const int c = lane & 7;
#pragma unroll
    for (int j = 0; j < 4; ++j) { const int n = (lane >> 3) + 8 * j; const LAS float* s = scr + (8 * c) * 33 + n;
        v4u o; o.x = pk2(s[0 * 33], s[1 * 33]); o.y = pk2(s[2 * 33], s[3 * 33]); o.z = pk2(s[4 * 33], s[5 * 33]); o.w = pk2(s[6 * 33], s[7 * 33]);
        *(v4u*)(WT + (size_t)(drow0 + n) * K + k0 + 8 * c) = o; }
    LDS_WAIT(); asm volatile("" ::: "memory");
}
__device__ __forceinline__ void phase_prologue(tab_t tab, LAS unsigned char* lds, int tid, int lane, int wave) {
    asm volatile("" : "+v"(lane), "+v"(tid));
    unsigned char* ws = WSP();
    LAS float* scr = (LAS float*)(lds + wave * 16384);
    const int G = gridDim.x, gw = blockIdx.x * NWAVES + wave, NGW = G * NWAVES;
    constexpr int I_GU = (D / 64) * (FF / 32), I_DN = (FF / 64) * (D / 32), I_IN = (D / 64) * (5376 / 32), I_OA = (512 / 64) * (D / 32), I_O = (D / 64) * (D / 32);
    constexpr int NITEMS = 4 * I_GU + 2 * I_DN + I_IN + 2 * I_OA + I_O;
    for (int it = gw; it < NITEMS; it += NGW) {
        int r = it;
        if (r < I_GU) { transpose_item(INP(2), D, FF, (bf16*)(ws + WS_W1GU), INP(1), 1, scr, r, lane); continue; } r -= I_GU;
        if (r < I_GU) { transpose_item(INP(3), D, FF, (bf16*)(ws + WS_W1GU), INP(1), 2, scr, r, lane); continue; } r -= I_GU;
        if (r < I_DN) { transpose_item(INP(4), FF, D, (bf16*)(ws + WS_W1D), nullptr, 0, scr, r, lane); continue; } r -= I_DN;
        if (r < I_GU) { transpose_item(INP(23), D, FF, (bf16*)(ws + WS_W2GU), INP(22), 1, scr, r, lane); continue; } r -= I_GU;
        if (r < I_GU) { transpose_item(INP(24), D, FF, (bf16*)(ws + WS_W2GU), INP(22), 2, scr, r, lane); continue; } r -= I_GU;
        if (r < I_DN) { transpose_item(INP(25), FF, D, (bf16*)(ws + WS_W2D), nullptr, 0, scr, r, lane); continue; } r -= I_DN;
        if (r < I_IN) { transpose_item(INP(6), D, 5376, (bf16*)(ws + WS_WIN), INP(5), 0, scr, r, lane); continue; } r -= I_IN;
        if (r < I_OA) { transpose_item(INP(8), 512, D, (bf16*)(ws + WS_WOA), nullptr, 0, scr, r, lane); continue; } r -= I_OA;
        if (r < I_OA) { transpose_item(INP(20), 512, D, (bf16*)(ws + WS_WOB), nullptr, 0, scr, r, lane); continue; } r -= I_OA;
        transpose_item(INP(21), D, D, (bf16*)(ws + WS_WO), nullptr, 0, scr, r, lane);
    }
    { bf16* WL = (bf16*)(ws + WS_WL); const float* wdu = INP(11); const float* wiu = INP(13); const float* wgu = INP(14);
      for (int idx = blockIdx.x * 512 + tid; idx < 1536 * 256; idx += G * 512) {
          const int n = idx >> 8, kc = idx & 255; float v = 0.f;
          if (n < 512) { if (kc < 64) v = wdu[kc * 512 + n]; }
          else if (n < 1024) { if (kc >= 64 && kc < 128) v = wiu[(kc - 64) * 512 + (n - 512)]; }
          else { if (kc >= 128) v = wgu[(kc - 128) * 512 + (n - 1024)]; }
          WL[idx] = (bf16)f2bf(v); } }
    { const float* x = INP(0); bf16* xb = (bf16*)(ws + WS_XB); float* ssq0 = (float*)(ws + WS_SSQ0);
      for (int m = gw; m < M; m += NGW) {
          const f32x4* xr = (const f32x4*)(x + (size_t)m * D) + lane; f32x4 v[4]; float s = 0.f;
#pragma unroll
          for (int j = 0; j < 4; ++j) { v[j] = xr[64 * j]; s += (v[j][0] * v[j][0] + v[j][1] * v[j][1]) + (v[j][2] * v[j][2] + v[j][3] * v[j][3]); }
          s = wave_sum(s);
          unsigned long long* o8 = (unsigned long long*)(xb + (size_t)m * D) + lane;
#pragma unroll
          for (int j = 0; j < 4; ++j) o8[64 * j] = (unsigned long long)pk2(v[j][0], v[j][1]) | ((unsigned long long)pk2(v[j][2], v[j][3]) << 32);
          if (lane < 16) ssq0[(size_t)m * 16 + lane] = (lane == 0) ? s : 0.f;
      } }
}

__device__ __forceinline__ void ld8(const bf16* p, float (&v)[8]) {
    const v4u w = *(const v4u*)p;
    v[0] = __uint_as_float(w.x << 16); v[1] = __uint_as_float(w.x & 0xffff0000u); v[2] = __uint_as_float(w.y << 16); v[3] = __uint_as_float(w.y & 0xffff0000u);
    v[4] = __uint_as_float(w.z << 16); v[5] = __uint_as_float(w.z & 0xffff0000u); v[6] = __uint_as_float(w.w << 16); v[7] = __uint_as_float(w.w & 0xffff0000u);
}
__device__ __forceinline__ void st8(bf16* p, const float (&v)[8]) {
    v4u w; w.x = pk2(v[0], v[1]); w.y = pk2(v[2], v[3]); w.z = pk2(v[4], v[5]); w.w = pk2(v[6], v[7]); *(v4u*)p = w;
}
__device__ __forceinline__ void phase_prep(tab_t tab, int tid) {
    asm volatile("" : "+v"(tid));
    unsigned char* ws = WSP();
    const bf16* PA = (const bf16*)(ws + WS_PA); const bf16* PB = (const bf16*)(ws + WS_PB);
    bf16* ZA = (bf16*)(ws + WS_ZA); bf16* LIN = (bf16*)(ws + WS_LIN);
    const float* cw = INP(7); const float* mu = INP(9);
    const int gt = blockIdx.x * 512 + tid, NT = gridDim.x * 512;
    for (int it = gt; it < M * 64; it += NT) {
        const int m = it >> 6, c0 = (it & 63) * 8, t = m & (T - 1);
        float bb[8], c_[8], u_[8], acc[8], w0[8], w1[8], w2[8];
#pragma unroll
        for (int j = 0; j < 8; ++j) { w0[j] = cw[c0 + j]; w1[j] = cw[512 + c0 + j]; w2[j] = cw[1024 + c0 + j]; }
        const bf16* row = PA + (size_t)m * 1536;
        ld8(row + c0, bb); ld8(row + 512 + c0, c_); ld8(row + 1024 + c0, u_);
#pragma unroll
        for (int j = 0; j < 8; ++j) acc[j] = w2[j] * (c_[j] * u_[j]);
        if (t >= 1) { ld8(row - 1536 + 512 + c0, c_); ld8(row - 1536 + 1024 + c0, u_);
#pragma unroll
            for (int j = 0; j < 8; ++j) acc[j] += w1[j] * (c_[j] * u_[j]); }
        if (t >= 2) { ld8(row - 3072 + 512 + c0, c_); ld8(row - 3072 + 1024 + c0, u_);
#pragma unroll
            for (int j = 0; j < 8; ++j) acc[j] += w0[j] * (c_[j] * u_[j]); }
#pragma unroll
        for (int j = 0; j < 8; ++j) acc[j] *= bb[j];
        st8(ZA + (size_t)m * 512 + c0, acc);
    }
    for (int it = gt; it < M * 32; it += NT) {
        const int m = it >> 5, c0 = (it & 31) * 8, t = m & (T - 1);
        float x[8], xp[8];
        const bf16* row = PB + (size_t)m * 1792 + 1536 + c0;
        ld8(row, x);
        if (t >= 1) ld8(row - 1792, xp); else {
#pragma unroll
            for (int j = 0; j < 8; ++j) xp[j] = 0.f; }
#pragma unroll
        for (int j = 0; j < 8; ++j) { float v = x[j] + (xp[j] - x[j]) * mu[1536 + c0 + j]; x[j] = (c0 < 64) ? tanhf_(v) : ((c0 < 128) ? v : sigmf(v)); }
        st8(LIN + (size_t)m * 256 + c0, x);
    }
}

struct ScanCtx {
    const bf16* PB; const bf16* LOGW; const bf16* ICLR; const bf16* GG; bf16* ZB; float* PC; float* NS;
    const float* mu; const float* k_k; const float* k_a; const float* r_k; const float* lnw; const float* lnb;
};
template <int MODE>
__device__ __forceinline__ void scan_task(const ScanCtx& X, int cid, LAS float* wl, int lane) {
    asm volatile("" : "+v"(lane));
    const int bh = cid >> 6, c = cid & 63, b = bh >> 3, h = bh & 7;
    const int m0 = b * T + c * 128;
    const int rg = lane >> 2, ks = lane & 3;
    const int hc = h * 64 + lane;
    float S[4][16];
#pragma unroll
    for (int i = 0; i < 4; ++i)
#pragma unroll
        for (int e = 0; e < 16; ++e) S[i][e] = (MODE == 0 && (rg * 4 + i) == (ks * 16 + e)) ? 1.f : 0.f;
    if (MODE == 2 && c > 0) {
        const float* src = X.NS + (size_t)(cid - 1) * 4096;
#pragma unroll
        for (int i = 0; i < 4; ++i)
#pragma unroll
            for (int q = 0; q < 4; ++q) { const f32x4 v = *(const f32x4*)(src + (rg * 4 + i) * 64 + ks * 16 + q * 4); S[i][4 * q] = v[0]; S[i][4 * q + 1] = v[1]; S[i][4 * q + 2] = v[2]; S[i][4 * q + 3] = v[3]; }
    }
    const float mu_r = X.mu[hc], mu_k = X.mu[512 + hc], mu_v = X.mu[1024 + hc];
    const float kk_c = X.k_k[hc], ka_c = X.k_a[hc], rk_c = X.r_k[hc], lnw = X.lnw[hc], lnb = X.lnb[hc];
    LAS float* LA = wl; LAS float* LW = wl + 512; LAS float* LB = wl + 1024; LAS float* LK = wl + 1536; LAS float* LR = wl + 2048; LAS float* LV = wl + 2560; LAS float* LY = wl + 3072; LAS float* LBon = wl + 3584;
    for (int sub = 0; sub < 16; ++sub) {
        const int mb = m0 + sub * 8;
#pragma unroll 4
        for (int s = 0; s < 8; ++s) {
            const int m = mb + s; const bool first = ((m & (T - 1)) == 0);
            const bf16* row = X.PB + (size_t)m * 1792;
            const float rc = bf2f(row[hc]), kc = bf2f(row[512 + hc]), vc = bf2f(row[1024 + hc]);
            float rp = 0.f, kp = 0.f, vp = 0.f;
            if (!first) { rp = bf2f(row[hc - 1792]); kp = bf2f(row[512 + hc - 1792]); vp = bf2f(row[1024 + hc - 1792]); }
            const float r = rc + (rp - rc) * mu_r, k = kc + (kp - kc) * mu_k, v = vc + (vp - vc) * mu_v;
            const float lw = bf2f(X.LOGW[(size_t)m * 512 + hc]), ic = bf2f(X.ICLR[(size_t)m * 512 + hc]);
            float kk = k * kk_c; const float n2 = wave_sum(kk * kk); kk = kk / fmaxf(sqrtf(n2), 1e-12f);
            const float k2 = k * (1.0f + (ic - 1.0f) * ka_c);
            LA[s * 64 + lane] = -kk; LW[s * 64 + lane] = __expf(lw); LB[s * 64 + lane] = kk * ic;
            if (MODE >= 1) { LK[s * 64 + lane] = k2; LV[s * 64 + lane] = v; }
            if (MODE == 2) { LR[s * 64 + lane] = r; const float bon = wave_sum(r * k2 * rk_c); if (lane == 0) LBon[s] = bon; }
        }
        LDS_WAIT(); __builtin_amdgcn_wave_barrier(); asm volatile("" ::: "memory");
        for (int s = 0; s < 8; ++s) {
            f32x4 a4[4], w4[4], b4[4], k4[4], r4[4]; f32x4 vv = (f32x4){0.f, 0.f, 0.f, 0.f};
#pragma unroll
            for (int q = 0; q < 4; ++q) { a4[q] = *(const LAS f32x4*)(LA + s * 64 + ks * 16 + 4 * q); w4[q] = *(const LAS f32x4*)(LW + s * 64 + ks * 16 + 4 * q); b4[q] = *(const LAS f32x4*)(LB + s * 64 + ks * 16 + 4 * q); }
            if (MODE >= 1) {
#pragma unroll
                for (int q = 0; q < 4; ++q) k4[q] = *(const LAS f32x4*)(LK + s * 64 + ks * 16 + 4 * q);
                vv = *(const LAS f32x4*)(LV + s * 64 + rg * 4);
            }
            if (MODE == 2) {
#pragma unroll
                for (int q = 0; q < 4; ++q) r4[q] = *(const LAS f32x4*)(LR + s * 64 + ks * 16 + 4 * q);
            }
            float sa[4];
#pragma unroll
            for (int i = 0; i < 4; ++i) {
                float p[4];
#pragma unroll
                for (int q = 0; q < 4; ++q) p[q] = (S[i][4 * q] * a4[q][0] + S[i][4 * q + 1] * a4[q][1]) + (S[i][4 * q + 2] * a4[q][2] + S[i][4 * q + 3] * a4[q][3]);
                sa[i] = quad_sum((p[0] + p[1]) + (p[2] + p[3]));
            }
#pragma unroll
            for (int i = 0; i < 4; ++i)
#pragma unroll
                for (int q = 0; q < 4; ++q)
#pragma unroll
                    for (int j = 0; j < 4; ++j) {
                        float t = S[i][4 * q + j] * w4[q][j] + sa[i] * b4[q][j];
                        if (MODE >= 1) t += vv[i] * k4[q][j];
                        S[i][4 * q + j] = t;
                    }
            if (MODE == 2) {
                f32x4 y;
#pragma unroll
                for (int i = 0; i < 4; ++i) {
                    float p[4];
#pragma unroll
                    for (int q = 0; q < 4; ++q) p[q] = (S[i][4 * q] * r4[q][0] + S[i][4 * q + 1] * r4[q][1]) + (S[i][4 * q + 2] * r4[q][2] + S[i][4 * q + 3] * r4[q][3]);
                    y[i] = quad_sum((p[0] + p[1]) + (p[2] + p[3]));
                }
                if (ks == 0) *(LAS f32x4*)(LY + s * 64 + rg * 4) = y;
            }
        }
        if (MODE == 2) {
            LDS_WAIT(); __builtin_amdgcn_wave_barrier(); asm volatile("" ::: "memory");
#pragma unroll 4
            for (int s = 0; s < 8; ++s) {
                const int m = mb + s;
                const float y = LY[s * 64 + lane];
                const float mean = wave_sum(y) * (1.0f / 64.0f); const float d = y - mean; const float var = wave_sum(d * d) * (1.0f / 64.0f);
                float yn = d * rsqrtf(var + 64e-5f) * lnw + lnb;
                yn += LBon[s] * LV[s * 64 + lane];
                const float g = bf2f(X.GG[(size_t)m * 512 + hc]);
                X.ZB[(size_t)m * 512 + hc] = (bf16)f2bf(yn * g);
            }
        }
        LDS_WAIT(); __builtin_amdgcn_wave_barrier(); asm volatile("" ::: "memory");
    }
    if (MODE <= 1) {
        float* dst = (MODE == 0 ? X.PC : X.NS) + (size_t)cid * 4096;
#pragma unroll
        for (int i = 0; i < 4; ++i)
#pragma unroll
            for (int q = 0; q < 4; ++q) *(f32x4*)(dst + (rg * 4 + i) * 64 + ks * 16 + q * 4) = (f32x4){S[i][4 * q], S[i][4 * q + 1], S[i][4 * q + 2], S[i][4 * q + 3]};
    }
}
__device__ __forceinline__ void scan_pass_b(const ScanCtx& X, LAS unsigned char* lds, int bh, int tid, int lane, int wave) {
    asm volatile("" : "+v"(lane), "+v"(tid));
    LAS float* Ss = (LAS float*)lds;
    for (int i = tid; i < 64 * 65; i += 512) Ss[i] = 0.f;
    __syncthreads();
    const int bi = (wave >> 1) & 1, bj = wave & 1, l32 = lane & 31, lh = lane >> 5;
    for (int c = 0; c < 63; ++c) {
        const float* P = X.PC + (size_t)(bh * 64 + c) * 4096; float* N = X.NS + (size_t)(bh * 64 + c) * 4096;
        f32x16 acc;
        if (wave < 4) {
#pragma unroll
            for (int r = 0; r < 16; ++r) acc[r] = N[(32 * bi + 8 * (r >> 2) + 4 * lh + (r & 3)) * 64 + 32 * bj + l32];
#pragma unroll 8
            for (int kk = 0; kk < 32; ++kk) {
                const float av = Ss[(32 * bi + l32) * 65 + 2 * kk + lh];
                const float bv = P[(2 * kk + lh) * 64 + 32 * bj + l32];
                acc = __builtin_amdgcn_mfma_f32_32x32x2f32(av, bv, acc, 0, 0, 0);
            }
        }
        __syncthreads();
        if (wave < 4) {
#pragma unroll
            for (int r = 0; r < 16; ++r) { const int row = 32 * bi + 8 * (r >> 2) + 4 * lh + (r & 3), col = 32 * bj + l32; Ss[row * 65 + col] = acc[r]; N[row * 64 + col] = acc[r]; }
        }
        __syncthreads();
    }
}

__device__ __forceinline__ void phase_final(tab_t tab, int lane, int wave) {
    asm volatile("" : "+v"(lane));
    float* out = OUTP(); const float* g = INP(26);
    const int gw = blockIdx.x * NWAVES + wave, NGW = gridDim.x * NWAVES;
    f32x4 gv[4];
#pragma unroll
    for (int j = 0; j < 4; ++j) gv[j] = ((const f32x4*)g)[lane + 64 * j];
    for (int m = gw; m < M; m += NGW) {
        f32x4* xr = (f32x4*)(out + (size_t)m * D) + lane; f32x4 v[4]; float s = 0.f;
#pragma unroll
        for (int j = 0; j < 4; ++j) { v[j] = xr[64 * j]; s += (v[j][0] * v[j][0] + v[j][1] * v[j][1]) + (v[j][2] * v[j][2] + v[j][3] * v[j][3]); }
        const float rs = rsqrtf(wave_sum(s) * (1.0f / D) + 1e-6f);
#pragma unroll
        for (int j = 0; j < 4; ++j) xr[64 * j] = v[j] * rs * gv[j];
    }
}

__device__ __forceinline__ ScanCtx make_scan_ctx(tab_t tab) {
    unsigned char* ws = WSP();
    ScanCtx X; X.PB = (const bf16*)(ws + WS_PB); X.LOGW = (const bf16*)(ws + WS_LOGW); X.ICLR = (const bf16*)(ws + WS_ICLR); X.GG = (const bf16*)(ws + WS_GG); X.ZB = (bf16*)(ws + WS_ZB);
    X.PC = (float*)(ws + WS_PC); X.NS = (float*)(ws + WS_NS); X.mu = INP(9); X.k_k = INP(15); X.k_a = INP(16); X.r_k = INP(17); X.lnw = INP(18); X.lnb = INP(19);
    return X;
}
__global__ void __launch_bounds__(NWAVES * 64, 2) fwd(Args a) {
    extern __shared__ __attribute__((aligned(16))) unsigned char lds_raw[];
    LAS unsigned char* lds = (LAS unsigned char*)lds_raw;
    const int tid = threadIdx.x, lane = tid & 63, wave = __builtin_amdgcn_readfirstlane(tid >> 6);
    const int G = gridDim.x;
    { LAS unsigned long long* tw = (LAS unsigned long long*)(lds + TAB_OFF);
      if (tid == 0) {
#pragma unroll
          for (int i = 0; i < 27; ++i) tw[i] = (unsigned long long)a.in[i];
          tw[27] = (unsigned long long)a.out; tw[28] = (unsigned long long)a.ws; }
      __syncthreads(); }
    const tab_t tab = (tab_t)(lds + TAB_OFF);
    const int ph_lo = a.ph_lo, ph_hi = a.ph_hi;

    for (int p = ph_lo; p < ph_hi; ++p) {
        pg8::Gemm g{nullptr, nullptr, M, 0, 0}; bool isg = false;
        switch (p) {
        case 0: phase_prologue(tab, lds, tid, lane, wave); break;
        case 4: phase_prep(tab, tid); break;
        case 6: { const ScanCtx X = make_scan_ctx(tab); LAS float* wl = (LAS float*)lds + wave * SCAN_WAVE_FLOATS;
                  for (int task = wave * G + (int)blockIdx.x; task < 2048; task += NWAVES * G) { if (task < 1024) scan_task<0>(X, task, wl, lane); else scan_task<1>(X, task - 1024, wl, lane); } } break;
        case 7: if (blockIdx.x < 16) { const ScanCtx X = make_scan_ctx(tab); scan_pass_b(X, lds, (int)blockIdx.x, tid, lane, wave); } break;
        case 8: { const ScanCtx X = make_scan_ctx(tab); LAS float* wl = (LAS float*)lds + wave * SCAN_WAVE_FLOATS;
                  for (int task = wave * G + (int)blockIdx.x; task < 1024; task += NWAVES * G) scan_task<2>(X, task, wl, lane); } break;
        case 15: phase_final(tab, lane, wave); break;
        default: {
            unsigned char* ws = WSP(); isg = true;
            const size_t aoff = (p == 2 || p == 14) ? WS_HID : (p == 5) ? WS_LIN : (p == 10) ? WS_ZA : (p == 11) ? WS_ZB : (p == 12) ? WS_MRG : WS_XB;
            const size_t boff = (p == 1) ? WS_W1GU : (p == 2) ? WS_W1D : (p == 3) ? WS_WIN : (p == 5) ? WS_WL : (p == 9) ? (WS_WIN + (size_t)3328 * D * 2) : (p == 10) ? WS_WOA : (p == 11) ? WS_WOB : (p == 12) ? WS_WO : (p == 13) ? WS_W2GU : WS_W2D;
            const int N = (p == 1 || p == 13) ? 2 * FF : (p == 3) ? 3328 : (p == 5) ? 1536 : (p == 9) ? 2048 : D;
            const int K = (p == 2 || p == 14) ? FF : (p == 5) ? 256 : (p == 10 || p == 11) ? 512 : D;
            g = pg8::Gemm{(const bf16*)(ws + aoff), (const bf16*)(ws + boff), M, N, K}; } break;
        }
        if (isg) { pg8::Epi E{p, tab}; pg8::StaticOrder S; S.init(M, g.N, G, (int)blockIdx.x); pg8::gemm_phase<pg8::Epi, pg8::StaticOrder, true, true>(lds, g, S, E); }
        if (p + 1 < ph_hi) { __syncthreads(); cg::this_grid().sync(); }
    }
}

extern "C" void kernel_launch(void* const* d_in, const int* in_sizes, int n_in, void* d_out, int out_size, void* d_ws, size_t ws_size, hipStream_t stream) {
    static int grid = 0;
    if (grid == 0) {
        if (n_in != 27 || in_sizes[0] != M * D || out_size != M * D || ws_size < WS_END) { fprintf(stderr, "kernel_launch: unexpected shapes (n_in %d, in0 %d, out %d, ws %zu)\n", n_in, n_in > 0 ? in_sizes[0] : -1, out_size, ws_size); grid = -1; return; }
        int dev = 0, cus = 0, per_cu = 0;
        if (hipGetDevice(&dev) != hipSuccess || hipDeviceGetAttribute(&cus, hipDeviceAttributeMultiprocessorCount, dev) != hipSuccess) { grid = -1; return; }
        if (hipFuncSetAttribute((const void*)fwd, hipFuncAttributeMaxDynamicSharedMemorySize, LDS_BYTES) != hipSuccess) { fprintf(stderr, "kernel_launch: hipFuncSetAttribute failed\n"); grid = -1; return; }
        if (hipOccupancyMaxActiveBlocksPerMultiprocessor(&per_cu, (const void*)fwd, NWAVES * 64, LDS_BYTES) != hipSuccess || per_cu < 1) { fprintf(stderr, "kernel_launch: occupancy query says %d blocks per CU\n", per_cu); per_cu = 1; }
        (void)hipGetLastError();
        grid = cus * 1;
    }
    if (grid < 0) return;
    Args a{};
    for (int i = 0; i < 27; ++i) a.in[i] = (const float*)d_in[i];
    a.out = (float*)d_out; a.ws = (unsigned char*)d_ws;
#if MK_PER_PHASE
    for (int p = 0; p < NPH; ++p) { a.ph_lo = p; a.ph_hi = p + 1; hipLaunchKernelGGL(fwd, dim3(grid), dim3(NWAVES * 64), LDS_BYTES, stream, a); }
#else
    a.ph_lo = 0; a.ph_hi = NPH;
    void* args[] = {&a};
    hipError_t e = hipLaunchCooperativeKernel((const void*)fwd, dim3(grid), dim3(NWAVES * 64), args, LDS_BYTES, stream);
    if (e != hipSuccess) fprintf(stderr, "kernel_launch: cooperative launch failed: %s (grid %d)\n", hipGetErrorString(e), grid);
#endif
}
```

```cpp
#include <hip/hip_runtime.h>
#include <hip/hip_cooperative_groups.h>
#include <cstdio>
#include <cstdint>
namespace cg = cooperative_groups;

#ifndef MK_PER_PHASE
#define MK_PER_PHASE 0
#endif
#ifndef PROBE_REPMASK
#define PROBE_REPMASK 0
#endif
#define PROBE_SYNCREP 1
#define PROBE_PBDRY 0
constexpr int NWAVES = 8;
constexpr int T = 8192, D = 1024, M = 16384, FF = 2816, NPH = 16;
constexpr size_t MiB = 1u << 20;
constexpr size_t WS_W1GU = 1 * MiB, WS_W1D = 12 * MiB, WS_W2GU = 17 * MiB + MiB / 2, WS_W2D = 28 * MiB + MiB / 2, WS_WIN = 34 * MiB, WS_WOA = 44 * MiB + MiB / 2,
                 WS_WOB = 45 * MiB + MiB / 2, WS_WO = 46 * MiB + MiB / 2, WS_WL = 48 * MiB + MiB / 2;
constexpr size_t WS_XB = 50 * MiB, WS_SSQ0 = 82 * MiB, WS_SSQ1 = 83 * MiB, WS_SSQ2 = 84 * MiB, WS_R = 85 * MiB;
constexpr size_t WS_HID = WS_R, WS_PA = WS_R, WS_PB = WS_R + 48 * MiB, WS_ZA = WS_R + 104 * MiB, WS_LIN = WS_R + 120 * MiB, WS_NS = WS_R + 128 * MiB, WS_ZB = WS_R + 144 * MiB;
constexpr size_t WS_LOGW = WS_R, WS_ICLR = WS_R + 16 * MiB, WS_GG = WS_R + 32 * MiB;
constexpr size_t WS_PC = WS_W1GU;
constexpr size_t WS_SG = WS_R, WS_MRG = WS_R + 64 * MiB;
constexpr size_t WS_END = WS_R + 160 * MiB;
static_assert(WS_END <= 256 * MiB, "workspace map");
constexpr int CW_BAR = 4096; constexpr size_t CTL_ZERO_BYTES = 65536;
constexpr int MISC_OFF = 131072 + 512;
constexpr int LDS_BYTES = 147456;
constexpr int SCAN_WAVE_FLOATS = 3712;

#define LAS __attribute__((address_space(3)))
typedef unsigned short bf16;
typedef unsigned v4u __attribute__((ext_vector_type(4)));
typedef float f32x4 __attribute__((ext_vector_type(4)));
typedef float f32x16 __attribute__((ext_vector_type(16)));
#define LDS_WAIT() asm volatile("s_waitcnt lgkmcnt(0)" ::: "memory")
__device__ __forceinline__ unsigned f2bf(float f) { unsigned u = __builtin_bit_cast(unsigned, f); return (u + 0x7fffu + ((u >> 16) & 1u)) >> 16; }
__device__ __forceinline__ unsigned pk2(float lo, float hi) { return f2bf(lo) | (f2bf(hi) << 16); }
__device__ __forceinline__ float bf2f(bf16 h) { return __uint_as_float((unsigned)h << 16); }
__device__ __forceinline__ float wave_sum(float v) {
#pragma unroll
    for (int o = 1; o < 64; o <<= 1) v += __shfl_xor(v, o);
    return v;
}
__device__ __forceinline__ float dppf(float x, int ctrl_is_xor2) {
    const int xi = __builtin_bit_cast(int, x);
    const int r = ctrl_is_xor2 ? __builtin_amdgcn_update_dpp(xi, xi, 0x4E, 0xF, 0xF, false) : __builtin_amdgcn_update_dpp(xi, xi, 0xB1, 0xF, 0xF, false);
    return __builtin_bit_cast(float, r);
}
__device__ __forceinline__ float quad_sum(float x) { x += dppf(x, 0); x += dppf(x, 1); return x; }
__device__ __forceinline__ float sigmf(float x) { return __builtin_amdgcn_rcpf(1.0f + __expf(-x)); }
__device__ __forceinline__ float tanhf_(float x) { return 1.0f - 2.0f * __builtin_amdgcn_rcpf(1.0f + __expf(2.0f * x)); }

constexpr int TAB_OFF = 131072 + 1024;
typedef LAS const unsigned long long* tab_t;
__device__ __forceinline__ unsigned long long ldptr_(tab_t tab, int i) {
    const unsigned long long v = tab[i];
    const unsigned lo = __builtin_amdgcn_readfirstlane((unsigned)v), hi = __builtin_amdgcn_readfirstlane((unsigned)(v >> 32));
    return ((unsigned long long)hi << 32) | lo;
}
#define INP(i) ((const float*)ldptr_(tab, (i)))
#define OUTP() ((float*)ldptr_(tab, 27))
#define WSP() ((unsigned char*)ldptr_(tab, 28))
namespace pg8 {
#define PG8_LAS __attribute__((address_space(3)))
typedef unsigned short bf16_t;
typedef short bf16x8 __attribute__((ext_vector_type(8)));
typedef float f32x4 __attribute__((ext_vector_type(4)));
typedef unsigned u32x4 __attribute__((ext_vector_type(4)));
constexpr int BM = 256, BK = 64, HALF = 128, HTB = HALF * BK * 2  , STAGE_BYTES = 8 * HTB, NXCD = 8, WGM = 8;

__host__ __device__ __forceinline__ int lds_byte(int r, int c) { const int st = (r >> 4) * 2 + (c >> 5), rr = r & 15, cc = c & 31, ob = rr * 64 + cc * 2; return st * 1024 + (ob ^ (((ob >> 9) & 1) << 5)); }
__host__ __device__ __forceinline__ void stage_rc(int b, int& R, int& C) { const int st = b / 1024, sb = b % 1024, swz = sb ^ (((sb >> 9) & 1) << 5); R = (st >> 1) * 16 + swz / 64; C = (st & 1) * 32 + (swz % 64) / 2; }
__host__ __device__ __forceinline__ int perm32(int rho) { const int n = rho >> 4, i = rho & 15; return 8 * (i >> 2) + 4 * n + (i & 3); }

struct Unit { int pm, pn; };
struct Gemm { const bf16_t* A; const bf16_t* Bt; int M, N, K; };

struct StaticOrder {
    int nM, nN, nwg, G, c;
    __host__ __device__ void init(int M, int N, int G_, int c_) { nM = M / BM; nN = N / BM; nwg = nM * nN; G = G_; c = c_; }
    __host__ __device__ bool next(int i, Unit& u) const {
        const long L = (long)i * G + c; if (L >= nwg) return false;
        int wgid = (int)L; { const int q = nwg / NXCD, r = nwg % NXCD, xcd = wgid % NXCD, off = wgid / NXCD; wgid = (xcd < r ? xcd * (q + 1) : r * (q + 1) + (xcd - r) * q) + off; }
        const int nig = WGM * nN, gid = wgid / nig, fm = gid * WGM, gsz = (nM - fm) < WGM ? (nM - fm) : WGM;
        u.pm = fm + ((wgid % nig) % gsz); u.pn = (wgid % nig) / gsz; return true;
    }
    __device__ __forceinline__ void a_ready(const Unit&) const {}
    __device__ __forceinline__ void done(const Unit&) const {}
};
__device__ __forceinline__ unsigned cvt_pk_bf16(float lo, float hi) { unsigned r; asm volatile("v_cvt_pk_bf16_f32 %0, %1, %2" : "=v"(r) : "v"(lo), "v"(hi)); return r; }
__device__ __forceinline__ float sigm(float x) { return __builtin_amdgcn_rcpf(1.0f + __expf(-x)); }
__device__ __forceinline__ void store8(bf16_t* p, f32x4 a, f32x4 b) {
    u32x4 w; w.x = cvt_pk_bf16(a[0], a[1]); w.y = cvt_pk_bf16(a[2], a[3]); w.z = cvt_pk_bf16(b[0], b[1]); w.w = cvt_pk_bf16(b[2], b[3]);
    *(u32x4*)p = w;
}
__device__ __forceinline__ void load8(const bf16_t* p, f32x4& a, f32x4& b) {
    const u32x4 w = *(const u32x4*)p;
    a[0] = __uint_as_float(w.x << 16); a[1] = __uint_as_float(w.x & 0xffff0000u); a[2] = __uint_as_float(w.y << 16); a[3] = __uint_as_float(w.y & 0xffff0000u);
    b[0] = __uint_as_float(w.z << 16); b[1] = __uint_as_float(w.z & 0xffff0000u); b[2] = __uint_as_float(w.w << 16); b[3] = __uint_as_float(w.w & 0xffff0000u);
}
enum { EM_SWIGLU = 0, EM_RESID = 1, EM_PAB = 2, EM_LORA = 3, EM_GATES = 4, EM_MERGE1 = 5, EM_MERGE2 = 6 };
struct Epi {
    static constexpr bool PERM = true, AFTER_DRAIN = false;
    int p; tab_t tab;
    __device__ __forceinline__ void operator()(const f32x4 (&acc)[2][2][4][2], const Unit& u, int wr, int wc, int fr, int fq) const {
        unsigned char* ws = WSP();
        const int mode = (p == 1 || p == 13) ? EM_SWIGLU : (p == 2 || p == 12 || p == 14) ? EM_RESID : (p == 3) ? EM_PAB : (p == 5) ? EM_LORA : (p == 9) ? EM_GATES : (p == 10) ? EM_MERGE1 : EM_MERGE2;
        const float* ssq = (const float*)(ws + (p == 1 ? WS_SSQ0 : (p == 13 ? WS_SSQ2 : WS_SSQ1)));
        bf16_t* o0 = nullptr; bf16_t* o1 = nullptr; bf16_t* o2 = nullptr; const float* base = nullptr; float* outf = nullptr; float* ssq_out = nullptr; float scale = 1.f;
        const bf16_t* sg = (const bf16_t*)(ws + WS_SG); const float* q0 = nullptr; const float* q1 = nullptr;
        if (mode == EM_SWIGLU) o0 = (bf16_t*)(ws + WS_HID);
        else if (mode == EM_RESID) { outf = OUTP(); base = (p == 2) ? INP(0) : (const float*)outf; o0 = (p == 14) ? nullptr : (bf16_t*)(ws + WS_XB);
                                     ssq_out = (p == 14) ? nullptr : (float*)(ws + (p == 2 ? WS_SSQ1 : WS_SSQ2)); scale = (p == 12) ? 1.0f : 0.5f; }
        else if (mode == EM_PAB) { o0 = (bf16_t*)(ws + WS_PA); o1 = (bf16_t*)(ws + WS_PB); }
        else if (mode == EM_LORA) { o0 = (bf16_t*)(ws + WS_LOGW); o1 = (bf16_t*)(ws + WS_ICLR); o2 = (bf16_t*)(ws + WS_GG); q0 = INP(10); q1 = INP(12); }
        else if (mode == EM_GATES) o0 = (bf16_t*)(ws + WS_SG);
        else o0 = (bf16_t*)(ws + WS_MRG);
        const int rowb = u.pm * BM + wr * 64 + fr;
        const int cw = wc * 32 + 8 * fq;
#pragma unroll
        for (int ai = 0; ai < 2; ++ai)
#pragma unroll
            for (int m = 0; m < 4; ++m) {
                const size_t row = (size_t)(rowb + ai * HALF + m * 16);
                float s = 1.f;
                if (mode == EM_SWIGLU || mode == EM_PAB || mode == EM_GATES) {
                    const f32x4* q = (const f32x4*)(ssq + row * 16);
                    const f32x4 a = q[0], b = q[1], c = q[2], d = q[3];
                    const f32x4 t = (a + b) + (c + d);
                    s = rsqrtf(((t[0] + t[1]) + (t[2] + t[3])) * (1.0f / 1024.0f) + 1e-6f);
                }
                if (mode == EM_SWIGLU) {
                    f32x4 h0, h1;
#pragma unroll
                    for (int j = 0; j < 4; ++j) {
                        const float g0 = acc[ai][0][m][0][j] * s, u0 = acc[ai][1][m][0][j] * s;
                        const float g1 = acc[ai][0][m][1][j] * s, u1 = acc[ai][1][m][1][j] * s;
                        h0[j] = g0 * sigm(g0) * u0; h1[j] = g1 * sigm(g1) * u1;
                    }
                    store8(o0 + row * 2816 + u.pn * 128 + cw, h0, h1);
                } else if (mode == EM_RESID) {
                    float part = 0.f;
#pragma unroll
                    for (int bj = 0; bj < 2; ++bj) {
                        const size_t off = row * 1024 + u.pn * 256 + bj * HALF + cw;
                        const f32x4 b0 = *(const f32x4*)(base + off), b1 = *(const f32x4*)(base + off + 4);
                        const f32x4 v0 = b0 + acc[ai][bj][m][0] * scale, v1 = b1 + acc[ai][bj][m][1] * scale;
                        *(f32x4*)(outf + off) = v0; *(f32x4*)(outf + off + 4) = v1;
                        if (o0) store8(o0 + off, v0, v1);
                        part += (v0[0] * v0[0] + v0[1] * v0[1]) + (v0[2] * v0[2] + v0[3] * v0[3]) + (v1[0] * v1[0] + v1[1] * v1[1]) + (v1[2] * v1[2] + v1[3] * v1[3]);
                    }
                    if (ssq_out) { part += __shfl_xor(part, 16); part += __shfl_xor(part, 32); if (fq == 0) ssq_out[row * 16 + u.pn * 4 + wc] = part; }
                } else {
#pragma unroll
                    for (int bj = 0; bj < 2; ++bj) {
                        const int col = u.pn * 256 + bj * HALF + cw;
                        f32x4 v0 = acc[ai][bj][m][0], v1 = acc[ai][bj][m][1];
                        if (mode == EM_PAB) {
                            v0 = v0 * s; v1 = v1 * s;
                            if (u.pn < 6) store8(o0 + row * 1536 + col, v0, v1); else store8(o1 + row * 1792 + (col - 1536), v0, v1);
                        } else if (mode == EM_LORA) {
                            const int sel = u.pn >> 1, c = col & 511;
                            if (sel == 0) {
                                const f32x4 p0 = *(const f32x4*)(q0 + c), p1 = *(const f32x4*)(q0 + c + 4);
#pragma unroll
                                for (int j = 0; j < 4; ++j) { v0[j] = -0.6065306597f * sigm(p0[j] + v0[j]); v1[j] = -0.6065306597f * sigm(p1[j] + v1[j]); }
                                store8(o0 + row * 512 + c, v0, v1);
                            } else if (sel == 1) {
                                const f32x4 p0 = *(const f32x4*)(q1 + c), p1 = *(const f32x4*)(q1 + c + 4);
#pragma unroll
                                for (int j = 0; j < 4; ++j) { v0[j] = sigm(p0[j] + v0[j]); v1[j] = sigm(p1[j] + v1[j]); }
                                store8(o1 + row * 512 + c, v0, v1);
                            } else store8(o2 + row * 512 + c, v0, v1);
                        } else if (mode == EM_GATES) {
#pragma unroll
                            for (int j = 0; j < 4; ++j) { v0[j] = sigm(v0[j] * s); v1[j] = sigm(v1[j] * s); }
                            store8(o0 + row * 2048 + col, v0, v1);
                        } else if (mode == EM_MERGE1) {
                            f32x4 g0, g1; load8(sg + row * 2048 + col, g0, g1);
                            store8(o0 + row * 1024 + col, g0 * v0, g1 * v1);
                        } else {
                            f32x4 g0, g1, m0, m1; load8(sg + row * 2048 + 1024 + col, g0, g1); load8(o0 + row * 1024 + col, m0, m1);
                            store8(o0 + row * 1024 + col, m0 + g0 * v0, m1 + g1 * v1);
                        }
                    }
                }
            }
    }
};

template <class Epi, class Sched, bool ALIGN_EPI = false, bool SP2 = false>
__device__ __forceinline__ void gemm_phase(PG8_LAS unsigned char* lds, const Gemm g, const Sched& S, const Epi& E) {
    const int tid = threadIdx.x, wid = __builtin_amdgcn_readfirstlane(tid >> 6), lane = tid & 63, wr = wid >> 2, wc = wid & 3, fr = lane & 15, fq = lane >> 4;
    const int K = g.K, nt = K / BK;
    unsigned voffA[2], voffB[2];
#pragma unroll
    for (int i = 0; i < 2; ++i) { int R, C; stage_rc(tid * 16 + i * 8192, R, C); const int Rb = Epi::PERM ? ((R & ~31) + perm32(R & 31)) : R;
        voffA[i] = (unsigned)(R * K + C) * 2u; voffB[i] = (unsigned)(Rb * K + C) * 2u; }
    const size_t kstep = (size_t)(BK * 2);
    const size_t hstep = (size_t)HALF * K * 2;
    const size_t tstep = 2 * hstep;
    const unsigned ldsw = (unsigned)wid * 1024u;
    const int aoff = lds_byte(wr * 64 + fr, fq * 8), boff = lds_byte(wc * 32 + fr, fq * 8);
#define PG8_SA(b, h) (((b) * 2 + (h)) * HTB)
#define PG8_SB(b, h) ((4 + (b) * 2 + (h)) * HTB)
#define PG8_STAGE(bufoff, gbase, voff) do { _Pragma("unroll") for (int _i = 0; _i < 2; ++_i) \
        __builtin_amdgcn_global_load_lds((const unsigned*)((const char*)(gbase) + (voff)[_i]), (PG8_LAS unsigned*)(lds + (bufoff) + ldsw + _i * 8192), 16, 0, 0); } while (0)
#define PG8_LDA(dst, b, h) do { _Pragma("unroll") for (int m = 0; m < 4; ++m) _Pragma("unroll") for (int k = 0; k < 2; ++k) dst[m][k] = *(const PG8_LAS bf16x8*)(lds + PG8_SA(b, h) + aoff + m * 2048 + k * 1024); } while (0)
#define PG8_LDB(dst, b, h) do { _Pragma("unroll") for (int n = 0; n < 2; ++n) _Pragma("unroll") for (int k = 0; k < 2; ++k) dst[n][k] = *(const PG8_LAS bf16x8*)(lds + PG8_SB(b, h) + boff + n * 2048 + k * 1024); } while (0)
#define PG8_MMA(ai, bj, At, Bt) do { __builtin_amdgcn_s_setprio(1); _Pragma("unroll") for (int m = 0; m < 4; ++m) _Pragma("unroll") for (int n = 0; n < 2; ++n) _Pragma("unroll") for (int k = 0; k < 2; ++k) \
        acc[ai][bj][m][n] = __builtin_amdgcn_mfma_f32_16x16x32_bf16(Bt[n][k], At[m][k], acc[ai][bj][m][n], 0, 0, 0); __builtin_amdgcn_s_setprio(0); } while (0)
#define PG8_WAIT_V(n) asm volatile("s_waitcnt vmcnt(" #n ")" ::: "memory")
#define PG8_WAIT_L(n) asm volatile("s_waitcnt lgkmcnt(" #n ")" ::: "memory")
#define PG8_BAR __builtin_amdgcn_s_barrier()
#define PG8_SCHED __builtin_amdgcn_sched_barrier(0)
    Unit cur, nxt; int ui = 0;
    if (!S.next(0, cur)) return;
    f32x4 acc[2][2][4][2];
#pragma unroll
    for (int a = 0; a < 2; ++a)
#pragma unroll
        for (int b = 0; b < 2; ++b)
#pragma unroll
            for (int m = 0; m < 4; ++m)
#pragma unroll
                for (int n = 0; n < 2; ++n) acc[a][b][m][n] = (f32x4){0.f, 0.f, 0.f, 0.f};
    bf16x8 At[4][2], B0[2][2], B1[2][2];
    const char* cA = (const char*)g.A + (size_t)cur.pm * tstep; const char* cB = (const char*)g.Bt + (size_t)cur.pn * tstep;
    S.a_ready(cur);
    if constexpr (SP2) {
        PG8_STAGE(PG8_SB(0, 0), cB, voffB); PG8_STAGE(PG8_SB(0, 1), cB + hstep, voffB); PG8_STAGE(PG8_SA(0, 0), cA, voffA); PG8_STAGE(PG8_SA(0, 1), cA + hstep, voffA);
        if (wr == 1) PG8_BAR;
        PG8_WAIT_V(2); PG8_BAR;
        PG8_STAGE(PG8_SB(1, 0), cB + kstep, voffB); PG8_STAGE(PG8_SA(1, 0), cA + kstep, voffA); PG8_STAGE(PG8_SB(1, 1), cB + hstep + kstep, voffB);
        PG8_WAIT_V(6); PG8_BAR;
    } else {
        PG8_STAGE(PG8_SB(0, 0), cB, voffB); PG8_STAGE(PG8_SA(0, 0), cA, voffA); PG8_STAGE(PG8_SB(0, 1), cB + hstep, voffB); PG8_STAGE(PG8_SA(0, 1), cA + hstep, voffA);
        if (wr == 1) PG8_BAR;
        PG8_WAIT_V(4); PG8_BAR;
        PG8_STAGE(PG8_SB(1, 0), cB + kstep, voffB); PG8_STAGE(PG8_SA(1, 0), cA + kstep, voffA); PG8_STAGE(PG8_SB(1, 1), cB + hstep + kstep, voffB);
        PG8_WAIT_V(6); PG8_BAR;
    }
    for (;;) {
        const bool has_next = S.next(ui + 1, nxt);
        const char* nA = has_next ? (const char*)g.A + (size_t)nxt.pm * tstep : cA; const char* nB = has_next ? (const char*)g.Bt + (size_t)nxt.pn * tstep : cB;
        for (int t = 0; t < nt; t += 2) {
            const bool last = (t == nt - 2);
            const char* a1 = cA + (size_t)(t + 1) * kstep;
            const char* a2 = last ? nA : cA + (size_t)(t + 2) * kstep; const char* b2 = last ? nB : cB + (size_t)(t + 2) * kstep;
            const char* a3 = a2 + kstep; const char* b3 = b2 + kstep;
            if (last && has_next) S.a_ready(nxt);
            if constexpr (SP2) {
            PG8_LDB(B0, 0, 0); PG8_LDB(B1, 0, 1); PG8_SCHED; PG8_LDA(At, 0, 0); PG8_STAGE(PG8_SA(1, 1), a1 + hstep, voffA);
            PG8_WAIT_V(8); PG8_WAIT_L(0); PG8_BAR; PG8_MMA(0, 0, At, B0); PG8_MMA(0, 1, At, B1); PG8_BAR; PG8_SCHED;
            PG8_LDA(At, 0, 1); PG8_STAGE(PG8_SB(0, 0), b2, voffB); PG8_STAGE(PG8_SB(0, 1), b2 + hstep, voffB); PG8_STAGE(PG8_SA(0, 0), a2, voffA);
            PG8_WAIT_V(8); PG8_WAIT_L(0); PG8_BAR; PG8_MMA(1, 0, At, B0); PG8_MMA(1, 1, At, B1); PG8_BAR; PG8_SCHED;
            PG8_LDB(B0, 1, 0); PG8_LDB(B1, 1, 1); PG8_SCHED; PG8_LDA(At, 1, 0); PG8_STAGE(PG8_SA(0, 1), a2 + hstep, voffA);
            PG8_WAIT_V(8); PG8_WAIT_L(0); PG8_BAR; PG8_MMA(0, 0, At, B0); PG8_MMA(0, 1, At, B1); PG8_BAR; PG8_SCHED;
            PG8_LDA(At, 1, 1); PG8_STAGE(PG8_SB(1, 0), b3, voffB); PG8_STAGE(PG8_SB(1, 1), b3 + hstep, voffB); PG8_STAGE(PG8_SA(1, 0), a3, voffA);
            PG8_WAIT_V(8); PG8_WAIT_L(0); PG8_BAR; PG8_MMA(1, 0, At, B0); PG8_MMA(1, 1, At, B1); PG8_BAR; PG8_SCHED;
            } else {
            PG8_LDB(B0, 0, 0); PG8_SCHED; PG8_LDA(At, 0, 0); PG8_STAGE(PG8_SA(1, 1), a1 + hstep, voffA);
            PG8_WAIT_L(8); PG8_BAR; PG8_WAIT_L(0); PG8_MMA(0, 0, At, B0); PG8_BAR; PG8_SCHED;
            PG8_LDB(B1, 0, 1); PG8_STAGE(PG8_SB(0, 0), b2, voffB);
            PG8_BAR; PG8_WAIT_L(0); PG8_MMA(0, 1, At, B1); PG8_BAR;
            PG8_LDA(At, 0, 1); PG8_STAGE(PG8_SA(0, 0), a2, voffA);
            PG8_BAR; PG8_WAIT_L(0); PG8_MMA(1, 0, At, B0); PG8_BAR; PG8_SCHED;
            PG8_STAGE(PG8_SB(0, 1), b2 + hstep, voffB);
            PG8_WAIT_V(6); PG8_BAR; PG8_MMA(1, 1, At, B1); PG8_BAR;
            PG8_LDB(B0, 1, 0); PG8_SCHED; PG8_LDA(At, 1, 0); PG8_STAGE(PG8_SA(0, 1), a2 + hstep, voffA);
            PG8_WAIT_L(8); PG8_BAR; PG8_WAIT_L(0); PG8_MMA(0, 0, At, B0); PG8_BAR; PG8_SCHED;
            PG8_LDB(B1, 1, 1); PG8_STAGE(PG8_SB(1, 0), b3, voffB);
            PG8_BAR; PG8_WAIT_L(0); PG8_MMA(0, 1, At, B1); PG8_BAR;
            PG8_LDA(At, 1, 1); PG8_STAGE(PG8_SA(1, 0), a3, voffA);
            PG8_BAR; PG8_WAIT_L(0); PG8_MMA(1, 0, At, B0); PG8_BAR; PG8_SCHED;
            PG8_STAGE(PG8_SB(1, 1), b3 + hstep, voffB);
            PG8_WAIT_V(6); PG8_BAR; PG8_MMA(1, 1, At, B1); PG8_BAR;
            }
        }
        if constexpr (ALIGN_EPI) { if (wr == 0) PG8_BAR; }
        if constexpr (!Epi::AFTER_DRAIN) { E(acc, cur, wr, wc, fr, fq); S.done(cur); }
        if (!has_next) break;
#pragma unroll
        for (int a = 0; a < 2; ++a)
#pragma unroll
            for (int b = 0; b < 2; ++b)
#pragma unroll
                for (int m = 0; m < 4; ++m)
#pragma unroll
                    for (int n = 0; n < 2; ++n) acc[a][b][m][n] = (f32x4){0.f, 0.f, 0.f, 0.f};
        cur = nxt; cA = nA; cB = nB; ++ui;
        if constexpr (ALIGN_EPI) { if (wr == 1) PG8_BAR; }
    }
    PG8_WAIT_V(0);
    if constexpr (!ALIGN_EPI) { if (wr == 0) PG8_BAR; }
    PG8_BAR;
    if constexpr (Epi::AFTER_DRAIN) { E.fused(acc, cur, wr, wc, fr, fq, lds, wid, lane); S.done(cur); }
#undef PG8_SA
#undef PG8_SB
#undef PG8_STAGE
#undef PG8_LDA
#undef PG8_LDB
#undef PG8_MMA
#undef PG8_WAIT_V
#undef PG8_WAIT_L
#undef PG8_BAR
#undef PG8_SCHED
}
}
struct Args { const float* in[27]; float* out; unsigned char* ws; int ph_lo, ph_hi; };

__device__ __forceinline__ void transpose_item(const float* W, int K, int N, bf16* WT, const float* gain, int il, LAS float* scr, int item, int lane) {
    const int nblk = N / 32, kb = item / nblk, nb = item % nblk, k0 = 64 * kb, n0 = 32 * nb;
#pragma unroll 8
    for (int i = 0; i < 32; ++i) { const int kk = 2 * i + (lane >> 5); float v = W[(size_t)(k0 + kk) * N + n0 + (lane & 31)]; if (gain) v *= gain[k0 + kk]; scr[kk * 33 + (lane & 31)] = v; }
    LDS_WAIT(); asm volatile("" ::: "memory");
    const int drow0 = il ? (((n0 >> 7) << 8) + (n0 & 127) + (il == 2 ? 128 : 0)) : n0;
    const int c = lane & 7;
#pragma unroll
    for (int j = 0; j < 4; ++j) { const int n = (lane >> 3) + 8 * j; const LAS float* s = scr + (8 * c) * 33 + n;
        v4u o; o.x = pk2(s[0 * 33], s[1 * 33]); o.y = pk2(s[2 * 33], s[3 * 33]); o.z = pk2(s[4 * 33], s[5 * 33]); o.w = pk2(s[6 * 33], s[7 * 33]);
        *(v4u*)(WT + (size_t)(drow0 + n) * K + k0 + 8 * c) = o; }
    LDS_WAIT(); asm volatile("" ::: "memory");
}
__device__ __forceinline__ void phase_prologue(tab_t tab, LAS unsigned char* lds, int tid, int lane, int wave) {
    asm volatile("" : "+v"(lane), "+v"(tid));
    unsigned char* ws = WSP();
    LAS float* scr = (LAS float*)(lds + wave * 16384);
    const int G = gridDim.x, gw = blockIdx.x * NWAVES + wave, NGW = G * NWAVES;
    constexpr int I_GU = (D / 64) * (FF / 32), I_DN = (FF / 64) * (D / 32), I_IN = (D / 64) * (5376 / 32), I_OA = (512 / 64) * (D / 32), I_O = (D / 64) * (D / 32);
    constexpr int NITEMS = 4 * I_GU + 2 * I_DN + I_IN + 2 * I_OA + I_O;
    for (int it = gw; it < NITEMS; it += NGW) {
        int r = it;
        if (r < I_GU) { transpose_item(INP(2), D, FF, (bf16*)(ws + WS_W1GU), INP(1), 1, scr, r, lane); continue; } r -= I_GU;
        if (r < I_GU) { transpose_item(INP(3), D, FF, (bf16*)(ws + WS_W1GU), INP(1), 2, scr, r, lane); continue; } r -= I_GU;
        if (r < I_DN) { transpose_item(INP(4), FF, D, (bf16*)(ws + WS_W1D), nullptr, 0, scr, r, lane); continue; } r -= I_DN;
        if (r < I_GU) { transpose_item(INP(23), D, FF, (bf16*)(ws + WS_W2GU), INP(22), 1, scr, r, lane); continue; } r -= I_GU;
        if (r < I_GU) { transpose_item(INP(24), D, FF, (bf16*)(ws + WS_W2GU), INP(22), 2, scr, r, lane); continue; } r -= I_GU;
        if (r < I_DN) { transpose_item(INP(25), FF, D, (bf16*)(ws + WS_W2D), nullptr, 0, scr, r, lane); continue; } r -= I_DN;
        if (r < I_IN) { transpose_item(INP(6), D, 5376, (bf16*)(ws + WS_WIN), INP(5), 0, scr, r, lane); continue; } r -= I_IN;
        if (r < I_OA) { transpose_item(INP(8), 512, D, (bf16*)(ws + WS_WOA), nullptr, 0, scr, r, lane); continue; } r -= I_OA;
        if (r < I_OA) { transpose_item(INP(20), 512, D, (bf16*)(ws + WS_WOB), nullptr, 0, scr, r, lane); continue; } r -= I_OA;
        transpose_item(INP(21), D, D, (bf16*)(ws + WS_WO), nullptr, 0, scr, r, lane);
    }
    { bf16* WL = (bf16*)(ws + WS_WL); const float* wdu = INP(11); const float* wiu = INP(13); const float* wgu = INP(14);
      for (int idx = blockIdx.x * 512 + tid; idx < 1536 * 256; idx += G * 512) {
          const int n = idx >> 8, kc = idx & 255; float v = 0.f;
          if (n < 512) { if (kc < 64) v = wdu[kc * 512 + n]; }
          else if (n < 1024) { if (kc >= 64 && kc < 128) v = wiu[(kc - 64) * 512 + (n - 512)]; }
          else { if (kc >= 128) v = wgu[(kc - 128) * 512 + (n - 1024)]; }
          WL[idx] = (bf16)f2bf(v); } }
    { const float* x = INP(0); bf16* xb = (bf16*)(ws + WS_XB); float* ssq0 = (float*)(ws + WS_SSQ0);
      for (int m = gw; m < M; m += NGW) {
          const f32x4* xr = (const f32x4*)(x + (size_t)m * D) + lane; f32x4 v[4]; float s = 0.f;
#pragma unroll
          for (int j = 0; j < 4; ++j) { v[j] = xr[64 * j]; s += (v[j][0] * v[j][0] + v[j][1] * v[j][1]) + (v[j][2] * v[j][2] + v[j][3] * v[j][3]); }
          s = wave_sum(s);
          unsigned long long* o8 = (unsigned long long*)(xb + (size_t)m * D) + lane;
#pragma unroll
          for (int j = 0; j < 4; ++j) o8[64 * j] = (unsigned long long)pk2(v[j][0], v[j][1]) | ((unsigned long long)pk2(v[j][2], v[j][3]) << 32);
          if (lane < 16) ssq0[(size_t)m * 16 + lane] = (lane == 0) ? s : 0.f;
      } }
}

__device__ __forceinline__ void ld8(const bf16* p, float (&v)[8]) {
    const v4u w = *(const v4u*)p;
    v[0] = __uint_as_float(w.x << 16); v[1] = __uint_as_float(w.x & 0xffff0000u); v[2] = __uint_as_float(w.y << 16); v[3] = __uint_as_float(w.y & 0xffff0000u);
    v[4] = __uint_as_float(w.z << 16); v[5] = __uint_as_float(w.z & 0xffff0000u); v[6] = __uint_as_float(w.w << 16); v[7] = __uint_as_float(w.w & 0xffff0000u);
}
__device__ __forceinline__ void st8(bf16* p, const float (&v)[8]) {
    v4u w; w.x = pk2(v[0], v[1]); w.y = pk2(v[2], v[3]); w.z = pk2(v[4], v[5]); w.w = pk2(v[6], v[7]); *(v4u*)p = w;
}
__device__ __forceinline__ void phase_prep(tab_t tab, int tid) {
    asm volatile("" : "+v"(tid));
    unsigned char* ws = WSP();
    const bf16* PA = (const bf16*)(ws + WS_PA); const bf16* PB = (const bf16*)(ws + WS_PB);
    bf16* ZA = (bf16*)(ws + WS_ZA); bf16* LIN = (bf16*)(ws + WS_LIN);
    const float* cw = INP(7); const float* mu = INP(9);
    const int gt = blockIdx.x * 512 + tid, NT = gridDim.x * 512;
    for (int it = gt; it < M * 64; it += NT) {
        const int m = it >> 6, c0 = (it & 63) * 8, t = m & (T - 1);
        float bb[8], c_[8], u_[8], acc[8], w0[8], w1[8], w2[8];
#pragma unroll
        for (int j = 0; j < 8; ++j) { w0[j] = cw[c0 + j]; w1[j] = cw[512 + c0 + j]; w2[j] = cw[1024 + c0 + j]; }
        const bf16* row = PA + (size_t)m * 1536;
        ld8(row + c0, bb); ld8(row + 512 + c0, c_); ld8(row + 1024 + c0, u_);
#pragma unroll
        for (int j = 0; j < 8; ++j) acc[j] = w2[j] * (c_[j] * u_[j]);
        if (t >= 1) { ld8(row - 1536 + 512 + c0, c_); ld8(row - 1536 + 1024 + c0, u_);
#pragma unroll
            for (int j = 0; j < 8; ++j) acc[j] += w1[j] * (c_[j] * u_[j]); }
        if (t >= 2) { ld8(row - 3072 + 512 + c0, c_); ld8(row - 3072 + 1024 + c0, u_);
#pragma unroll
            for (int j = 0; j < 8; ++j) acc[j] += w0[j] * (c_[j] * u_[j]); }
#pragma unroll
        for (int j = 0; j < 8; ++j) acc[j] *= bb[j];
        st8(ZA + (size_t)m * 512 + c0, acc);
    }
    for (int it = gt; it < M * 32; it += NT) {
        const int m = it >> 5, c0 = (it & 31) * 8, t = m & (T - 1);
        float x[8], xp[8];
        const bf16* row = PB + (size_t)m * 1792 + 1536 + c0;
        ld8(row, x);
        if (t >= 1) ld8(row - 1792, xp); else {
#pragma unroll
            for (int j = 0; j < 8; ++j) xp[j] = 0.f; }
#pragma unroll
        for (int j = 0; j < 8; ++j) { float v = x[j] + (xp[j] - x[j]) * mu[1536 + c0 + j]; x[j] = (c0 < 64) ? tanhf_(v) : ((c0 < 128) ? v : sigmf(v)); }
        st8(LIN + (size_t)m * 256 + c0, x);
    }
}

struct ScanCtx {
    const bf16* PB; const bf16* LOGW; const bf16* ICLR; const bf16* GG; bf16* ZB; float* PC; float* NS;
    const float* mu; const float* k_k; const float* k_a; const float* r_k; const float* lnw; const float* lnb;
};
template <int CTRL> __device__ __forceinline__ float dppx(float x) {
    const int xi = __builtin_bit_cast(int, x);
    return __builtin_bit_cast(float, __builtin_amdgcn_update_dpp(xi, xi, CTRL, 0xF, 0xF, false));
}
__device__ __forceinline__ float wave_sum_dpp(float v) {
    v += dppx<0xB1>(v); v += dppx<0x4E>(v); v += dppx<0x141>(v); v += dppx<0x140>(v);
    const int vi = __builtin_bit_cast(int, v);
    const float s0 = __builtin_bit_cast(float, __builtin_amdgcn_readlane(vi, 0)), s1 = __builtin_bit_cast(float, __builtin_amdgcn_readlane(vi, 16));
    const float s2 = __builtin_bit_cast(float, __builtin_amdgcn_readlane(vi, 32)), s3 = __builtin_bit_cast(float, __builtin_amdgcn_readlane(vi, 48));
    return (s0 + s1) + (s2 + s3);
}
struct Raw8 { unsigned r[8], k[8], v[8], lw[8], ic[8]; };
__device__ __forceinline__ void load_raw(const ScanCtx& X, int mb, int hc, Raw8& q) {
#pragma unroll
    for (int s = 0; s < 8; ++s) {
        const bf16* row = X.PB + (size_t)(mb + s) * 1792;
        q.r[s] = row[hc]; q.k[s] = row[512 + hc]; q.v[s] = row[1024 + hc];
        q.lw[s] = X.LOGW[(size_t)(mb + s) * 512 + hc]; q.ic[s] = X.ICLR[(size_t)(mb + s) * 512 + hc];
    }
}
template <int MODE>
__device__ __forceinline__ void scan_task(const ScanCtx& X, int cid, LAS float* wl, int lane) {
    asm volatile("" : "+v"(lane));
    const int bh = cid >> 6, c = cid & 63, b = bh >> 3, h = bh & 7;
    const int m0 = b * T + c * 128;
    const int rg = lane >> 2, ks = lane & 3;
    const int hc = h * 64 + lane;
    float S[4][16];
#pragma unroll
    for (int i = 0; i < 4; ++i)
#pragma unroll
        for (int e = 0; e < 16; ++e) S[i][e] = (MODE == 0 && (rg * 4 + i) == (ks * 16 + e)) ? 1.f : 0.f;
    if (MODE == 2 && c > 0) {
        const float* src = X.NS + (size_t)(cid - 1) * 4096;
#pragma unroll
        for (int i = 0; i < 4; ++i)
#pragma unroll
            for (int q = 0; q < 4; ++q) { const f32x4 v = *(const f32x4*)(src + (rg * 4 + i) * 64 + ks * 16 + q * 4); S[i][4 * q] = v[0]; S[i][4 * q + 1] = v[1]; S[i][4 * q + 2] = v[2]; S[i][4 * q + 3] = v[3]; }
    }
    const float mu_r = X.mu[hc], mu_k = X.mu[512 + hc], mu_v = X.mu[1024 + hc];
    const float kk_c = X.k_k[hc], ka_c = X.k_a[hc], rk_c = X.r_k[hc], lnw = X.lnw[hc], lnb = X.lnb[hc];
    LAS float* LA = wl; LAS float* LW = wl + 512; LAS float* LB = wl + 1024; LAS float* LK = wl + 1536; LAS float* LR = wl + 2048; LAS float* LV = wl + 2560; LAS float* LY = wl + 3072; LAS float* LBon = wl + 3584;
    float rp = 0.f, kp = 0.f, vp = 0.f;
    if (c > 0) { const bf16* row = X.PB + (size_t)(m0 - 1) * 1792; rp = bf2f(row[hc]); kp = bf2f(row[512 + hc]); vp = bf2f(row[1024 + hc]); }
    Raw8 cur; load_raw(X, m0, hc, cur);
    for (int sub = 0; sub < 16; ++sub) {
        const int mb = m0 + sub * 8;
#pragma unroll
        for (int s = 0; s < 8; ++s) {
            const float rc = __uint_as_float(cur.r[s] << 16), kc = __uint_as_float(cur.k[s] << 16), vc = __uint_as_float(cur.v[s] << 16);
            const float r = rc + (rp - rc) * mu_r, k = kc + (kp - kc) * mu_k, v = vc + (vp - vc) * mu_v;
            rp = rc; kp = kc; vp = vc;
            const float lw = __uint_as_float(cur.lw[s] << 16), ic = __uint_as_float(cur.ic[s] << 16);
            float kk = k * kk_c; const float n2 = wave_sum_dpp(kk * kk); kk = kk * rsqrtf(fmaxf(n2, 1e-24f));
            const float k2 = k * (1.0f + (ic - 1.0f) * ka_c);
            LA[s * 64 + lane] = -kk; LW[s * 64 + lane] = __expf(lw); LB[s * 64 + lane] = kk * ic;
            if (MODE >= 1) { LK[s * 64 + lane] = k2; LV[s * 64 + lane] = v; }
            if (MODE == 2) { LR[s * 64 + lane] = r; const float bon = wave_sum_dpp(r * k2 * rk_c); if (lane == 0) LBon[s] = bon; }
        }
        if (sub < 15) load_raw(X, mb + 8, hc, cur);
        unsigned gq[8];
        if (MODE == 2) {
#pragma unroll
            for (int s = 0; s < 8; ++s) gq[s] = X.GG[(size_t)(mb + s) * 512 + hc];
        }
        asm volatile("s_waitcnt lgkmcnt(0)" ::: "memory"); __builtin_amdgcn_wave_barrier();
#pragma nounroll
        for (int s = 0; s < 8; ++s) {
            f32x4 a4[4], w4[4], b4[4], k4[4], r4[4]; f32x4 vv = (f32x4){0.f, 0.f, 0.f, 0.f};
#pragma unroll
            for (int q = 0; q < 4; ++q) { a4[q] = *(const LAS f32x4*)(LA + s * 64 + ks * 16 + 4 * q); w4[q] = *(const LAS f32x4*)(LW + s * 64 + ks * 16 + 4 * q); b4[q] = *(const LAS f32x4*)(LB + s * 64 + ks * 16 + 4 * q); }
            if (MODE >= 1) {
#pragma unroll
                for (int q = 0; q < 4; ++q) k4[q] = *(const LAS f32x4*)(LK + s * 64 + ks * 16 + 4 * q);
                vv = *(const LAS f32x4*)(LV + s * 64 + rg * 4);
            }
            if (MODE == 2) {
#pragma unroll
                for (int q = 0; q < 4; ++q) r4[q] = *(const LAS f32x4*)(LR + s * 64 + ks * 16 + 4 * q);
            }
            float sa[4];
#pragma unroll
            for (int i = 0; i < 4; ++i) {
                float p[4];
#pragma unroll
                for (int q = 0; q < 4; ++q) p[q] = (S[i][4 * q] * a4[q][0] + S[i][4 * q + 1] * a4[q][1]) + (S[i][4 * q + 2] * a4[q][2] + S[i][4 * q + 3] * a4[q][3]);
                sa[i] = quad_sum((p[0] + p[1]) + (p[2] + p[3]));
            }
#pragma unroll
            for (int i = 0; i < 4; ++i)
#pragma unroll
                for (int q = 0; q < 4; ++q)
#pragma unroll
                    for (int j = 0; j < 4; ++j) {
                        float t = S[i][4 * q + j] * w4[q][j] + sa[i] * b4[q][j];
                        if (MODE >= 1) t += vv[i] * k4[q][j];
                        S[i][4 * q + j] = t;
                    }
            if (MODE == 2) {
                f32x4 y;
#pragma unroll
                for (int i = 0; i < 4; ++i) {
                    float p[4];
#pragma unroll
                    for (int q = 0; q < 4; ++q) p[q] = (S[i][4 * q] * r4[q][0] + S[i][4 * q + 1] * r4[q][1]) + (S[i][4 * q + 2] * r4[q][2] + S[i][4 * q + 3] * r4[q][3]);
                    y[i] = quad_sum((p[0] + p[1]) + (p[2] + p[3]));
                }
                if (ks == 0) *(LAS f32x4*)(LY + s * 64 + rg * 4) = y;
            }
        }
        if (MODE == 2) {
            asm volatile("s_waitcnt lgkmcnt(0)" ::: "memory"); __builtin_amdgcn_wave_barrier();
#pragma unroll
            for (int s = 0; s < 8; ++s) {
                const int m = mb + s;
                const float y = LY[s * 64 + lane];
                const float mean = wave_sum_dpp(y) * (1.0f / 64.0f); const float d = y - mean; const float var = wave_sum_dpp(d * d) * (1.0f / 64.0f);
                float yn = d * rsqrtf(var + 64e-5f) * lnw + lnb;
                yn += LBon[s] * LV[s * 64 + lane];
                const float g = __uint_as_float(gq[s] << 16);
                X.ZB[(size_t)m * 512 + hc] = (bf16)f2bf(yn * g);
            }
        }
        asm volatile("s_waitcnt lgkmcnt(0)" ::: "memory"); __builtin_amdgcn_wave_barrier();
    }
    if (MODE <= 1) {
        float* dst = (MODE == 0 ? X.PC : X.NS) + (size_t)cid * 4096;
#pragma unroll
        for (int i = 0; i < 4; ++i)
#pragma unroll
            for (int q = 0; q < 4; ++q) *(f32x4*)(dst + (rg * 4 + i) * 64 + ks * 16 + q * 4) = (f32x4){S[i][4 * q], S[i][4 * q + 1], S[i][4 * q + 2], S[i][4 * q + 3]};
    }
}
struct PbBuf { float p[16]; float n[4]; };
__device__ __forceinline__ void pb_load(const ScanCtx& X, int bh, int c, int half, int rb, int cb, int l16, int lq, PbBuf& q) {
    const float* P = X.PC + (size_t)(bh * 64 + c) * 4096; const float* N = X.NS + (size_t)(bh * 64 + c) * 4096;
#pragma unroll
    for (int kk = 0; kk < 16; ++kk) q.p[kk] = P[(4 * kk + lq) * 64 + cb * 16 + l16];
#pragma unroll
    for (int r = 0; r < 4; ++r) q.n[r] = N[(32 * half + rb * 16 + 4 * lq + r) * 64 + cb * 16 + l16];
}
__device__ __forceinline__ void pb_step(const ScanCtx& X, LAS float* Ss, int bh, int c, int half, int rb, int cb, int l16, int lq, const PbBuf& q, bool store) {
    f32x4 acc = (f32x4){q.n[0], q.n[1], q.n[2], q.n[3]};
    float av[16];
#pragma unroll
    for (int kk = 0; kk < 16; ++kk) av[kk] = Ss[(rb * 16 + l16) * 68 + 4 * kk + lq];
#pragma unroll
    for (int kk = 0; kk < 16; ++kk) acc = __builtin_amdgcn_mfma_f32_16x16x4f32(av[kk], q.p[kk], acc, 0, 0, 0);
    asm volatile("s_waitcnt lgkmcnt(0)" ::: "memory"); __builtin_amdgcn_s_barrier(); asm volatile("" ::: "memory");
    float* N = X.NS + (size_t)(bh * 64 + c) * 4096;
#pragma unroll
    for (int r = 0; r < 4; ++r) { Ss[(rb * 16 + 4 * lq + r) * 68 + cb * 16 + l16] = acc[r]; if (store) N[(32 * half + rb * 16 + 4 * lq + r) * 64 + cb * 16 + l16] = acc[r]; }
    asm volatile("s_waitcnt lgkmcnt(0)" ::: "memory"); __builtin_amdgcn_s_barrier(); asm volatile("" ::: "memory");
}
__device__ __forceinline__ void scan_pass_b(const ScanCtx& X, LAS unsigned char* lds, int wb, int tid, int lane, int wave, bool store) {
    asm volatile("" : "+v"(lane), "+v"(tid));
    LAS float* Ss = (LAS float*)lds;
    for (int i = tid; i < 32 * 68; i += 512) Ss[i] = 0.f;
    __syncthreads();
    const int bh = wb >> 1, half = wb & 1, rb = wave >> 2, cb = wave & 3, l16 = lane & 15, lq = lane >> 4;
    PbBuf q0, q1, q2;
    pb_load(X, bh, 0, half, rb, cb, l16, lq, q0); pb_load(X, bh, 1, half, rb, cb, l16, lq, q1); pb_load(X, bh, 2, half, rb, cb, l16, lq, q2);
    for (int c = 0; c < 63; c += 3) {
        pb_step(X, Ss, bh, c, half, rb, cb, l16, lq, q0, store); if (c + 3 < 63) pb_load(X, bh, c + 3, half, rb, cb, l16, lq, q0);
        pb_step(X, Ss, bh, c + 1, half, rb, cb, l16, lq, q1, store); if (c + 4 < 63) pb_load(X, bh, c + 4, half, rb, cb, l16, lq, q1);
        pb_step(X, Ss, bh, c + 2, half, rb, cb, l16, lq, q2, store); if (c + 5 < 63) pb_load(X, bh, c + 5, half, rb, cb, l16, lq, q2);
    }
}

__device__ __forceinline__ void phase_final(tab_t tab, int lane, int wave) {
    asm volatile("" : "+v"(lane));
    float* out = OUTP(); const float* g = INP(26);
    const int gw = blockIdx.x * NWAVES + wave, NGW = gridDim.x * NWAVES;
    f32x4 gv[4];
#pragma unroll
    for (int j = 0; j < 4; ++j) gv[j] = ((const f32x4*)g)[lane + 64 * j];
    for (int m = gw; m < M; m += NGW) {
        f32x4* xr = (f32x4*)(out + (size_t)m * D) + lane; f32x4 v[4]; float s = 0.f;
#pragma unroll
        for (int j = 0; j < 4; ++j) { v[j] = xr[64 * j]; s += (v[j][0] * v[j][0] + v[j][1] * v[j][1]) + (v[j][2] * v[j][2] + v[j][3] * v[j][3]); }
        const float rs = rsqrtf(wave_sum(s) * (1.0f / D) + 1e-6f);
#pragma unroll
        for (int j = 0; j < 4; ++j) xr[64 * j] = v[j] * rs * gv[j];
    }
}

#define RLX_AGENT __ATOMIC_RELAXED, __HIP_MEMORY_SCOPE_AGENT
#define XB_TMO      128
#define XB_XCNT(j)  (256  + 64 * (j))
#define XB_XSUB(j)  (1280 + 64 * (j))
#define XB_XGEN(j)  (2304 + 64 * (j))
#define XB_TOP      3328
#define XB_TOPGEN   3392
#define XCD_BAR_WORDS 3456
#define XB_SPIN_CAP (1u << 18)

__device__ __forceinline__ unsigned xb_ld(unsigned* p)              { return __hip_atomic_load(p, __ATOMIC_RELAXED, __HIP_MEMORY_SCOPE_AGENT); }
__device__ __forceinline__ unsigned xb_add(unsigned* p, unsigned v) { return __hip_atomic_fetch_add(p, v, __ATOMIC_RELAXED, __HIP_MEMORY_SCOPE_AGENT); }
__device__ __forceinline__ unsigned xb_xcc_id() { return (unsigned)__builtin_amdgcn_s_getreg((3 << 11) | 20) & 0xFu; }
#define XB_SPIN(cond, bar) do { unsigned _sp = 0; while (cond) { __builtin_amdgcn_s_sleep(1); \
    if ((++_sp & 255u) == 0u) { if (xb_ld(&(bar)[XB_TMO])) break; if (_sp > XB_SPIN_CAP) { atomicAdd(&(bar)[XB_TMO], 1u); break; } } } } while (0)

struct XcdBarrier {
    unsigned* bar; unsigned x;
    volatile LAS unsigned* st;
};

__device__ __forceinline__ XcdBarrier xcd_barrier_post(unsigned* bar, volatile LAS unsigned* st) {
    XcdBarrier b; b.bar = bar; b.x = xb_xcc_id(); b.st = st;
    if (threadIdx.x == 0) (void)xb_add(&bar[XB_XCNT(b.x)], 1u);
    return b;
}
__device__ __forceinline__ void xcd_barrier_complete(unsigned* bar, unsigned x, unsigned& nloc, unsigned& nx) {
    const unsigned G = gridDim.x * gridDim.y * gridDim.z;
    unsigned sum, cnt, mine, sp = 0u;
    for (;;) {
        sum = 0u; cnt = 0u; mine = 0u;
#pragma unroll
        for (unsigned j = 0; j < 16; ++j) { const unsigned c = xb_ld(&bar[XB_XCNT(j)]); sum += c; cnt += (c > 0u) ? 1u : 0u; mine = (j == x) ? c : mine; }
        if (sum == G) break;
        __builtin_amdgcn_s_sleep(1);
        if ((++sp & 255u) == 0u) { if (xb_ld(&bar[XB_TMO])) break; if (sp > XB_SPIN_CAP) { atomicAdd(&bar[XB_TMO], 1u); break; } }
    }
    nloc = mine > 0u ? mine : 1u; nx = cnt > 0u ? cnt : 1u;
}

__device__ __forceinline__ void xcd_barrier(const XcdBarrier& b) {
    asm volatile("s_waitcnt vmcnt(0)" ::: "memory");
    __syncthreads();
    if (threadIdx.x == 0) {
        unsigned* bar = b.bar;
        __builtin_amdgcn_s_waitcnt(0);
        unsigned nloc = b.st[0], nx = b.st[1];
        if (nloc == 0u) { xcd_barrier_complete(bar, b.x, nloc, nx); b.st[0] = nloc; b.st[1] = nx; }
        const unsigned old = xb_add(&bar[XB_XSUB(b.x)], 1u);
        const unsigned gen = old / nloc;
        if (old + 1u == (gen + 1u) * nloc) {
            __builtin_amdgcn_fence(__ATOMIC_RELEASE, "agent");
            asm volatile("s_waitcnt vmcnt(0)" ::: "memory");
            const unsigned og = xb_add(&bar[XB_TOP], 1u);
            const unsigned tg = og / nx;
            if (og + 1u == (tg + 1u) * nx) xb_add(&bar[XB_TOPGEN], 1u);
            else XB_SPIN(xb_ld(&bar[XB_TOPGEN]) == tg, bar);
            __builtin_amdgcn_fence(__ATOMIC_ACQUIRE, "agent");
            xb_add(&bar[XB_XGEN(b.x)], 1u);
            asm volatile("s_waitcnt vmcnt(0)" ::: "memory");
        } else {
            XB_SPIN(xb_ld(&bar[XB_XGEN(b.x)]) == gen, bar);
            __builtin_amdgcn_fence(__ATOMIC_ACQUIRE, "agent");
            asm volatile("s_waitcnt vmcnt(0)" ::: "memory");
        }
    }
    __syncthreads();
}

__device__ __forceinline__ ScanCtx make_scan_ctx(tab_t tab) {
    unsigned char* ws = WSP();
    ScanCtx X; X.PB = (const bf16*)(ws + WS_PB); X.LOGW = (const bf16*)(ws + WS_LOGW); X.ICLR = (const bf16*)(ws + WS_ICLR); X.GG = (const bf16*)(ws + WS_GG); X.ZB = (bf16*)(ws + WS_ZB);
    X.PC = (float*)(ws + WS_PC); X.NS = (float*)(ws + WS_NS); X.mu = INP(9); X.k_k = INP(15); X.k_a = INP(16); X.r_k = INP(17); X.lnw = INP(18); X.lnb = INP(19);
    return X;
}
__global__ void __launch_bounds__(NWAVES * 64, 2) fwd(Args a) {
    extern __shared__ __attribute__((aligned(16))) unsigned char lds_raw[];
    LAS unsigned char* lds = (LAS unsigned char*)lds_raw;
    const int tid = threadIdx.x, lane = tid & 63, wave = __builtin_amdgcn_readfirstlane(tid >> 6);
    const int G = gridDim.x;
    { LAS unsigned long long* tw = (LAS unsigned long long*)(lds + TAB_OFF);
      if (tid == 0) {
#pragma unroll
          for (int i = 0; i < 27; ++i) tw[i] = (unsigned long long)a.in[i];
          tw[27] = (unsigned long long)a.out; tw[28] = (unsigned long long)a.ws; }
      if (tid < 2) ((LAS unsigned*)(lds + MISC_OFF))[tid] = 0u;
      __syncthreads(); }
    (void)xcd_barrier_post((unsigned*)a.ws + CW_BAR, (volatile LAS unsigned*)(lds + MISC_OFF));
    const tab_t tab = (tab_t)(lds + TAB_OFF);
    const int ph_lo = a.ph_lo, ph_hi = a.ph_hi;

    for (int p = ph_lo; p < ph_hi; ++p) {
      for (int rep = 0; rep <= ((PROBE_REPMASK >> p) & 1); ++rep) {
        pg8::Gemm g{nullptr, nullptr, M, 0, 0}; bool isg = false;
        switch (p) {
        case 0: phase_prologue(tab, lds, tid, lane, wave); break;
        case 4: phase_prep(tab, tid); break;
        case 6: { const ScanCtx X = make_scan_ctx(tab); LAS float* wl = (LAS float*)lds + wave * SCAN_WAVE_FLOATS;
                  for (int task = wave * G + (int)blockIdx.x; task < 2048; task += NWAVES * G) { if (task < 1024) scan_task<0>(X, task, wl, lane); else scan_task<1>(X, task - 1024, wl, lane); } } break;
        case 7: if (blockIdx.x < 32) { const ScanCtx X = make_scan_ctx(tab); for (int dr = PROBE_PBDRY; dr >= 0; --dr) { scan_pass_b(X, lds, (int)blockIdx.x, tid, lane, wave, dr == 0); __syncthreads(); } } break;
        case 8: { const ScanCtx X = make_scan_ctx(tab); LAS float* wl = (LAS float*)lds + wave * SCAN_WAVE_FLOATS;
                  for (int task = wave * G + (int)blockIdx.x; task < 1024; task += NWAVES * G) scan_task<2>(X, task, wl, lane); } break;
        case 15: phase_final(tab, lane, wave); break;
        default: {
            unsigned char* ws = WSP(); isg = true;
            const size_t aoff = (p == 2 || p == 14) ? WS_HID : (p == 5) ? WS_LIN : (p == 10) ? WS_ZA : (p == 11) ? WS_ZB : (p == 12) ? WS_MRG : WS_XB;
            const size_t boff = (p == 1) ? WS_W1GU : (p == 2) ? WS_W1D : (p == 3) ? WS_WIN : (p == 5) ? WS_WL : (p == 9) ? (WS_WIN + (size_t)3328 * D * 2) : (p == 10) ? WS_WOA : (p == 11) ? WS_WOB : (p == 12) ? WS_WO : (p == 13) ? WS_W2GU : WS_W2D;
            const int N = (p == 1 || p == 13) ? 2 * FF : (p == 3) ? 3328 : (p == 5) ? 1536 : (p == 9) ? 2048 : D;
            const int K = (p == 2 || p == 14) ? FF : (p == 5) ? 256 : (p == 10 || p == 11) ? 512 : D;
            g = pg8::Gemm{(const bf16*)(ws + aoff), (const bf16*)(ws + boff), M, N, K}; } break;
        }
        if (isg) { pg8::Epi E{p, tab}; pg8::StaticOrder S; S.init(M, g.N, G, (int)blockIdx.x); pg8::gemm_phase<pg8::Epi, pg8::StaticOrder, true, true>(lds, g, S, E); }
      }
        if (p + 1 < ph_hi) { for (int sr = 0; sr < PROBE_SYNCREP; ++sr) {
            if (ph_hi > NPH) { __syncthreads(); cg::this_grid().sync(); }
            else { XcdBarrier bar; bar.bar = (unsigned*)WSP() + CW_BAR; bar.x = xb_xcc_id(); bar.st = (volatile LAS unsigned*)(lds + MISC_OFF); xcd_barrier(bar); } } }
    }
}

extern "C" void kernel_launch(void* const* d_in, const int* in_sizes, int n_in, void* d_out, int out_size, void* d_ws, size_t ws_size, hipStream_t stream) {
    static int grid = 0;
    if (grid == 0) {
        if (n_in != 27 || in_sizes[0] != M * D || out_size != M * D || ws_size < WS_END) { fprintf(stderr, "kernel_launch: unexpected shapes (n_in %d, in0 %d, out %d, ws %zu)\n", n_in, n_in > 0 ? in_sizes[0] : -1, out_size, ws_size); grid = -1; return; }
        int dev = 0, cus = 0, per_cu = 0;
        if (hipGetDevice(&dev) != hipSuccess || hipDeviceGetAttribute(&cus, hipDeviceAttributeMultiprocessorCount, dev) != hipSuccess) { grid = -1; return; }
        if (hipFuncSetAttribute((const void*)fwd, hipFuncAttributeMaxDynamicSharedMemorySize, LDS_BYTES) != hipSuccess) { fprintf(stderr, "kernel_launch: hipFuncSetAttribute failed\n"); grid = -1; return; }
        if (hipOccupancyMaxActiveBlocksPerMultiprocessor(&per_cu, (const void*)fwd, NWAVES * 64, LDS_BYTES) != hipSuccess || per_cu < 1) { fprintf(stderr, "kernel_launch: occupancy query says %d blocks per CU\n", per_cu); per_cu = 1; }
        (void)hipGetLastError();
        grid = cus * 1;
    }
    if (grid < 0) return;
    if (hipMemsetAsync(d_ws, 0, CTL_ZERO_BYTES, stream) != hipSuccess) { fprintf(stderr, "kernel_launch: hipMemsetAsync failed\n"); return; }
    Args a{};
    for (int i = 0; i < 27; ++i) a.in[i] = (const float*)d_in[i];
    a.out = (float*)d_out; a.ws = (unsigned char*)d_ws;
#if MK_PER_PHASE
    for (int p = 0; p < NPH; ++p) { a.ph_lo = p; a.ph_hi = p + 1; hipLaunchKernelGGL(fwd, dim3(grid), dim3(NWAVES * 64), LDS_BYTES, stream, a); }
#else
    a.ph_lo = 0; a.ph_hi = NPH;
    void* args[] = {&a};
    hipError_t e = hipLaunchCooperativeKernel((const void*)fwd, dim3(grid), dim3(NWAVES * 64), args, LDS_BYTES, stream);
    if (e != hipSuccess) fprintf(stderr, "kernel_launch: cooperative launch failed: %s (grid %d)\n", hipGetErrorString(e), grid);
#endif
}
```

```cpp
#include <hip/hip_runtime.h>
#include <hip/hip_cooperative_groups.h>
#include <cstdio>
#include <cstdint>
namespace cg = cooperative_groups;

#ifndef MK_PER_PHASE
#define MK_PER_PHASE 0
#endif
#ifndef PROBE_REPMASK
#define PROBE_REPMASK 0
#endif
#define PROBE_SYNCREP 1
#define PROBE_PBDRY 0
constexpr int NWAVES = 8;
constexpr int T = 8192, D = 1024, M = 16384, FF = 2816, NPH = 16;
constexpr size_t MiB = 1u << 20;
constexpr size_t WS_W1GU = 1 * MiB, WS_W1D = 12 * MiB, WS_W2GU = 17 * MiB + MiB / 2, WS_W2D = 28 * MiB + MiB / 2, WS_WIN = 34 * MiB, WS_WOA = 44 * MiB + MiB / 2,
                 WS_WOB = 45 * MiB + MiB / 2, WS_WO = 46 * MiB + MiB / 2, WS_WL = 48 * MiB + MiB / 2;
constexpr size_t WS_XB = 50 * MiB, WS_SSQ0 = 82 * MiB, WS_SSQ1 = 83 * MiB, WS_SSQ2 = 84 * MiB, WS_R = 85 * MiB;
constexpr size_t WS_HID = WS_R, WS_PA = WS_R, WS_PB = WS_R + 48 * MiB, WS_ZA = WS_R + 104 * MiB, WS_LIN = WS_R + 120 * MiB, WS_NS = WS_R + 128 * MiB, WS_ZB = WS_R + 144 * MiB;
constexpr size_t WS_LOGW = WS_R, WS_ICLR = WS_R + 16 * MiB, WS_GG = WS_R + 32 * MiB;
constexpr size_t WS_PC = WS_W1GU;
constexpr size_t WS_SG = WS_R, WS_MRG = WS_R + 64 * MiB;
constexpr size_t WS_END = WS_R + 160 * MiB;
static_assert(WS_END <= 256 * MiB, "workspace map");
constexpr int CW_BAR = 4096; constexpr size_t CTL_ZERO_BYTES = 65536;
constexpr int MISC_OFF = 131072 + 512;
constexpr int LDS_BYTES = 147456;
constexpr int SCAN_WAVE_FLOATS = 3712;

#define LAS __attribute__((address_space(3)))
typedef unsigned short bf16;
typedef unsigned v4u __attribute__((ext_vector_type(4)));
typedef float f32x4 __attribute__((ext_vector_type(4)));
typedef float f32x16 __attribute__((ext_vector_type(16)));
#define LDS_WAIT() asm volatile("s_waitcnt lgkmcnt(0)" ::: "memory")
__device__ __forceinline__ unsigned f2bf(float f) { unsigned u = __builtin_bit_cast(unsigned, f); return (u + 0x7fffu + ((u >> 16) & 1u)) >> 16; }
__device__ __forceinline__ unsigned pk2(float lo, float hi) { return f2bf(lo) | (f2bf(hi) << 16); }
__device__ __forceinline__ float bf2f(bf16 h) { return __uint_as_float((unsigned)h << 16); }
__device__ __forceinline__ float wave_sum(float v) {
#pragma unroll
    for (int o = 1; o < 64; o <<= 1) v += __shfl_xor(v, o);
    return v;
}
__device__ __forceinline__ float dppf(float x, int ctrl_is_xor2) {
    const int xi = __builtin_bit_cast(int, x);
    const int r = ctrl_is_xor2 ? __builtin_amdgcn_update_dpp(xi, xi, 0x4E, 0xF, 0xF, false) : __builtin_amdgcn_update_dpp(xi, xi, 0xB1, 0xF, 0xF, false);
    return __builtin_bit_cast(float, r);
}
__device__ __forceinline__ float quad_sum(float x) { x += dppf(x, 0); x += dppf(x, 1); return x; }
__device__ __forceinline__ float sigmf(float x) { return __builtin_amdgcn_rcpf(1.0f + __expf(-x)); }
__device__ __forceinline__ float tanhf_(float x) { return 1.0f - 2.0f * __builtin_amdgcn_rcpf(1.0f + __expf(2.0f * x)); }

constexpr int TAB_OFF = 131072 + 1024;
typedef LAS const unsigned long long* tab_t;
__device__ __forceinline__ unsigned long long ldptr_(tab_t tab, int i) {
    const unsigned long long v = tab[i];
    const unsigned lo = __builtin_amdgcn_readfirstlane((unsigned)v), hi = __builtin_amdgcn_readfirstlane((unsigned)(v >> 32));
    return ((unsigned long long)hi << 32) | lo;
}
#define INP(i) ((const float*)ldptr_(tab, (i)))
#define OUTP() ((float*)ldptr_(tab, 27))
#define WSP() ((unsigned char*)ldptr_(tab, 28))
namespace pg8 {
#define PG8_LAS __attribute__((address_space(3)))
typedef unsigned short bf16_t;
typedef short bf16x8 __attribute__((ext_vector_type(8)));
typedef float f32x4 __attribute__((ext_vector_type(4)));
typedef unsigned u32x4 __attribute__((ext_vector_type(4)));
constexpr int BM = 256, BK = 64, HALF = 128, HTB = HALF * BK * 2  , STAGE_BYTES = 8 * HTB, NXCD = 8, WGM = 8;

__host__ __device__ __forceinline__ int lds_byte(int r, int c) { const int st = (r >> 4) * 2 + (c >> 5), rr = r & 15, cc = c & 31, ob = rr * 64 + cc * 2; return st * 1024 + (ob ^ (((ob >> 9) & 1) << 5)); }
__host__ __device__ __forceinline__ void stage_rc(int b, int& R, int& C) { const int st = b / 1024, sb = b % 1024, swz = sb ^ (((sb >> 9) & 1) << 5); R = (st >> 1) * 16 + swz / 64; C = (st & 1) * 32 + (swz % 64) / 2; }
__host__ __device__ __forceinline__ int perm32(int rho) { const int n = rho >> 4, i = rho & 15; return 8 * (i >> 2) + 4 * n + (i & 3); }

struct Unit { int pm, pn; };
struct Gemm { const bf16_t* A; const bf16_t* Bt; int M, N, K; };

struct StaticOrder {
    int nM, nN, nwg, G, c;
    __host__ __device__ void init(int M, int N, int G_, int c_) { nM = M / BM; nN = N / BM; nwg = nM * nN; G = G_; c = c_; }
    __host__ __device__ bool next(int i, Unit& u) const {
        const long L = (long)i * G + c; if (L >= nwg) return false;
        int wgid = (int)L; { const int q = nwg / NXCD, r = nwg % NXCD, xcd = wgid % NXCD, off = wgid / NXCD; wgid = (xcd < r ? xcd * (q + 1) : r * (q + 1) + (xcd - r) * q) + off; }
        const int nig = WGM * nN, gid = wgid / nig, fm = gid * WGM, gsz = (nM - fm) < WGM ? (nM - fm) : WGM;
        u.pm = fm + ((wgid % nig) % gsz); u.pn = (wgid % nig) / gsz; return true;
    }
    __device__ __forceinline__ void a_ready(const Unit&) const {}
    __device__ __forceinline__ void done(const Unit&) const {}
};
__device__ __forceinline__ unsigned cvt_pk_bf16(float lo, float hi) { unsigned r; asm volatile("v_cvt_pk_bf16_f32 %0, %1, %2" : "=v"(r) : "v"(lo), "v"(hi)); return r; }
__device__ __forceinline__ float sigm(float x) { return __builtin_amdgcn_rcpf(1.0f + __expf(-x)); }
__device__ __forceinline__ void store8(bf16_t* p, f32x4 a, f32x4 b) {
    u32x4 w; w.x = cvt_pk_bf16(a[0], a[1]); w.y = cvt_pk_bf16(a[2], a[3]); w.z = cvt_pk_bf16(b[0], b[1]); w.w = cvt_pk_bf16(b[2], b[3]);
    *(u32x4*)p = w;
}
__device__ __forceinline__ void load8(const bf16_t* p, f32x4& a, f32x4& b) {
    const u32x4 w = *(const u32x4*)p;
    a[0] = __uint_as_float(w.x << 16); a[1] = __uint_as_float(w.x & 0xffff0000u); a[2] = __uint_as_float(w.y << 16); a[3] = __uint_as_float(w.y & 0xffff0000u);
    b[0] = __uint_as_float(w.z << 16); b[1] = __uint_as_float(w.z & 0xffff0000u); b[2] = __uint_as_float(w.w << 16); b[3] = __uint_as_float(w.w & 0xffff0000u);
}
enum { EM_SWIGLU = 0, EM_RESID = 1, EM_PAB = 2, EM_LORA = 3, EM_GATES = 4, EM_MERGE1 = 5, EM_MERGE2 = 6 };
struct Epi {
    static constexpr bool PERM = true, AFTER_DRAIN = false;
    int p; tab_t tab;
    __device__ __forceinline__ void operator()(const f32x4 (&acc)[2][2][4][2], const Unit& u, int wr, int wc, int fr, int fq) const {
        unsigned char* ws = WSP();
        const int mode = (p == 1 || p == 13) ? EM_SWIGLU : (p == 2 || p == 12 || p == 14) ? EM_RESID : (p == 3) ? EM_PAB : (p == 5) ? EM_LORA : (p == 9) ? EM_GATES : (p == 10) ? EM_MERGE1 : EM_MERGE2;
        const float* ssq = (const float*)(ws + (p == 1 ? WS_SSQ0 : (p == 13 ? WS_SSQ2 : WS_SSQ1)));
        bf16_t* o0 = nullptr; bf16_t* o1 = nullptr; bf16_t* o2 = nullptr; const float* base = nullptr; float* outf = nullptr; float* ssq_out = nullptr; float scale = 1.f;
        const bf16_t* sg = (const bf16_t*)(ws + WS_SG); const float* q0 = nullptr; const float* q1 = nullptr;
        if (mode == EM_SWIGLU) o0 = (bf16_t*)(ws + WS_HID);
        else if (mode == EM_RESID) { outf = OUTP(); base = (p == 2) ? INP(0) : (const float*)outf; o0 = (p == 14) ? nullptr : (bf16_t*)(ws + WS_XB);
                                     ssq_out = (p == 14) ? nullptr : (float*)(ws + (p == 2 ? WS_SSQ1 : WS_SSQ2)); scale = (p == 12) ? 1.0f : 0.5f; }
        else if (mode == EM_PAB) { o0 = (bf16_t*)(ws + WS_PA); o1 = (bf16_t*)(ws + WS_PB); }
        else if (mode == EM_LORA) { o0 = (bf16_t*)(ws + WS_LOGW); o1 = (bf16_t*)(ws + WS_ICLR); o2 = (bf16_t*)(ws + WS_GG); q0 = INP(10); q1 = INP(12); }
        else if (mode == EM_GATES) o0 = (bf16_t*)(ws + WS_SG);
        else o0 = (bf16_t*)(ws + WS_MRG);
        const int rowb = u.pm * BM + wr * 64 + fr;
        const int cw = wc * 32 + 8 * fq;
#pragma unroll
        for (int ai = 0; ai < 2; ++ai)
#pragma unroll
            for (int m = 0; m < 4; ++m) {
                const size_t row = (size_t)(rowb + ai * HALF + m * 16);
                float s = 1.f;
                if (mode == EM_SWIGLU || mode == EM_PAB || mode == EM_GATES) {
                    const f32x4* q = (const f32x4*)(ssq + row * 16);
                    const f32x4 a = q[0], b = q[1], c = q[2], d = q[3];
                    const f32x4 t = (a + b) + (c + d);
                    s = rsqrtf(((t[0] + t[1]) + (t[2] + t[3])) * (1.0f / 1024.0f) + 1e-6f);
                }
                if (mode == EM_SWIGLU) {
                    f32x4 h0, h1;
#pragma unroll
                    for (int j = 0; j < 4; ++j) {
                        const float g0 = acc[ai][0][m][0][j] * s, u0 = acc[ai][1][m][0][j] * s;
                        const float g1 = acc[ai][0][m][1][j] * s, u1 = acc[ai][1][m][1][j] * s;
                        h0[j] = g0 * sigm(g0) * u0; h1[j] = g1 * sigm(g1) * u1;
                    }
                    store8(o0 + row * 2816 + u.pn * 128 + cw, h0, h1);
                } else if (mode == EM_RESID) {
                    float part = 0.f;
#pragma unroll
                    for (int bj = 0; bj < 2; ++bj) {
                        const size_t off = row * 1024 + u.pn * 256 + bj * HALF + cw;
                        const f32x4 b0 = *(const f32x4*)(base + off), b1 = *(const f32x4*)(base + off + 4);
                        const f32x4 v0 = b0 + acc[ai][bj][m][0] * scale, v1 = b1 + acc[ai][bj][m][1] * scale;
                        *(f32x4*)(outf + off) = v0; *(f32x4*)(outf + off + 4) = v1;
                        if (o0) store8(o0 + off, v0, v1);
                        part += (v0[0] * v0[0] + v0[1] * v0[1]) + (v0[2] * v0[2] + v0[3] * v0[3]) + (v1[0] * v1[0] + v1[1] * v1[1]) + (v1[2] * v1[2] + v1[3] * v1[3]);
                    }
                    if (ssq_out) { part += __shfl_xor(part, 16); part += __shfl_xor(part, 32); if (fq == 0) ssq_out[row * 16 + u.pn * 4 + wc] = part; }
                } else {
#pragma unroll
                    for (int bj = 0; bj < 2; ++bj) {
                        const int col = u.pn * 256 + bj * HALF + cw;
                        f32x4 v0 = acc[ai][bj][m][0], v1 = acc[ai][bj][m][1];
                        if (mode == EM_PAB) {
                            v0 = v0 * s; v1 = v1 * s;
                            if (u.pn < 6) store8(o0 + row * 1536 + col, v0, v1); else store8(o1 + row * 1792 + (col - 1536), v0, v1);
                        } else if (mode == EM_LORA) {
                            const int sel = u.pn >> 1, c = col & 511;
                            if (sel == 0) {
                                const f32x4 p0 = *(const f32x4*)(q0 + c), p1 = *(const f32x4*)(q0 + c + 4);
#pragma unroll
                                for (int j = 0; j < 4; ++j) { v0[j] = -0.6065306597f * sigm(p0[j] + v0[j]); v1[j] = -0.6065306597f * sigm(p1[j] + v1[j]); }
                                store8(o0 + row * 512 + c, v0, v1);
                            } else if (sel == 1) {
                                const f32x4 p0 = *(const f32x4*)(q1 + c), p1 = *(const f32x4*)(q1 + c + 4);
#pragma unroll
                                for (int j = 0; j < 4; ++j) { v0[j] = sigm(p0[j] + v0[j]); v1[j] = sigm(p1[j] + v1[j]); }
                                store8(o1 + row * 512 + c, v0, v1);
                            } else store8(o2 + row * 512 + c, v0, v1);
                        } else if (mode == EM_GATES) {
#pragma unroll
                            for (int j = 0; j < 4; ++j) { v0[j] = sigm(v0[j] * s); v1[j] = sigm(v1[j] * s); }
                            store8(o0 + row * 2048 + col, v0, v1);
                        } else if (mode == EM_MERGE1) {
                            f32x4 g0, g1; load8(sg + row * 2048 + col, g0, g1);
                            store8(o0 + row * 1024 + col, g0 * v0, g1 * v1);
                        } else {
                            f32x4 g0, g1, m0, m1; load8(sg + row * 2048 + 1024 + col, g0, g1); load8(o0 + row * 1024 + col, m0, m1);
                            store8(o0 + row * 1024 + col, m0 + g0 * v0, m1 + g1 * v1);
                        }
                    }
                }
            }
    }
};

template <class Epi, class Sched, bool ALIGN_EPI = false, bool SP2 = false>
__device__ __forceinline__ void gemm_phase(PG8_LAS unsigned char* lds, const Gemm g, const Sched& S, const Epi& E) {
    const int tid = threadIdx.x, wid = __builtin_amdgcn_readfirstlane(tid >> 6), lane = tid & 63, wr = wid >> 2, wc = wid & 3, fr = lane & 15, fq = lane >> 4;
    const int K = g.K, nt = K / BK;
    unsigned voffA[2], voffB[2];
#pragma unroll
    for (int i = 0; i < 2; ++i) { int R, C; stage_rc(tid * 16 + i * 8192, R, C); const int Rb = Epi::PERM ? ((R & ~31) + perm32(R & 31)) : R;
        voffA[i] = (unsigned)(R * K + C) * 2u; voffB[i] = (unsigned)(Rb * K + C) * 2u; }
    const size_t kstep = (size_t)(BK * 2);
    const size_t hstep = (size_t)HALF * K * 2;
    const size_t tstep = 2 * hstep;
    const unsigned ldsw = (unsigned)wid * 1024u;
    const int aoff = lds_byte(wr * 64 + fr, fq * 8), boff = lds_byte(wc * 32 + fr, fq * 8);
#define PG8_SA(b, h) (((b) * 2 + (h)) * HTB)
#define PG8_SB(b, h) ((4 + (b) * 2 + (h)) * HTB)
#define PG8_STAGE(bufoff, gbase, voff) do { _Pragma("unroll") for (int _i = 0; _i < 2; ++_i) \
        __builtin_amdgcn_global_load_lds((const unsigned*)((const char*)(gbase) + (voff)[_i]), (PG8_LAS unsigned*)(lds + (bufoff) + ldsw + _i * 8192), 16, 0, 0); } while (0)
#define PG8_LDA(dst, b, h) do { _Pragma("unroll") for (int m = 0; m < 4; ++m) _Pragma("unroll") for (int k = 0; k < 2; ++k) dst[m][k] = *(const PG8_LAS bf16x8*)(lds + PG8_SA(b, h) + aoff + m * 2048 + k * 1024); } while (0)
#define PG8_LDB(dst, b, h) do { _Pragma("unroll") for (int n = 0; n < 2; ++n) _Pragma("unroll") for (int k = 0; k < 2; ++k) dst[n][k] = *(const PG8_LAS bf16x8*)(lds + PG8_SB(b, h) + boff + n * 2048 + k * 1024); } while (0)
#define PG8_MMA(ai, bj, At, Bt) do { __builtin_amdgcn_s_setprio(1); _Pragma("unroll") for (int m = 0; m < 4; ++m) _Pragma("unroll") for (int n = 0; n < 2; ++n) _Pragma("unroll") for (int k = 0; k < 2; ++k) \
        acc[ai][bj][m][n] = __builtin_amdgcn_mfma_f32_16x16x32_bf16(Bt[n][k], At[m][k], acc[ai][bj][m][n], 0, 0, 0); __builtin_amdgcn_s_setprio(0); } while (0)
#define PG8_WAIT_V(n) asm volatile("s_waitcnt vmcnt(" #n ")" ::: "memory")
#define PG8_WAIT_L(n) asm volatile("s_waitcnt lgkmcnt(" #n ")" ::: "memory")
#define PG8_BAR __builtin_amdgcn_s_barrier()
#define PG8_SCHED __builtin_amdgcn_sched_barrier(0)
    Unit cur, nxt; int ui = 0;
    if (!S.next(0, cur)) return;
    f32x4 acc[2][2][4][2];
#pragma unroll
    for (int a = 0; a < 2; ++a)
#pragma unroll
        for (int b = 0; b < 2; ++b)
#pragma unroll
            for (int m = 0; m < 4; ++m)
#pragma unroll
                for (int n = 0; n < 2; ++n) acc[a][b][m][n] = (f32x4){0.f, 0.f, 0.f, 0.f};
    bf16x8 At[4][2], B0[2][2], B1[2][2];
    const char* cA = (const char*)g.A + (size_t)cur.pm * tstep; const char* cB = (const char*)g.Bt + (size_t)cur.pn * tstep;
    S.a_ready(cur);
    if constexpr (SP2) {
        PG8_STAGE(PG8_SB(0, 0), cB, voffB); PG8_STAGE(PG8_SB(0, 1), cB + hstep, voffB); PG8_STAGE(PG8_SA(0, 0), cA, voffA); PG8_STAGE(PG8_SA(0, 1), cA + hstep, voffA);
        if (wr == 1) PG8_BAR;
        PG8_WAIT_V(2); PG8_BAR;
        PG8_STAGE(PG8_SB(1, 0), cB + kstep, voffB); PG8_STAGE(PG8_SA(1, 0), cA + kstep, voffA); PG8_STAGE(PG8_SB(1, 1), cB + hstep + kstep, voffB);
        PG8_WAIT_V(6); PG8_BAR;
    } else {
        PG8_STAGE(PG8_SB(0, 0), cB, voffB); PG8_STAGE(PG8_SA(0, 0), cA, voffA); PG8_STAGE(PG8_SB(0, 1), cB + hstep, voffB); PG8_STAGE(PG8_SA(0, 1), cA + hstep, voffA);
        if (wr == 1) PG8_BAR;
        PG8_WAIT_V(4); PG8_BAR;
        PG8_STAGE(PG8_SB(1, 0), cB + kstep, voffB); PG8_STAGE(PG8_SA(1, 0), cA + kstep, voffA); PG8_STAGE(PG8_SB(1, 1), cB + hstep + kstep, voffB);
        PG8_WAIT_V(6); PG8_BAR;
    }
    for (;;) {
        const bool has_next = S.next(ui + 1, nxt);
        const char* nA = has_next ? (const char*)g.A + (size_t)nxt.pm * tstep : cA; const char* nB = has_next ? (const char*)g.Bt + (size_t)nxt.pn * tstep : cB;
        for (int t = 0; t < nt; t += 2) {
            const bool last = (t == nt - 2);
            const char* a1 = cA + (size_t)(t + 1) * kstep;
            const char* a2 = last ? nA : cA + (size_t)(t + 2) * kstep; const char* b2 = last ? nB : cB + (size_t)(t + 2) * kstep;
            const char* a3 = a2 + kstep; const char* b3 = b2 + kstep;
            if (last && has_next) S.a_ready(nxt);
            if constexpr (SP2) {
            PG8_LDB(B0, 0, 0); PG8_LDB(B1, 0, 1); PG8_SCHED; PG8_LDA(At, 0, 0); PG8_STAGE(PG8_SA(1, 1), a1 + hstep, voffA);
            PG8_WAIT_V(8); PG8_WAIT_L(0); PG8_BAR; PG8_MMA(0, 0, At, B0); PG8_MMA(0, 1, At, B1); PG8_BAR; PG8_SCHED;
            PG8_LDA(At, 0, 1); PG8_STAGE(PG8_SB(0, 0), b2, voffB); PG8_STAGE(PG8_SB(0, 1), b2 + hstep, voffB); PG8_STAGE(PG8_SA(0, 0), a2, voffA);
            PG8_WAIT_V(8); PG8_WAIT_L(0); PG8_BAR; PG8_MMA(1, 0, At, B0); PG8_MMA(1, 1, At, B1); PG8_BAR; PG8_SCHED;
            PG8_LDB(B0, 1, 0); PG8_LDB(B1, 1, 1); PG8_SCHED; PG8_LDA(At, 1, 0); PG8_STAGE(PG8_SA(0, 1), a2 + hstep, voffA);
            PG8_WAIT_V(8); PG8_WAIT_L(0); PG8_BAR; PG8_MMA(0, 0, At, B0); PG8_MMA(0, 1, At, B1); PG8_BAR; PG8_SCHED;
            PG8_LDA(At, 1, 1); PG8_STAGE(PG8_SB(1, 0), b3, voffB); PG8_STAGE(PG8_SB(1, 1), b3 + hstep, voffB); PG8_STAGE(PG8_SA(1, 0), a3, voffA);
            PG8_WAIT_V(8); PG8_WAIT_L(0); PG8_BAR; PG8_MMA(1, 0, At, B0); PG8_MMA(1, 1, At, B1); PG8_BAR; PG8_SCHED;
            } else {
            PG8_LDB(B0, 0, 0); PG8_SCHED; PG8_LDA(At, 0, 0); PG8_STAGE(PG8_SA(1, 1), a1 + hstep, voffA);
            PG8_WAIT_L(8); PG8_BAR; PG8_WAIT_L(0); PG8_MMA(0, 0, At, B0); PG8_BAR; PG8_SCHED;
            PG8_LDB(B1, 0, 1); PG8_STAGE(PG8_SB(0, 0), b2, voffB);
            PG8_BAR; PG8_WAIT_L(0); PG8_MMA(0, 1, At, B1); PG8_BAR;
            PG8_LDA(At, 0, 1); PG8_STAGE(PG8_SA(0, 0), a2, voffA);
            PG8_BAR; PG8_WAIT_L(0); PG8_MMA(1, 0, At, B0); PG8_BAR; PG8_SCHED;
            PG8_STAGE(PG8_SB(0, 1), b2 + hstep, voffB);
            PG8_WAIT_V(6); PG8_BAR; PG8_MMA(1, 1, At, B1); PG8_BAR;
            PG8_LDB(B0, 1, 0); PG8_SCHED; PG8_LDA(At, 1, 0); PG8_STAGE(PG8_SA(0, 1), a2 + hstep, voffA);
            PG8_WAIT_L(8); PG8_BAR; PG8_WAIT_L(0); PG8_MMA(0, 0, At, B0); PG8_BAR; PG8_SCHED;
            PG8_LDB(B1, 1, 1); PG8_STAGE(PG8_SB(1, 0), b3, voffB);
            PG8_BAR; PG8_WAIT_L(0); PG8_MMA(0, 1, At, B1); PG8_BAR;
            PG8_LDA(At, 1, 1); PG8_STAGE(PG8_SA(1, 0), a3, voffA);
            PG8_BAR; PG8_WAIT_L(0); PG8_MMA(1, 0, At, B0); PG8_BAR; PG8_SCHED;
            PG8_STAGE(PG8_SB(1, 1), b3 + hstep, voffB);
            PG8_WAIT_V(6); PG8_BAR; PG8_MMA(1, 1, At, B1); PG8_BAR;
            }
        }
        if constexpr (ALIGN_EPI) { if (wr == 0) PG8_BAR; }
        if constexpr (!Epi::AFTER_DRAIN) { E(acc, cur, wr, wc, fr, fq); S.done(cur); }
        if (!has_next) break;
#pragma unroll
        for (int a = 0; a < 2; ++a)
#pragma unroll
            for (int b = 0; b < 2; ++b)
#pragma unroll
                for (int m = 0; m < 4; ++m)
#pragma unroll
                    for (int n = 0; n < 2; ++n) acc[a][b][m][n] = (f32x4){0.f, 0.f, 0.f, 0.f};
        cur = nxt; cA = nA; cB = nB; ++ui;
        if constexpr (ALIGN_EPI) { if (wr == 1) PG8_BAR; }
    }
    PG8_WAIT_V(0);
    if constexpr (!ALIGN_EPI) { if (wr == 0) PG8_BAR; }
    PG8_BAR;
    if constexpr (Epi::AFTER_DRAIN) { E.fused(acc, cur, wr, wc, fr, fq, lds, wid, lane); S.done(cur); }
#undef PG8_SA
#undef PG8_SB
#undef PG8_STAGE
#undef PG8_LDA
#undef PG8_LDB
#undef PG8_MMA
#undef PG8_WAIT_V
#undef PG8_WAIT_L
#undef PG8_BAR
#undef PG8_SCHED
}
}
struct Args { const float* in[27]; float* out; unsigned char* ws; int ph_lo, ph_hi; };

__device__ __forceinline__ void transpose_item(const float* W, int K, int N, bf16* WT, const float* gain, int il, LAS float* scr, int item, int lane) {
    const int nblk = N / 32, kb = item / nblk, nb = item % nblk, k0 = 64 * kb, n0 = 32 * nb;
#pragma unroll 8
    for (int i = 0; i < 32; ++i) { const int kk = 2 * i + (lane >> 5); float v = W[(size_t)(k0 + kk) * N + n0 + (lane & 31)]; if (gain) v *= gain[k0 + kk]; scr[kk * 33 + (lane & 31)] = v; }
    LDS_WAIT(); asm volatile("" ::: "memory");
    const int drow0 = il ? (((n0 >> 7) << 8) + (n0 & 127) + (il == 2 ? 128 : 0)) : n0;
    const int c = lane & 7;
#pragma unroll
    for (int j = 0; j < 4; ++j) { const int n = (lane >> 3) + 8 * j; const LAS float* s = scr + (8 * c) * 33 + n;
        v4u o; o.x = pk2(s[0 * 33], s[1 * 33]); o.y = pk2(s[2 * 33], s[3 * 33]); o.z = pk2(s[4 * 33], s[5 * 33]); o.w = pk2(s[6 * 33], s[7 * 33]);
        *(v4u*)(WT + (size_t)(drow0 + n) * K + k0 + 8 * c) = o; }
    LDS_WAIT(); asm volatile("" ::: "memory");
}
__device__ __forceinline__ void weights_set1(tab_t tab, LAS unsigned char* lds, int lane, int wave, int gw, int NGW) {
    asm volatile("" : "+v"(lane));
    unsigned char* ws = WSP();
    LAS float* scr = (LAS float*)(lds + wave * 16384);
    constexpr int I_GU = (D / 64) * (FF / 32), I_DN = (FF / 64) * (D / 32), I_OA = (512 / 64) * (D / 32), I_O = (D / 64) * (D / 32);
    constexpr int NITEMS = 2 * I_GU + I_DN + 2 * I_OA + I_O;
    for (int it = gw; it < NITEMS; it += NGW) {
        int r = it;
        if (r < I_GU) { transpose_item(INP(23), D, FF, (bf16*)(ws + WS_W2GU), INP(22), 1, scr, r, lane); continue; } r -= I_GU;
        if (r < I_GU) { transpose_item(INP(24), D, FF, (bf16*)(ws + WS_W2GU), INP(22), 2, scr, r, lane); continue; } r -= I_GU;
        if (r < I_DN) { transpose_item(INP(25), FF, D, (bf16*)(ws + WS_W2D), nullptr, 0, scr, r, lane); continue; } r -= I_DN;
        if (r < I_OA) { transpose_item(INP(8), 512, D, (bf16*)(ws + WS_WOA), nullptr, 0, scr, r, lane); continue; } r -= I_OA;
        if (r < I_OA) { transpose_item(INP(20), 512, D, (bf16*)(ws + WS_WOB), nullptr, 0, scr, r, lane); continue; } r -= I_OA;
        transpose_item(INP(21), D, D, (bf16*)(ws + WS_WO), nullptr, 0, scr, r, lane);
    }
}
__device__ __forceinline__ void phase_prologue(tab_t tab, LAS unsigned char* lds, int tid, int lane, int wave) {
    asm volatile("" : "+v"(lane), "+v"(tid));
    unsigned char* ws = WSP();
    LAS float* scr = (LAS float*)(lds + wave * 16384);
    const int G = gridDim.x, gw = blockIdx.x * NWAVES + wave, NGW = G * NWAVES;
    constexpr int I_GU = (D / 64) * (FF / 32), I_DN = (FF / 64) * (D / 32), I_IN = (D / 64) * (5376 / 32);
    constexpr int NITEMS = 2 * I_GU + I_DN + I_IN;
    for (int it = gw; it < NITEMS; it += NGW) {
        int r = it;
        if (r < I_GU) { transpose_item(INP(2), D, FF, (bf16*)(ws + WS_W1GU), INP(1), 1, scr, r, lane); continue; } r -= I_GU;
        if (r < I_GU) { transpose_item(INP(3), D, FF, (bf16*)(ws + WS_W1GU), INP(1), 2, scr, r, lane); continue; } r -= I_GU;
        if (r < I_DN) { transpose_item(INP(4), FF, D, (bf16*)(ws + WS_W1D), nullptr, 0, scr, r, lane); continue; } r -= I_DN;
        transpose_item(INP(6), D, 5376, (bf16*)(ws + WS_WIN), INP(5), 0, scr, r, lane);
    }
    { bf16* WL = (bf16*)(ws + WS_WL); const float* wdu = INP(11); const float* wiu = INP(13); const float* wgu = INP(14);
      for (int idx = blockIdx.x * 512 + tid; idx < 1536 * 256; idx += G * 512) {
          const int n = idx >> 8, kc = idx & 255; float v = 0.f;
          if (n < 512) { if (kc < 64) v = wdu[kc * 512 + n]; }
          else if (n < 1024) { if (kc >= 64 && kc < 128) v = wiu[(kc - 64) * 512 + (n - 512)]; }
          else { if (kc >= 128) v = wgu[(kc - 128) * 512 + (n - 1024)]; }
          WL[idx] = (bf16)f2bf(v); } }
    { const float* x = INP(0); bf16* xb = (bf16*)(ws + WS_XB); float* ssq0 = (float*)(ws + WS_SSQ0);
      for (int m = gw; m < M; m += NGW) {
          const f32x4* xr = (const f32x4*)(x + (size_t)m * D) + lane; f32x4 v[4]; float s = 0.f;
#pragma unroll
          for (int j = 0; j < 4; ++j) { v[j] = xr[64 * j]; s += (v[j][0] * v[j][0] + v[j][1] * v[j][1]) + (v[j][2] * v[j][2] + v[j][3] * v[j][3]); }
          s = wave_sum(s);
          unsigned long long* o8 = (unsigned long long*)(xb + (size_t)m * D) + lane;
#pragma unroll
          for (int j = 0; j < 4; ++j) o8[64 * j] = (unsigned long long)pk2(v[j][0], v[j][1]) | ((unsigned long long)pk2(v[j][2], v[j][3]) << 32);
          if (lane < 16) ssq0[(size_t)m * 16 + lane] = (lane == 0) ? s : 0.f;
      } }
}

__device__ __forceinline__ void ld8(const bf16* p, float (&v)[8]) {
    const v4u w = *(const v4u*)p;
    v[0] = __uint_as_float(w.x << 16); v[1] = __uint_as_float(w.x & 0xffff0000u); v[2] = __uint_as_float(w.y << 16); v[3] = __uint_as_float(w.y & 0xffff0000u);
    v[4] = __uint_as_float(w.z << 16); v[5] = __uint_as_float(w.z & 0xffff0000u); v[6] = __uint_as_float(w.w << 16); v[7] = __uint_as_float(w.w & 0xffff0000u);
}
__device__ __forceinline__ void st8(bf16* p, const float (&v)[8]) {
    v4u w; w.x = pk2(v[0], v[1]); w.y = pk2(v[2], v[3]); w.z = pk2(v[4], v[5]); w.w = pk2(v[6], v[7]); *(v4u*)p = w;
}
__device__ __forceinline__ void phase_prep(tab_t tab, int tid) {
    asm volatile("" : "+v"(tid));
    unsigned char* ws = WSP();
    const bf16* PA = (const bf16*)(ws + WS_PA); const bf16* PB = (const bf16*)(ws + WS_PB);
    bf16* ZA = (bf16*)(ws + WS_ZA); bf16* LIN = (bf16*)(ws + WS_LIN);
    const float* cw = INP(7); const float* mu = INP(9);
    const int gt = blockIdx.x * 512 + tid, NT = gridDim.x * 512;
    for (int it = gt; it < M * 64; it += NT) {
        const int m = it >> 6, c0 = (it & 63) * 8, t = m & (T - 1);
        float bb[8], c_[8], u_[8], acc[8], w0[8], w1[8], w2[8];
#pragma unroll
        for (int j = 0; j < 8; ++j) { w0[j] = cw[c0 + j]; w1[j] = cw[512 + c0 + j]; w2[j] = cw[1024 + c0 + j]; }
        const bf16* row = PA + (size_t)m * 1536;
        ld8(row + c0, bb); ld8(row + 512 + c0, c_); ld8(row + 1024 + c0, u_);
#pragma unroll
        for (int j = 0; j < 8; ++j) acc[j] = w2[j] * (c_[j] * u_[j]);
        if (t >= 1) { ld8(row - 1536 + 512 + c0, c_); ld8(row - 1536 + 1024 + c0, u_);
#pragma unroll
            for (int j = 0; j < 8; ++j) acc[j] += w1[j] * (c_[j] * u_[j]); }
        if (t >= 2) { ld8(row - 3072 + 512 + c0, c_); ld8(row - 3072 + 1024 + c0, u_);
#pragma unroll
            for (int j = 0; j < 8; ++j) acc[j] += w0[j] * (c_[j] * u_[j]); }
#pragma unroll
        for (int j = 0; j < 8; ++j) acc[j] *= bb[j];
        st8(ZA + (size_t)m * 512 + c0, acc);
    }
    for (int it = gt; it < M * 32; it += NT) {
        const int m = it >> 5, c0 = (it & 31) * 8, t = m & (T - 1);
        float x[8], xp[8];
        const bf16* row = PB + (size_t)m * 1792 + 1536 + c0;
        ld8(row, x);
        if (t >= 1) ld8(row - 1792, xp); else {
#pragma unroll
            for (int j = 0; j < 8; ++j) xp[j] = 0.f; }
#pragma unroll
        for (int j = 0; j < 8; ++j) { float v = x[j] + (xp[j] - x[j]) * mu[1536 + c0 + j]; x[j] = (c0 < 64) ? tanhf_(v) : ((c0 < 128) ? v : sigmf(v)); }
        st8(LIN + (size_t)m * 256 + c0, x);
    }
}

struct ScanCtx {
    const bf16* PB; const bf16* LOGW; const bf16* ICLR; const bf16* GG; bf16* ZB; float* PC; float* NS;
    const float* mu; const float* k_k; const float* k_a; const float* r_k; const float* lnw; const float* lnb;
};
template <int CTRL> __device__ __forceinline__ float dppx(float x) {
    const int xi = __builtin_bit_cast(int, x);
    return __builtin_bit_cast(float, __builtin_amdgcn_update_dpp(xi, xi, CTRL, 0xF, 0xF, false));
}
__device__ __forceinline__ float wave_sum_dpp(float v) {
    v += dppx<0xB1>(v); v += dppx<0x4E>(v); v += dppx<0x141>(v); v += dppx<0x140>(v);
    const int vi = __builtin_bit_cast(int, v);
    const float s0 = __builtin_bit_cast(float, __builtin_amdgcn_readlane(vi, 0)), s1 = __builtin_bit_cast(float, __builtin_amdgcn_readlane(vi, 16));
    const float s2 = __builtin_bit_cast(float, __builtin_amdgcn_readlane(vi, 32)), s3 = __builtin_bit_cast(float, __builtin_amdgcn_readlane(vi, 48));
    return (s0 + s1) + (s2 + s3);
}
typedef float f32x2 __attribute__((ext_vector_type(2)));
#define LBAR() do { asm volatile("s_waitcnt lgkmcnt(0)" ::: "memory"); __builtin_amdgcn_s_barrier(); asm volatile("" ::: "memory"); } while (0)
struct Raw4 { unsigned r[5], k[5], v[5], lw[4], ic[4]; };
__device__ __forceinline__ void load_raw4(const ScanCtx& X, int ms, bool prev_valid, int hc, Raw4& q) {
#pragma unroll
    for (int j = 0; j < 5; ++j) {
        const int m = (j == 0 && !prev_valid) ? ms : (ms - 1 + j);
        const bf16* row = X.PB + (size_t)m * 1792;
        q.r[j] = row[hc]; q.k[j] = row[512 + hc]; q.v[j] = row[1024 + hc];
    }
    if (!prev_valid) { q.r[0] = 0u; q.k[0] = 0u; q.v[0] = 0u; }
#pragma unroll
    for (int j = 0; j < 4; ++j) { q.lw[j] = X.LOGW[(size_t)(ms + j) * 512 + hc]; q.ic[j] = X.ICLR[(size_t)(ms + j) * 512 + hc]; }
}
template <int PASS, int MODE>
__device__ __forceinline__ void scan_pair(const ScanCtx& X, int cid, bool active, int role, LAS float* pl, int lane) {
    asm volatile("" : "+v"(lane));
    constexpr int R = (PASS == 0) ? 4 : 2;
    const int bh = cid >> 6, c = cid & 63, b = bh >> 3, h = bh & 7;
    const int m0 = b * T + c * 128;
    const int rg = lane >> 2, ks = lane & 3;
    const int hc = h * 64 + lane;
    const int row0 = (PASS == 0) ? rg * 4 : role * 32 + rg * 2;
    f32x2 S[R][8];
#pragma unroll
    for (int i = 0; i < R; ++i)
#pragma unroll
        for (int j = 0; j < 8; ++j) { S[i][j].x = (MODE == 0 && (row0 + i) == (ks * 16 + 2 * j)) ? 1.f : 0.f; S[i][j].y = (MODE == 0 && (row0 + i) == (ks * 16 + 2 * j + 1)) ? 1.f : 0.f; }
    if (MODE == 2 && c > 0 && active) {
        const float* src = X.NS + (size_t)(cid - 1) * 4096;
#pragma unroll
        for (int i = 0; i < R; ++i)
#pragma unroll
            for (int q = 0; q < 4; ++q) { const f32x4 v = *(const f32x4*)(src + (row0 + i) * 64 + ks * 16 + q * 4); S[i][2 * q] = (f32x2){v[0], v[1]}; S[i][2 * q + 1] = (f32x2){v[2], v[3]}; }
    }
    const float mu_r = X.mu[hc], mu_k = X.mu[512 + hc], mu_v = X.mu[1024 + hc];
    const float kk_c = X.k_k[hc], ka_c = X.k_a[hc], rk_c = X.r_k[hc], lnw = X.lnw[hc], lnb = X.lnb[hc];
    LAS float* LA = pl; LAS float* LW = pl + 512; LAS float* LB = pl + 1024; LAS float* LK = pl + 1536; LAS float* LR = pl + 2048; LAS float* LV = pl + 2560; LAS float* LY = pl + 3072; LAS float* LBon = pl + 3584;
    const int s0 = role * 4;
    Raw4 cur;
    if (active) load_raw4(X, m0 + s0, !(c == 0 && role == 0), hc, cur);
    for (int sub = 0; sub < 16; ++sub) {
        const int mb = m0 + sub * 8;
        unsigned gq[4];
        if (active) {
#pragma unroll
            for (int j = 0; j < 4; ++j) {
                const int s = s0 + j;
                const float rc = __uint_as_float(cur.r[j + 1] << 16), kc = __uint_as_float(cur.k[j + 1] << 16), vc = __uint_as_float(cur.v[j + 1] << 16);
                const float rp = __uint_as_float(cur.r[j] << 16), kp = __uint_as_float(cur.k[j] << 16), vp = __uint_as_float(cur.v[j] << 16);
                const float r = rc + (rp - rc) * mu_r, k = kc + (kp - kc) * mu_k, v = vc + (vp - vc) * mu_v;
                const float lw = __uint_as_float(cur.lw[j] << 16), ic = __uint_as_float(cur.ic[j] << 16);
                float kk = k * kk_c; const float n2 = wave_sum_dpp(kk * kk); kk = kk * rsqrtf(fmaxf(n2, 1e-24f));
                const float k2 = k * (1.0f + (ic - 1.0f) * ka_c);
                LA[s * 64 + lane] = -kk; LW[s * 64 + lane] = __expf(lw); LB[s * 64 + lane] = kk * ic; LK[s * 64 + lane] = k2; LV[s * 64 + lane] = v;
                if (MODE == 2) { LR[s * 64 + lane] = r; const float bon = wave_sum_dpp(r * k2 * rk_c); if (lane == 0) LBon[s] = bon; }
            }
            if (sub < 15) load_raw4(X, mb + 8 + s0, true, hc, cur);
            if (MODE == 2) {
#pragma unroll
                for (int j = 0; j < 4; ++j) gq[j] = X.GG[(size_t)(mb + s0 + j) * 512 + hc];
            }
        }
        LBAR();
        if (active) {
#pragma nounroll
            for (int s = 0; s < 8; ++s) {
                f32x2 a2[8], w2[8], b2[8], k2[8], r2[8]; float vv[R];
#pragma unroll
                for (int q = 0; q < 4; ++q) {
                    const f32x4 ta = *(const LAS f32x4*)(LA + s * 64 + ks * 16 + 4 * q), tw = *(const LAS f32x4*)(LW + s * 64 + ks * 16 + 4 * q), tb = *(const LAS f32x4*)(LB + s * 64 + ks * 16 + 4 * q);
                    a2[2 * q] = (f32x2){ta[0], ta[1]}; a2[2 * q + 1] = (f32x2){ta[2], ta[3]}; w2[2 * q] = (f32x2){tw[0], tw[1]}; w2[2 * q + 1] = (f32x2){tw[2], tw[3]}; b2[2 * q] = (f32x2){tb[0], tb[1]}; b2[2 * q + 1] = (f32x2){tb[2], tb[3]};
                }
                if (MODE >= 1) {
#pragma unroll
                    for (int q = 0; q < 4; ++q) { const f32x4 tk = *(const LAS f32x4*)(LK + s * 64 + ks * 16 + 4 * q); k2[2 * q] = (f32x2){tk[0], tk[1]}; k2[2 * q + 1] = (f32x2){tk[2], tk[3]}; }
                    if (R == 4) { const f32x4 t = *(const LAS f32x4*)(LV + s * 64 + row0); vv[0] = t[0]; vv[1] = t[1]; vv[R - 2] = t[2]; vv[R - 1] = t[3]; }
                    else { const f32x2 t = *(const LAS f32x2*)(LV + s * 64 + row0); vv[0] = t[0]; vv[1] = t[1]; }
                }
                if (MODE == 2) {
#pragma unroll
                    for (int q = 0; q < 4; ++q) { const f32x4 tr = *(const LAS f32x4*)(LR + s * 64 + ks * 16 + 4 * q); r2[2 * q] = (f32x2){tr[0], tr[1]}; r2[2 * q + 1] = (f32x2){tr[2], tr[3]}; }
                }
                float sa[R];
#pragma unroll
                for (int i = 0; i < R; ++i) {
                    f32x2 p0 = S[i][0] * a2[0], p1 = S[i][1] * a2[1];
#pragma unroll
                    for (int j = 2; j < 8; j += 2) { p0 = S[i][j] * a2[j] + p0; p1 = S[i][j + 1] * a2[j + 1] + p1; }
                    p0 = p0 + p1; sa[i] = quad_sum(p0.x + p0.y);
                }
#pragma unroll
                for (int i = 0; i < R; ++i) {
                    const f32x2 sa2 = (f32x2){sa[i], sa[i]};
#pragma unroll
                    for (int j = 0; j < 8; ++j) {
                        f32x2 t = sa2 * b2[j] + S[i][j] * w2[j];
                        if (MODE >= 1) { const f32x2 v2 = (f32x2){vv[i], vv[i]}; t = v2 * k2[j] + t; }
                        S[i][j] = t;
                    }
                }
                if (MODE == 2) {
                    f32x2 y;
#pragma unroll
                    for (int i = 0; i < R; ++i) {
                        f32x2 p0 = S[i][0] * r2[0], p1 = S[i][1] * r2[1];
#pragma unroll
                        for (int j = 2; j < 8; j += 2) { p0 = S[i][j] * r2[j] + p0; p1 = S[i][j + 1] * r2[j + 1] + p1; }
                        p0 = p0 + p1; y[i & 1] = quad_sum(p0.x + p0.y);
                    }
                    if (ks == 0) *(LAS f32x2*)(LY + s * 64 + row0) = y;
                }
            }
        }
        LBAR();
        if (MODE == 2) {
            if (active) {
#pragma unroll
                for (int j = 0; j < 4; ++j) {
                    const int s = s0 + j, m = mb + s;
                    const float y = LY[s * 64 + lane];
                    const float mean = wave_sum_dpp(y) * (1.0f / 64.0f); const float d = y - mean; const float var = wave_sum_dpp(d * d) * (1.0f / 64.0f);
                    float yn = d * rsqrtf(var + 64e-5f) * lnw + lnb;
                    yn += LBon[s] * LV[s * 64 + lane];
                    const float g = __uint_as_float(gq[j] << 16);
                    X.ZB[(size_t)m * 512 + hc] = (bf16)f2bf(yn * g);
                }
            }
            LBAR();
        }
    }
    if (MODE <= 1 && active) {
        float* dst = (MODE == 0 ? X.PC : X.NS) + (size_t)cid * 4096;
#pragma unroll
        for (int i = 0; i < R; ++i)
#pragma unroll
            for (int q = 0; q < 4; ++q) *(f32x4*)(dst + (row0 + i) * 64 + ks * 16 + q * 4) = (f32x4){S[i][2 * q].x, S[i][2 * q].y, S[i][2 * q + 1].x, S[i][2 * q + 1].y};
    }
}
struct PbBuf { float p[16]; float n[4]; };
__device__ __forceinline__ void pb_load(const ScanCtx& X, int bh, int c, int half, int rb, int cb, int l16, int lq, PbBuf& q) {
    const float* P = X.PC + (size_t)(bh * 64 + c) * 4096 + (16 * lq) * 64 + cb * 16 + l16; const float* N = X.NS + (size_t)(bh * 64 + c) * 4096 + (32 * half + rb * 16 + 4 * lq) * 64 + cb * 16 + l16;
#pragma unroll
    for (int kk = 0; kk < 16; ++kk) q.p[kk] = P[kk * 64];
#pragma unroll
    for (int r = 0; r < 4; ++r) q.n[r] = N[r * 64];
}
__device__ __forceinline__ void pb_step(const ScanCtx& X, LAS float* Sr, LAS float* Sw, int bh, int c, int half, int rb, int cb, int l16, int lq, const PbBuf& q) {
    f32x4 acc = (f32x4){q.n[0], q.n[1], q.n[2], q.n[3]};
    f32x4 av[4];
#pragma unroll
    for (int j = 0; j < 4; ++j) av[j] = *(const LAS f32x4*)(Sr + (rb * 16 + l16) * 68 + 16 * lq + 4 * j);
#pragma unroll
    for (int kk = 0; kk < 16; ++kk) acc = __builtin_amdgcn_mfma_f32_16x16x4f32(av[kk >> 2][kk & 3], q.p[kk], acc, 0, 0, 0);
    float* N = X.NS + (size_t)(bh * 64 + c) * 4096 + (32 * half + rb * 16 + 4 * lq) * 64 + cb * 16 + l16;
#pragma unroll
    for (int r = 0; r < 4; ++r) { Sw[(rb * 16 + 4 * lq + r) * 68 + cb * 16 + l16] = acc[r]; N[r * 64] = acc[r]; }
    asm volatile("s_waitcnt lgkmcnt(0)" ::: "memory"); __builtin_amdgcn_s_barrier(); asm volatile("" ::: "memory");
}
__device__ __forceinline__ void scan_pass_b(const ScanCtx& X, LAS unsigned char* lds, int wb, int tid, int lane, int wave) {
    asm volatile("" : "+v"(lane), "+v"(tid));
    LAS float* S0 = (LAS float*)lds; LAS float* S1 = S0 + 32 * 68;
    for (int i = tid; i < 32 * 68; i += 512) S0[i] = 0.f;
    __syncthreads();
    const int bh = wb >> 1, half = wb & 1, rb = wave >> 2, cb = wave & 3, l16 = lane & 15, lq = lane >> 4;
    PbBuf q0, q1, q2;
    pb_load(X, bh, 0, half, rb, cb, l16, lq, q0); pb_load(X, bh, 1, half, rb, cb, l16, lq, q1); pb_load(X, bh, 2, half, rb, cb, l16, lq, q2);
    for (int c = 0; c < 60; c += 6) {
        pb_step(X, S0, S1, bh, c, half, rb, cb, l16, lq, q0); pb_load(X, bh, c + 3, half, rb, cb, l16, lq, q0);
        pb_step(X, S1, S0, bh, c + 1, half, rb, cb, l16, lq, q1); pb_load(X, bh, c + 4, half, rb, cb, l16, lq, q1);
        pb_step(X, S0, S1, bh, c + 2, half, rb, cb, l16, lq, q2); pb_load(X, bh, c + 5, half, rb, cb, l16, lq, q2);
        pb_step(X, S1, S0, bh, c + 3, half, rb, cb, l16, lq, q0); pb_load(X, bh, c + 6, half, rb, cb, l16, lq, q0);
        pb_step(X, S0, S1, bh, c + 4, half, rb, cb, l16, lq, q1); pb_load(X, bh, c + 7, half, rb, cb, l16, lq, q1);
        pb_step(X, S1, S0, bh, c + 5, half, rb, cb, l16, lq, q2); pb_load(X, bh, c + 8, half, rb, cb, l16, lq, q2);
    }
    pb_step(X, S0, S1, bh, 60, half, rb, cb, l16, lq, q0); pb_step(X, S1, S0, bh, 61, half, rb, cb, l16, lq, q1); pb_step(X, S0, S1, bh, 62, half, rb, cb, l16, lq, q2);
}

__device__ __forceinline__ void phase_final(tab_t tab, int lane, int wave) {
    asm volatile("" : "+v"(lane));
    float* out = OUTP(); const float* g = INP(26);
    const int gw = blockIdx.x * NWAVES + wave, NGW = gridDim.x * NWAVES;
    f32x4 gv[4];
#pragma unroll
    for (int j = 0; j < 4; ++j) gv[j] = ((const f32x4*)g)[lane + 64 * j];
    for (int m = gw; m < M; m += NGW) {
        f32x4* xr = (f32x4*)(out + (size_t)m * D) + lane; f32x4 v[4]; float s = 0.f;
#pragma unroll
        for (int j = 0; j < 4; ++j) { v[j] = xr[64 * j]; s += (v[j][0] * v[j][0] + v[j][1] * v[j][1]) + (v[j][2] * v[j][2] + v[j][3] * v[j][3]); }
        const float rs = rsqrtf(wave_sum(s) * (1.0f / D) + 1e-6f);
#pragma unroll
        for (int j = 0; j < 4; ++j) xr[64 * j] = v[j] * rs * gv[j];
    }
}

#define RLX_AGENT __ATOMIC_RELAXED, __HIP_MEMORY_SCOPE_AGENT
#define XB_TMO      128
#define XB_XCNT(j)  (256  + 64 * (j))
#define XB_XSUB(j)  (1280 + 64 * (j))
#define XB_XGEN(j)  (2304 + 64 * (j))
#define XB_TOP      3328
#define XB_TOPGEN   3392
#define XCD_BAR_WORDS 3456
#define XB_SPIN_CAP (1u << 18)

__device__ __forceinline__ unsigned xb_ld(unsigned* p)              { return __hip_atomic_load(p, __ATOMIC_RELAXED, __HIP_MEMORY_SCOPE_AGENT); }
__device__ __forceinline__ unsigned xb_add(unsigned* p, unsigned v) { return __hip_atomic_fetch_add(p, v, __ATOMIC_RELAXED, __HIP_MEMORY_SCOPE_AGENT); }
__device__ __forceinline__ unsigned xb_xcc_id() { return (unsigned)__builtin_amdgcn_s_getreg((3 << 11) | 20) & 0xFu; }
#define XB_SPIN(cond, bar) do { unsigned _sp = 0; while (cond) { __builtin_amdgcn_s_sleep(1); \
    if ((++_sp & 255u) == 0u) { if (xb_ld(&(bar)[XB_TMO])) break; if (_sp > XB_SPIN_CAP) { atomicAdd(&(bar)[XB_TMO], 1u); break; } } } } while (0)

struct XcdBarrier {
    unsigned* bar; unsigned x;
    volatile LAS unsigned* st;
};

__device__ __forceinline__ XcdBarrier xcd_barrier_post(unsigned* bar, volatile LAS unsigned* st) {
    XcdBarrier b; b.bar = bar; b.x = xb_xcc_id(); b.st = st;
    if (threadIdx.x == 0) (void)xb_add(&bar[XB_XCNT(b.x)], 1u);
    return b;
}
__device__ __forceinline__ void xcd_barrier_complete(unsigned* bar, unsigned x, unsigned& nloc, unsigned& nx) {
    const unsigned G = gridDim.x * gridDim.y * gridDim.z;
    unsigned sum, cnt, mine, sp = 0u;
    for (;;) {
        sum = 0u; cnt = 0u; mine = 0u;
#pragma unroll
        for (unsigned j = 0; j < 16; ++j) { const unsigned c = xb_ld(&bar[XB_XCNT(j)]); sum += c; cnt += (c > 0u) ? 1u : 0u; mine = (j == x) ? c : mine; }
        if (sum == G) break;
        __builtin_amdgcn_s_sleep(1);
        if ((++sp & 255u) == 0u) { if (xb_ld(&bar[XB_TMO])) break; if (sp > XB_SPIN_CAP) { atomicAdd(&bar[XB_TMO], 1u); break; } }
    }
    nloc = mine > 0u ? mine : 1u; nx = cnt > 0u ? cnt : 1u;
}

__device__ __forceinline__ void xcd_barrier(const XcdBarrier& b) {
    asm volatile("s_waitcnt vmcnt(0)" ::: "memory");
    __syncthreads();
    if (threadIdx.x == 0) {
        unsigned* bar = b.bar;
        __builtin_amdgcn_s_waitcnt(0);
        unsigned nloc = b.st[0], nx = b.st[1];
        if (nloc == 0u) { xcd_barrier_complete(bar, b.x, nloc, nx); b.st[0] = nloc; b.st[1] = nx; }
        const unsigned old = xb_add(&bar[XB_XSUB(b.x)], 1u);
        const unsigned gen = old / nloc;
        if (old + 1u == (gen + 1u) * nloc) {
            __builtin_amdgcn_fence(__ATOMIC_RELEASE, "agent");
            asm volatile("s_waitcnt vmcnt(0)" ::: "memory");
            const unsigned og = xb_add(&bar[XB_TOP], 1u);
            const unsigned tg = og / nx;
            if (og + 1u == (tg + 1u) * nx) xb_add(&bar[XB_TOPGEN], 1u);
            else XB_SPIN(xb_ld(&bar[XB_TOPGEN]) == tg, bar);
            __builtin_amdgcn_fence(__ATOMIC_ACQUIRE, "agent");
            xb_add(&bar[XB_XGEN(b.x)], 1u);
            asm volatile("s_waitcnt vmcnt(0)" ::: "memory");
        } else {
            XB_SPIN(xb_ld(&bar[XB_XGEN(b.x)]) == gen, bar);
            __builtin_amdgcn_fence(__ATOMIC_ACQUIRE, "agent");
            asm volatile("s_waitcnt vmcnt(0)" ::: "memory");
        }
    }
    __syncthreads();
}

__device__ __forceinline__ ScanCtx make_scan_ctx(tab_t tab) {
    unsigned char* ws = WSP();
    ScanCtx X; X.PB = (const bf16*)(ws + WS_PB); X.LOGW = (const bf16*)(ws + WS_LOGW); X.ICLR = (const bf16*)(ws + WS_ICLR); X.GG = (const bf16*)(ws + WS_GG); X.ZB = (bf16*)(ws + WS_ZB);
    X.PC = (float*)(ws + WS_PC); X.NS = (float*)(ws + WS_NS); X.mu = INP(9); X.k_k = INP(15); X.k_a = INP(16); X.r_k = INP(17); X.lnw = INP(18); X.lnb = INP(19);
    return X;
}
__global__ void __launch_bounds__(NWAVES * 64, 2) fwd(Args a) {
    extern __shared__ __attribute__((aligned(16))) unsigned char lds_raw[];
    LAS unsigned char* lds = (LAS unsigned char*)lds_raw;
    const int tid = threadIdx.x, lane = tid & 63, wave = __builtin_amdgcn_readfirstlane(tid >> 6);
    const int G = gridDim.x;
    { LAS unsigned long long* tw = (LAS unsigned long long*)(lds + TAB_OFF);
      if (tid == 0) {
#pragma unroll
          for (int i = 0; i < 27; ++i) tw[i] = (unsigned long long)a.in[i];
          tw[27] = (unsigned long long)a.out; tw[28] = (unsigned long long)a.ws; }
      if (tid < 2) ((LAS unsigned*)(lds + MISC_OFF))[tid] = 0u;
      __syncthreads(); }
    (void)xcd_barrier_post((unsigned*)a.ws + CW_BAR, (volatile LAS unsigned*)(lds + MISC_OFF));
    const tab_t tab = (tab_t)(lds + TAB_OFF);
    const int ph_lo = a.ph_lo, ph_hi = a.ph_hi;

    for (int p = ph_lo; p < ph_hi; ++p) {
      for (int rep = 0; rep <= ((PROBE_REPMASK >> p) & 1); ++rep) {
        pg8::Gemm g{nullptr, nullptr, M, 0, 0}; bool isg = false;
        switch (p) {
        case 0: phase_prologue(tab, lds, tid, lane, wave); break;
        case 4: phase_prep(tab, tid); break;
        case 6: { const ScanCtx X = make_scan_ctx(tab); const int pi = wave & 3, role = wave >> 2; LAS float* pl = (LAS float*)lds + pi * SCAN_WAVE_FLOATS;
                  for (int base = 0; base < 1024; base += 4 * G) { const int cid = base + pi * G + (int)blockIdx.x; const bool act = cid < 1024;
                      if (role == 0) scan_pair<0, 0>(X, act ? cid : 0, act, 0, pl, lane); else scan_pair<0, 1>(X, act ? cid : 0, act, 1, pl, lane); } } break;
        case 7: if (blockIdx.x < 32) { const ScanCtx X = make_scan_ctx(tab); scan_pass_b(X, lds, (int)blockIdx.x, tid, lane, wave); }
                else weights_set1(tab, lds, lane, wave, ((int)blockIdx.x - 32) * NWAVES + wave, (G - 32) * NWAVES);
                break;
        case 8: { const ScanCtx X = make_scan_ctx(tab); const int pi = wave & 3, role = wave >> 2; LAS float* pl = (LAS float*)lds + pi * SCAN_WAVE_FLOATS;
                  for (int base = 0; base < 1024; base += 4 * G) { const int cid = base + pi * G + (int)blockIdx.x; const bool act = cid < 1024;
                      scan_pair<1, 2>(X, act ? cid : 0, act, role, pl, lane); } } break;
        case 15: phase_final(tab, lane, wave); break;
        default: {
            unsigned char* ws = WSP(); isg = true;
            const size_t aoff = (p == 2 || p == 14) ? WS_HID : (p == 5) ? WS_LIN : (p == 10) ? WS_ZA : (p == 11) ? WS_ZB : (p == 12) ? WS_MRG : WS_XB;
            const size_t boff = (p == 1) ? WS_W1GU : (p == 2) ? WS_W1D : (p == 3) ? WS_WIN : (p == 5) ? WS_WL : (p == 9) ? (WS_WIN + (size_t)3328 * D * 2) : (p == 10) ? WS_WOA : (p == 11) ? WS_WOB : (p == 12) ? WS_WO : (p == 13) ? WS_W2GU : WS_W2D;
            const int N = (p == 1 || p == 13) ? 2 * FF : (p == 3) ? 3328 : (p == 5) ? 1536 : (p == 9) ? 2048 : D;
            const int K = (p == 2 || p == 14) ? FF : (p == 5) ? 256 : (p == 10 || p == 11) ? 512 : D;
            g = pg8::Gemm{(const bf16*)(ws + aoff), (const bf16*)(ws + boff), M, N, K}; } break;
        }
        if (isg) { pg8::Epi E{p, tab}; pg8::StaticOrder S; S.init(M, g.N, G, (int)blockIdx.x); pg8::gemm_phase<pg8::Epi, pg8::StaticOrder, true, true>(lds, g, S, E); }
      }
        if (p + 1 < ph_hi) { for (int sr = 0; sr < PROBE_SYNCREP; ++sr) {
            if (ph_hi > NPH) { __syncthreads(); cg::this_grid().sync(); }
            else { XcdBarrier bar; bar.bar = (unsigned*)WSP() + CW_BAR; bar.x = xb_xcc_id(); bar.st = (volatile LAS unsigned*)(lds + MISC_OFF); xcd_barrier(bar); } } }
    }
}

extern "C" void kernel_launch(void* const* d_in, const int* in_sizes, int n_in, void* d_out, int out_size, void* d_ws, size_t ws_size, hipStream_t stream) {
    static int grid = 0;
    if (grid == 0) {
        if (n_in != 27 || in_sizes[0] != M * D || out_size != M * D || ws_size < WS_END) { fprintf(stderr, "kernel_launch: unexpected shapes (n_in %d, in0 %d, out %d, ws %zu)\n", n_in, n_in > 0 ? in_sizes[0] : -1, out_size, ws_size); grid = -1; return; }
        int dev = 0, cus = 0, per_cu = 0;
        if (hipGetDevice(&dev) != hipSuccess || hipDeviceGetAttribute(&cus, hipDeviceAttributeMultiprocessorCount, dev) != hipSuccess) { grid = -1; return; }
        if (hipFuncSetAttribute((const void*)fwd, hipFuncAttributeMaxDynamicSharedMemorySize, LDS_BYTES) != hipSuccess) { fprintf(stderr, "kernel_launch: hipFuncSetAttribute failed\n"); grid = -1; return; }
        if (hipOccupancyMaxActiveBlocksPerMultiprocessor(&per_cu, (const void*)fwd, NWAVES * 64, LDS_BYTES) != hipSuccess || per_cu < 1) { fprintf(stderr, "kernel_launch: occupancy query says %d blocks per CU\n", per_cu); per_cu = 1; }
        (void)hipGetLastError();
        grid = cus * 1;
    }
    if (grid < 0) return;
    if (hipMemsetAsync(d_ws, 0, CTL_ZERO_BYTES, stream) != hipSuccess) { fprintf(stderr, "kernel_launch: hipMemsetAsync failed\n"); return; }
    Args a{};
    for (int i = 0; i < 27; ++i) a.in[i] = (const float*)d_in[i];
    a.out = (float*)d_out; a.ws = (unsigned char*)d_ws;
#if MK_PER_PHASE
    for (int p = 0; p < NPH; ++p) { a.ph_lo = p; a.ph_hi = p + 1; hipLaunchKernelGGL(fwd, dim3(grid), dim3(NWAVES * 64), LDS_BYTES, stream, a); }
#else
    a.ph_lo = 0; a.ph_hi = NPH;
    void* args[] = {&a};
    hipError_t e = hipLaunchCooperativeKernel((const void*)fwd, dim3(grid), dim3(NWAVES * 64), args, LDS_BYTES, stream);
    if (e != hipSuccess) fprintf(stderr, "kernel_launch: cooperative launch failed: %s (grid %d)\n", hipGetErrorString(e), grid);
#endif
}
```

```cpp
#include <hip/hip_runtime.h>
#include <hip/hip_cooperative_groups.h>
#include <cstdio>
#include <cstdint>
namespace cg = cooperative_groups;

#ifndef MK_PER_PHASE
#define MK_PER_PHASE 0
#endif
#ifndef PROBE_REPMASK
#define PROBE_REPMASK 0
#endif
#define PROBE_SYNCREP 1
#define PROBE_PBDRY 0
#define PROBE_TIMEPH -1
constexpr int NWAVES = 8;
constexpr int T = 8192, D = 1024, M = 16384, FF = 2816, NPH = 16;
constexpr size_t MiB = 1u << 20;
constexpr size_t WS_W1GU = 1 * MiB, WS_W1D = 12 * MiB, WS_W2GU = 17 * MiB + MiB / 2, WS_W2D = 28 * MiB + MiB / 2, WS_WIN = 34 * MiB, WS_WOA = 44 * MiB + MiB / 2,
                 WS_WOB = 45 * MiB + MiB / 2, WS_WO = 46 * MiB + MiB / 2, WS_WL = 48 * MiB + MiB / 2;
constexpr size_t WS_XB = 50 * MiB, WS_SSQ0 = 82 * MiB, WS_SSQ1 = 83 * MiB, WS_SSQ2 = 84 * MiB, WS_R = 85 * MiB;
constexpr size_t WS_HID = WS_R, WS_PA = WS_R, WS_PB = WS_R + 48 * MiB, WS_ZA = WS_R + 104 * MiB, WS_LIN = WS_R + 120 * MiB, WS_NS = WS_R + 128 * MiB, WS_ZB = WS_R + 144 * MiB;
constexpr size_t WS_LOGW = WS_R, WS_ICLR = WS_R + 16 * MiB, WS_GG = WS_R + 32 * MiB;
constexpr size_t WS_PC = WS_W1GU;
constexpr size_t WS_SG = WS_R, WS_MRG = WS_R + 64 * MiB;
constexpr size_t WS_Q0 = WS_LIN, WS_Q1 = WS_R + 160 * MiB, WS_BON = WS_SSQ0;
constexpr size_t WS_END = WS_R + 168 * MiB;
static_assert(WS_END <= 256 * MiB, "workspace map");
constexpr int CW_BAR = 4096; constexpr size_t CTL_ZERO_BYTES = 65536;
constexpr int MISC_OFF = 131072 + 512;
constexpr int LDS_BYTES = 147456;
constexpr int SCAN_WAVE_FLOATS = 7424;

#define LAS __attribute__((address_space(3)))
#define GAS __attribute__((address_space(1)))
typedef unsigned short bf16;
typedef unsigned v4u __attribute__((ext_vector_type(4)));
typedef float f32x4 __attribute__((ext_vector_type(4)));
typedef float f32x16 __attribute__((ext_vector_type(16)));
#define LDS_WAIT() asm volatile("s_waitcnt lgkmcnt(0)" ::: "memory")
__device__ __forceinline__ unsigned f2bf(float f) { unsigned u = __builtin_bit_cast(unsigned, f); return (u + 0x7fffu + ((u >> 16) & 1u)) >> 16; }
__device__ __forceinline__ unsigned pk2(float lo, float hi) { return f2bf(lo) | (f2bf(hi) << 16); }
__device__ __forceinline__ float bf2f(bf16 h) { return __uint_as_float((unsigned)h << 16); }
__device__ __forceinline__ float wave_sum(float v) {
#pragma unroll
    for (int o = 1; o < 64; o <<= 1) v += __shfl_xor(v, o);
    return v;
}
__device__ __forceinline__ float dppf(float x, int ctrl_is_xor2) {
    const int xi = __builtin_bit_cast(int, x);
    const int r = ctrl_is_xor2 ? __builtin_amdgcn_update_dpp(xi, xi, 0x4E, 0xF, 0xF, false) : __builtin_amdgcn_update_dpp(xi, xi, 0xB1, 0xF, 0xF, false);
    return __builtin_bit_cast(float, r);
}
__device__ __forceinline__ float quad_sum(float x) { x += dppf(x, 0); x += dppf(x, 1); return x; }
__device__ __forceinline__ float sigmf(float x) { return __builtin_amdgcn_rcpf(1.0f + __expf(-x)); }
__device__ __forceinline__ float tanhf_(float x) { return 1.0f - 2.0f * __builtin_amdgcn_rcpf(1.0f + __expf(2.0f * x)); }

constexpr int TAB_OFF = 131072 + 1024;
typedef LAS const unsigned long long* tab_t;
__device__ __forceinline__ unsigned long long ldptr_(tab_t tab, int i) {
    const unsigned long long v = tab[i];
    const unsigned lo = __builtin_amdgcn_readfirstlane((unsigned)v), hi = __builtin_amdgcn_readfirstlane((unsigned)(v >> 32));
    return ((unsigned long long)hi << 32) | lo;
}
#define INP(i) ((const GAS float*)ldptr_(tab, (i)))
#define OUTP() ((GAS float*)ldptr_(tab, 27))
#define WSP() ((GAS unsigned char*)ldptr_(tab, 28))
namespace pg8 {
#define PG8_LAS __attribute__((address_space(3)))
typedef unsigned short bf16_t;
typedef short bf16x8 __attribute__((ext_vector_type(8)));
typedef float f32x4 __attribute__((ext_vector_type(4)));
typedef unsigned u32x4 __attribute__((ext_vector_type(4)));
constexpr int BM = 256, BK = 64, HALF = 128, HTB = HALF * BK * 2  , STAGE_BYTES = 8 * HTB, NXCD = 8, WGM = 8;

__host__ __device__ __forceinline__ int lds_byte(int r, int c) { const int st = (r >> 4) * 2 + (c >> 5), rr = r & 15, cc = c & 31, ob = rr * 64 + cc * 2; return st * 1024 + (ob ^ (((ob >> 9) & 1) << 5)); }
__host__ __device__ __forceinline__ void stage_rc(int b, int& R, int& C) { const int st = b / 1024, sb = b % 1024, swz = sb ^ (((sb >> 9) & 1) << 5); R = (st >> 1) * 16 + swz / 64; C = (st & 1) * 32 + (swz % 64) / 2; }
__host__ __device__ __forceinline__ int perm32(int rho) { const int n = rho >> 4, i = rho & 15; return 8 * (i >> 2) + 4 * n + (i & 3); }

struct Unit { int pm, pn; };
struct Gemm { const bf16_t* A; const bf16_t* Bt; int M, N, K; };

struct StaticOrder {
    int nM, nN, nwg, G, c;
    __host__ __device__ void init(int M, int N, int G_, int c_) { nM = M / BM; nN = N / BM; nwg = nM * nN; G = G_; c = c_; }
    __host__ __device__ bool next(int i, Unit& u) const {
        const long L = (long)i * G + c; if (L >= nwg) return false;
        int wgid = (int)L; { const int q = nwg / NXCD, r = nwg % NXCD, xcd = wgid % NXCD, off = wgid / NXCD; wgid = (xcd < r ? xcd * (q + 1) : r * (q + 1) + (xcd - r) * q) + off; }
        const int nig = WGM * nN, gid = wgid / nig, fm = gid * WGM, gsz = (nM - fm) < WGM ? (nM - fm) : WGM;
        u.pm = fm + ((wgid % nig) % gsz); u.pn = (wgid % nig) / gsz; return true;
    }
    __device__ __forceinline__ void a_ready(const Unit&) const {}
    __device__ __forceinline__ void done(const Unit&) const {}
};
__device__ __forceinline__ unsigned cvt_pk_bf16(float lo, float hi) { unsigned r; asm volatile("v_cvt_pk_bf16_f32 %0, %1, %2" : "=v"(r) : "v"(lo), "v"(hi)); return r; }
__device__ __forceinline__ float sigm(float x) { return __builtin_amdgcn_rcpf(1.0f + __expf(-x)); }
__device__ __forceinline__ void store8(GAS bf16_t* p, f32x4 a, f32x4 b) {
    u32x4 w; w.x = cvt_pk_bf16(a[0], a[1]); w.y = cvt_pk_bf16(a[2], a[3]); w.z = cvt_pk_bf16(b[0], b[1]); w.w = cvt_pk_bf16(b[2], b[3]);
    *(GAS u32x4*)p = w;
}
__device__ __forceinline__ void load8(const GAS bf16_t* p, f32x4& a, f32x4& b) {
    const u32x4 w = *(const GAS u32x4*)p;
    a[0] = __uint_as_float(w.x << 16); a[1] = __uint_as_float(w.x & 0xffff0000u); a[2] = __uint_as_float(w.y << 16); a[3] = __uint_as_float(w.y & 0xffff0000u);
    b[0] = __uint_as_float(w.z << 16); b[1] = __uint_as_float(w.z & 0xffff0000u); b[2] = __uint_as_float(w.w << 16); b[3] = __uint_as_float(w.w & 0xffff0000u);
}
enum { EM_SWIGLU = 0, EM_RESID = 1, EM_PAB = 2, EM_LORA = 3, EM_GATES = 4, EM_MERGE1 = 5, EM_MERGE2 = 6 };
struct Epi {
    static constexpr bool PERM = true, AFTER_DRAIN = false;
    int p; tab_t tab;
    __device__ __forceinline__ void operator()(const f32x4 (&acc)[2][2][4][2], const Unit& u, int wr, int wc, int fr, int fq) const {
        GAS unsigned char* ws = WSP();
        const int mode = (p == 1 || p == 13) ? EM_SWIGLU : (p == 2 || p == 12 || p == 14) ? EM_RESID : (p == 3) ? EM_PAB : (p == 5) ? EM_LORA : (p == 9) ? EM_GATES : (p == 10) ? EM_MERGE1 : EM_MERGE2;
        const GAS float* ssq = (const GAS float*)(ws + (p == 1 ? WS_SSQ0 : (p == 13 ? WS_SSQ2 : WS_SSQ1)));
        GAS bf16_t* o0 = nullptr; GAS bf16_t* o1 = nullptr; GAS bf16_t* o2 = nullptr; const GAS float* base = nullptr; GAS float* outf = nullptr; GAS float* ssq_out = nullptr; float scale = 1.f;
        const GAS bf16_t* sg = (const GAS bf16_t*)(ws + WS_SG); const GAS float* q0 = nullptr; const GAS float* q1 = nullptr;
        if (mode == EM_SWIGLU) o0 = (GAS bf16_t*)(ws + WS_HID);
        else if (mode == EM_RESID) { outf = OUTP(); base = (p == 2) ? INP(0) : (const GAS float*)outf; o0 = (p == 14) ? nullptr : (GAS bf16_t*)(ws + WS_XB);
                                     ssq_out = (p == 14) ? nullptr : (GAS float*)(ws + (p == 2 ? WS_SSQ1 : WS_SSQ2)); scale = (p == 12) ? 1.0f : 0.5f; }
        else if (mode == EM_PAB) { o0 = (GAS bf16_t*)(ws + WS_PA); o1 = (GAS bf16_t*)(ws + WS_PB); }
        else if (mode == EM_LORA) { o0 = (GAS bf16_t*)(ws + WS_LOGW); o1 = (GAS bf16_t*)(ws + WS_ICLR); o2 = (GAS bf16_t*)(ws + WS_GG); q0 = INP(10); q1 = INP(12); }
        else if (mode == EM_GATES) o0 = (GAS bf16_t*)(ws + WS_SG);
        else o0 = (GAS bf16_t*)(ws + WS_MRG);
        const int rowb = u.pm * BM + wr * 64 + fr;
        const int cw = wc * 32 + 8 * fq;
#pragma unroll
        for (int ai = 0; ai < 2; ++ai)
#pragma unroll
            for (int m = 0; m < 4; ++m) {
                const size_t row = (size_t)(rowb + ai * HALF + m * 16);
                float s = 1.f;
                if (mode == EM_SWIGLU || mode == EM_PAB || mode == EM_GATES) {
                    const GAS f32x4* q = (const GAS f32x4*)(ssq + row * 16);
                    const f32x4 a = q[0], b = q[1], c = q[2], d = q[3];
                    const f32x4 t = (a + b) + (c + d);
                    s = rsqrtf(((t[0] + t[1]) + (t[2] + t[3])) * (1.0f / 1024.0f) + 1e-6f);
                }
                if (mode == EM_SWIGLU) {
                    f32x4 h0, h1;
#pragma unroll
                    for (int j = 0; j < 4; ++j) {
                        const float g0 = acc[ai][0][m][0][j] * s, u0 = acc[ai][1][m][0][j] * s;
                        const float g1 = acc[ai][0][m][1][j] * s, u1 = acc[ai][1][m][1][j] * s;
                        h0[j] = g0 * sigm(g0) * u0; h1[j] = g1 * sigm(g1) * u1;
                    }
                    store8(o0 + row * 2816 + u.pn * 128 + cw, h0, h1);
                } else if (mode == EM_RESID) {
                    float part = 0.f;
#pragma unroll
                    for (int bj = 0; bj < 2; ++bj) {
                        const size_t off = row * 1024 + u.pn * 256 + bj * HALF + cw;
                        const f32x4 b0 = *(const GAS f32x4*)(base + off), b1 = *(const GAS f32x4*)(base + off + 4);
                        const f32x4 v0 = b0 + acc[ai][bj][m][0] * scale, v1 = b1 + acc[ai][bj][m][1] * scale;
                        *(GAS f32x4*)(outf + off) = v0; *(GAS f32x4*)(outf + off + 4) = v1;
                        if (o0) store8(o0 + off, v0, v1);
                        part += (v0[0] * v0[0] + v0[1] * v0[1]) + (v0[2] * v0[2] + v0[3] * v0[3]) + (v1[0] * v1[0] + v1[1] * v1[1]) + (v1[2] * v1[2] + v1[3] * v1[3]);
                    }
                    if (ssq_out) { part += __shfl_xor(part, 16); part += __shfl_xor(part, 32); if (fq == 0) ssq_out[row * 16 + u.pn * 4 + wc] = part; }
                } else {
#pragma unroll
                    for (int bj = 0; bj < 2; ++bj) {
                        const int col = u.pn * 256 + bj * HALF + cw;
                        f32x4 v0 = acc[ai][bj][m][0], v1 = acc[ai][bj][m][1];
                        if (mode == EM_PAB) {
                            v0 = v0 * s; v1 = v1 * s;
                            if (u.pn < 6) store8(o0 + row * 1536 + col, v0, v1); else store8(o1 + row * 1792 + (col - 1536), v0, v1);
                        } else if (mode == EM_LORA) {
                            const int sel = u.pn >> 1, c = col & 511;
                            if (sel == 0) {
                                const f32x4 p0 = *(const GAS f32x4*)(q0 + c), p1 = *(const GAS f32x4*)(q0 + c + 4);
#pragma unroll
                                for (int j = 0; j < 4; ++j) { v0[j] = -0.6065306597f * sigm(p0[j] + v0[j]); v1[j] = -0.6065306597f * sigm(p1[j] + v1[j]); }
                                store8(o0 + row * 512 + c, v0, v1);
                            } else if (sel == 1) {
                                const f32x4 p0 = *(const GAS f32x4*)(q1 + c), p1 = *(const GAS f32x4*)(q1 + c + 4);
#pragma unroll
                                for (int j = 0; j < 4; ++j) { v0[j] = sigm(p0[j] + v0[j]); v1[j] = sigm(p1[j] + v1[j]); }
                                store8(o1 + row * 512 + c, v0, v1);
                            } else store8(o2 + row * 512 + c, v0, v1);
                        } else if (mode == EM_GATES) {
#pragma unroll
                            for (int j = 0; j < 4; ++j) { v0[j] = sigm(v0[j] * s); v1[j] = sigm(v1[j] * s); }
                            store8(o0 + row * 2048 + col, v0, v1);
                        } else if (mode == EM_MERGE1) {
                            f32x4 g0, g1; load8(sg + row * 2048 + col, g0, g1);
                            store8(o0 + row * 1024 + col, g0 * v0, g1 * v1);
                        } else {
                            f32x4 g0, g1, m0, m1; load8(sg + row * 2048 + 1024 + col, g0, g1); load8(o0 + row * 1024 + col, m0, m1);
                            store8(o0 + row * 1024 + col, m0 + g0 * v0, m1 + g1 * v1);
                        }
                    }
                }
            }
    }
};

template <class Epi, class Sched, bool ALIGN_EPI = false, bool SP2 = false>
__device__ __forceinline__ void gemm_phase(PG8_LAS unsigned char* lds, const Gemm g, const Sched& S, const Epi& E) {
    const int tid = threadIdx.x, wid = __builtin_amdgcn_readfirstlane(tid >> 6), lane = tid & 63, wr = wid >> 2, wc = wid & 3, fr = lane & 15, fq = lane >> 4;
    const int K = g.K, nt = K / BK;
    unsigned voffA[2], voffB[2];
#pragma unroll
    for (int i = 0; i < 2; ++i) { int R, C; stage_rc(tid * 16 + i * 8192, R, C); const int Rb = Epi::PERM ? ((R & ~31) + perm32(R & 31)) : R;
        voffA[i] = (unsigned)(R * K + C) * 2u; voffB[i] = (unsigned)(Rb * K + C) * 2u; }
    const size_t kstep = (size_t)(BK * 2);
    const size_t hstep = (size_t)HALF * K * 2;
    const size_t tstep = 2 * hstep;
    const unsigned ldsw = (unsigned)wid * 1024u;
    const int aoff = lds_byte(wr * 64 + fr, fq * 8), boff = lds_byte(wc * 32 + fr, fq * 8);
#define PG8_SA(b, h) (((b) * 2 + (h)) * HTB)
#define PG8_SB(b, h) ((4 + (b) * 2 + (h)) * HTB)
#define PG8_STAGE(bufoff, gbase, voff) do { _Pragma("unroll") for (int _i = 0; _i < 2; ++_i) \
        __builtin_amdgcn_global_load_lds((const unsigned*)((const char*)(gbase) + (voff)[_i]), (PG8_LAS unsigned*)(lds + (bufoff) + ldsw + _i * 8192), 16, 0, 0); } while (0)
#define PG8_LDA(dst, b, h) do { _Pragma("unroll") for (int m = 0; m < 4; ++m) _Pragma("unroll") for (int k = 0; k < 2; ++k) dst[m][k] = *(const PG8_LAS bf16x8*)(lds + PG8_SA(b, h) + aoff + m * 2048 + k * 1024); } while (0)
#define PG8_LDB(dst, b, h) do { _Pragma("unroll") for (int n = 0; n < 2; ++n) _Pragma("unroll") for (int k = 0; k < 2; ++k) dst[n][k] = *(const PG8_LAS bf16x8*)(lds + PG8_SB(b, h) + boff + n * 2048 + k * 1024); } while (0)
#define PG8_MMA(ai, bj, At, Bt) do { __builtin_amdgcn_s_setprio(1); _Pragma("unroll") for (int m = 0; m < 4; ++m) _Pragma("unroll") for (int n = 0; n < 2; ++n) _Pragma("unroll") for (int k = 0; k < 2; ++k) \
        acc[ai][bj][m][n] = __builtin_amdgcn_mfma_f32_16x16x32_bf16(Bt[n][k], At[m][k], acc[ai][bj][m][n], 0, 0, 0); __builtin_amdgcn_s_setprio(0); } while (0)
#define PG8_WAIT_V(n) asm volatile("s_waitcnt vmcnt(" #n ")" ::: "memory")
#define PG8_WAIT_L(n) asm volatile("s_waitcnt lgkmcnt(" #n ")" ::: "memory")
#define PG8_BAR __builtin_amdgcn_s_barrier()
#define PG8_SCHED __builtin_amdgcn_sched_barrier(0)
    Unit cur, nxt; int ui = 0;
    if (!S.next(0, cur)) return;
    f32x4 acc[2][2][4][2];
#pragma unroll
    for (int a = 0; a < 2; ++a)
#pragma unroll
        for (int b = 0; b < 2; ++b)
#pragma unroll
            for (int m = 0; m < 4; ++m)
#pragma unroll
                for (int n = 0; n < 2; ++n) acc[a][b][m][n] = (f32x4){0.f, 0.f, 0.f, 0.f};
    bf16x8 At[4][2], B0[2][2], B1[2][2];
    const char* cA = (const char*)g.A + (size_t)cur.pm * tstep; const char* cB = (const char*)g.Bt + (size_t)cur.pn * tstep;
    S.a_ready(cur);
    if constexpr (SP2) {
        PG8_STAGE(PG8_SB(0, 0), cB, voffB); PG8_STAGE(PG8_SB(0, 1), cB + hstep, voffB); PG8_STAGE(PG8_SA(0, 0), cA, voffA); PG8_STAGE(PG8_SA(0, 1), cA + hstep, voffA);
        if (wr == 1) PG8_BAR;
        PG8_WAIT_V(2); PG8_BAR;
        PG8_STAGE(PG8_SB(1, 0), cB + kstep, voffB); PG8_STAGE(PG8_SA(1, 0), cA + kstep, voffA); PG8_STAGE(PG8_SB(1, 1), cB + hstep + kstep, voffB);
        PG8_WAIT_V(6); PG8_BAR;
    } else {
        PG8_STAGE(PG8_SB(0, 0), cB, voffB); PG8_STAGE(PG8_SA(0, 0), cA, voffA); PG8_STAGE(PG8_SB(0, 1), cB + hstep, voffB); PG8_STAGE(PG8_SA(0, 1), cA + hstep, voffA);
        if (wr == 1) PG8_BAR;
        PG8_WAIT_V(4); PG8_BAR;
        PG8_STAGE(PG8_SB(1, 0), cB + kstep, voffB); PG8_STAGE(PG8_SA(1, 0), cA + kstep, voffA); PG8_STAGE(PG8_SB(1, 1), cB + hstep + kstep, voffB);
        PG8_WAIT_V(6); PG8_BAR;
    }
    for (;;) {
        const bool has_next = S.next(ui + 1, nxt);
        const char* nA = has_next ? (const char*)g.A + (size_t)nxt.pm * tstep : cA; const char* nB = has_next ? (const char*)g.Bt + (size_t)nxt.pn * tstep : cB;
        for (int t = 0; t < nt; t += 2) {
            const bool last = (t == nt - 2);
            const char* a1 = cA + (size_t)(t + 1) * kstep;
            const char* a2 = last ? nA : cA + (size_t)(t + 2) * kstep; const char* b2 = last ? nB : cB + (size_t)(t + 2) * kstep;
            const char* a3 = a2 + kstep; const char* b3 = b2 + kstep;
            if (last && has_next) S.a_ready(nxt);
            if constexpr (SP2) {
            PG8_LDB(B0, 0, 0); PG8_LDB(B1, 0, 1); PG8_SCHED; PG8_LDA(At, 0, 0); PG8_STAGE(PG8_SA(1, 1), a1 + hstep, voffA);
            PG8_WAIT_V(8); PG8_WAIT_L(0); PG8_BAR; PG8_MMA(0, 0, At, B0); PG8_MMA(0, 1, At, B1); PG8_BAR; PG8_SCHED;
            PG8_LDA(At, 0, 1); PG8_STAGE(PG8_SB(0, 0), b2, voffB); PG8_STAGE(PG8_SB(0, 1), b2 + hstep, voffB); PG8_STAGE(PG8_SA(0, 0), a2, voffA);
            PG8_WAIT_V(8); PG8_WAIT_L(0); PG8_BAR; PG8_MMA(1, 0, At, B0); PG8_MMA(1, 1, At, B1); PG8_BAR; PG8_SCHED;
            PG8_LDB(B0, 1, 0); PG8_LDB(B1, 1, 1); PG8_SCHED; PG8_LDA(At, 1, 0); PG8_STAGE(PG8_SA(0, 1), a2 + hstep, voffA);
            PG8_WAIT_V(8); PG8_WAIT_L(0); PG8_BAR; PG8_MMA(0, 0, At, B0); PG8_MMA(0, 1, At, B1); PG8_BAR; PG8_SCHED;
            PG8_LDA(At, 1, 1); PG8_STAGE(PG8_SB(1, 0), b3, voffB); PG8_STAGE(PG8_SB(1, 1), b3 + hstep, voffB); PG8_STAGE(PG8_SA(1, 0), a3, voffA);
            PG8_WAIT_V(8); PG8_WAIT_L(0); PG8_BAR; PG8_MMA(1, 0, At, B0); PG8_MMA(1, 1, At, B1); PG8_BAR; PG8_SCHED;
            } else {
            PG8_LDB(B0, 0, 0); PG8_SCHED; PG8_LDA(At, 0, 0); PG8_STAGE(PG8_SA(1, 1), a1 + hstep, voffA);
            PG8_WAIT_L(8); PG8_BAR; PG8_WAIT_L(0); PG8_MMA(0, 0, At, B0); PG8_BAR; PG8_SCHED;
            PG8_LDB(B1, 0, 1); PG8_STAGE(PG8_SB(0, 0), b2, voffB);
            PG8_BAR; PG8_WAIT_L(0); PG8_MMA(0, 1, At, B1); PG8_BAR;
            PG8_LDA(At, 0, 1); PG8_STAGE(PG8_SA(0, 0), a2, voffA);
            PG8_BAR; PG8_WAIT_L(0); PG8_MMA(1, 0, At, B0); PG8_BAR; PG8_SCHED;
            PG8_STAGE(PG8_SB(0, 1), b2 + hstep, voffB);
            PG8_WAIT_V(6); PG8_BAR; PG8_MMA(1, 1, At, B1); PG8_BAR;
            PG8_LDB(B0, 1, 0); PG8_SCHED; PG8_LDA(At, 1, 0); PG8_STAGE(PG8_SA(0, 1), a2 + hstep, voffA);
            PG8_WAIT_L(8); PG8_BAR; PG8_WAIT_L(0); PG8_MMA(0, 0, At, B0); PG8_BAR; PG8_SCHED;
            PG8_LDB(B1, 1, 1); PG8_STAGE(PG8_SB(1, 0), b3, voffB);
            PG8_BAR; PG8_WAIT_L(0); PG8_MMA(0, 1, At, B1); PG8_BAR;
            PG8_LDA(At, 1, 1); PG8_STAGE(PG8_SA(1, 0), a3, voffA);
            PG8_BAR; PG8_WAIT_L(0); PG8_MMA(1, 0, At, B0); PG8_BAR; PG8_SCHED;
            PG8_STAGE(PG8_SB(1, 1), b3 + hstep, voffB);
            PG8_WAIT_V(6); PG8_BAR; PG8_MMA(1, 1, At, B1); PG8_BAR;
            }
        }
        if constexpr (ALIGN_EPI) { if (wr == 0) PG8_BAR; }
        if constexpr (!Epi::AFTER_DRAIN) { E(acc, cur, wr, wc, fr, fq); S.done(cur); }
        if (!has_next) break;
#pragma unroll
        for (int a = 0; a < 2; ++a)
#pragma unroll
            for (int b = 0; b < 2; ++b)
#pragma unroll
                for (int m = 0; m < 4; ++m)
#pragma unroll
                    for (int n = 0; n < 2; ++n) acc[a][b][m][n] = (f32x4){0.f, 0.f, 0.f, 0.f};
        cur = nxt; cA = nA; cB = nB; ++ui;
        if constexpr (ALIGN_EPI) { if (wr == 1) PG8_BAR; }
    }
    PG8_WAIT_V(0);
    if constexpr (!ALIGN_EPI) { if (wr == 0) PG8_BAR; }
    PG8_BAR;
    if constexpr (Epi::AFTER_DRAIN) { E.fused(acc, cur, wr, wc, fr, fq, lds, wid, lane); S.done(cur); }
#undef PG8_SA
#undef PG8_SB
#undef PG8_STAGE
#undef PG8_LDA
#undef PG8_LDB
#undef PG8_MMA
#undef PG8_WAIT_V
#undef PG8_WAIT_L
#undef PG8_BAR
#undef PG8_SCHED
}
}
struct Args { const float* in[27]; float* out; unsigned char* ws; int ph_lo, ph_hi; };

__device__ __forceinline__ void transpose_item(const GAS float* W, int K, int N, GAS bf16* WT, const GAS float* gain, int il, LAS float* scr, int item, int lane) {
    const int nblk = N / 32, kb = item / nblk, nb = item % nblk, k0 = 64 * kb, n0 = 32 * nb;
    float v[32];
    const GAS float* src = W + (size_t)(k0 + (lane >> 5)) * N + n0 + (lane & 31);
#pragma unroll
    for (int i = 0; i < 32; ++i) v[i] = src[(size_t)(2 * i) * N];
    if (gain) {
        float gg[32];
#pragma unroll
        for (int i = 0; i < 32; ++i) gg[i] = gain[k0 + 2 * i + (lane >> 5)];
#pragma unroll
        for (int i = 0; i < 32; ++i) v[i] *= gg[i];
    }
#pragma unroll
    for (int i = 0; i < 32; ++i) scr[(2 * i + (lane >> 5)) * 33 + (lane & 31)] = v[i];
    LDS_WAIT(); asm volatile("" ::: "memory");
    const int drow0 = il ? (((n0 >> 7) << 8) + (n0 & 127) + (il == 2 ? 128 : 0)) : n0;
    const int c = lane & 7;
#pragma unroll
    for (int j = 0; j < 4; ++j) { const int n = (lane >> 3) + 8 * j; const LAS float* s = scr + (8 * c) * 33 + n;
        v4u o; o.x = pk2(s[0 * 33], s[1 * 33]); o.y = pk2(s[2 * 33], s[3 * 33]); o.z = pk2(s[4 * 33], s[5 * 33]); o.w = pk2(s[6 * 33], s[7 * 33]);
        *(GAS v4u*)(WT + (size_t)(drow0 + n) * K + k0 + 8 * c) = o; }
    LDS_WAIT(); asm volatile("" ::: "memory");
}
__device__ __forceinline__ void weights_set1(tab_t tab, LAS unsigned char* lds, int lane, int wave, int gw, int NGW) {
    asm volatile("" : "+v"(lane));
    GAS unsigned char* ws = WSP();
    LAS float* scr = (LAS float*)(lds + wave * 16384);
    constexpr int I_GU = (D / 64) * (FF / 32), I_DN = (FF / 64) * (D / 32), I_OA = (512 / 64) * (D / 32), I_O = (D / 64) * (D / 32);
    constexpr int NITEMS = 2 * I_GU + I_DN + 2 * I_OA + I_O;
    for (int it = gw; it < NITEMS; it += NGW) {
        int r = it;
        if (r < I_GU) { transpose_item(INP(23), D, FF, (GAS bf16*)(ws + WS_W2GU), INP(22), 1, scr, r, lane); continue; } r -= I_GU;
        if (r < I_GU) { transpose_item(INP(24), D, FF, (GAS bf16*)(ws + WS_W2GU), INP(22), 2, scr, r, lane); continue; } r -= I_GU;
        if (r < I_DN) { transpose_item(INP(25), FF, D, (GAS bf16*)(ws + WS_W2D), nullptr, 0, scr, r, lane); continue; } r -= I_DN;
        if (r < I_OA) { transpose_item(INP(8), 512, D, (GAS bf16*)(ws + WS_WOA), nullptr, 0, scr, r, lane); continue; } r -= I_OA;
        if (r < I_OA) { transpose_item(INP(20), 512, D, (GAS bf16*)(ws + WS_WOB), nullptr, 0, scr, r, lane); continue; } r -= I_OA;
        transpose_item(INP(21), D, D, (GAS bf16*)(ws + WS_WO), nullptr, 0, scr, r, lane);
    }
}
__device__ __forceinline__ void phase_prologue(tab_t tab, LAS unsigned char* lds, int tid, int lane, int wave) {
    asm volatile("" : "+v"(lane), "+v"(tid));
    GAS unsigned char* ws = WSP();
    LAS float* scr = (LAS float*)(lds + wave * 16384);
    const int G = gridDim.x, gw = blockIdx.x * NWAVES + wave, NGW = G * NWAVES;
    constexpr int I_GU = (D / 64) * (FF / 32), I_DN = (FF / 64) * (D / 32), I_IN = (D / 64) * (5376 / 32);
    constexpr int NITEMS = 2 * I_GU + I_DN + I_IN;
    for (int it = gw; it < NITEMS; it += NGW) {
        int r = it;
        if (r < I_GU) { transpose_item(INP(2), D, FF, (GAS bf16*)(ws + WS_W1GU), INP(1), 1, scr, r, lane); continue; } r -= I_GU;
        if (r < I_GU) { transpose_item(INP(3), D, FF, (GAS bf16*)(ws + WS_W1GU), INP(1), 2, scr, r, lane); continue; } r -= I_GU;
        if (r < I_DN) { transpose_item(INP(4), FF, D, (GAS bf16*)(ws + WS_W1D), nullptr, 0, scr, r, lane); continue; } r -= I_DN;
        transpose_item(INP(6), D, 5376, (GAS bf16*)(ws + WS_WIN), INP(5), 0, scr, r, lane);
    }
    { GAS bf16* WL = (GAS bf16*)(ws + WS_WL); const GAS float* wdu = INP(11); const GAS float* wiu = INP(13); const GAS float* wgu = INP(14);
      for (int idx = blockIdx.x * 512 + tid; idx < 1536 * 256; idx += G * 512) {
          const int n = idx >> 8, kc = idx & 255; float v = 0.f;
          if (n < 512) { if (kc < 64) v = wdu[kc * 512 + n]; }
          else if (n < 1024) { if (kc >= 64 && kc < 128) v = wiu[(kc - 64) * 512 + (n - 512)]; }
          else { if (kc >= 128) v = wgu[(kc - 128) * 512 + (n - 1024)]; }
          WL[idx] = (bf16)f2bf(v); } }
    { const GAS float* x = INP(0); GAS bf16* xb = (GAS bf16*)(ws + WS_XB); GAS float* ssq0 = (GAS float*)(ws + WS_SSQ0);
      for (int m = gw; m < M; m += 2 * NGW) {
          const int m2 = m + NGW; const bool has2 = m2 < M;
          const GAS f32x4* xr = (const GAS f32x4*)(x + (size_t)m * D) + lane; const GAS f32x4* xr2 = (const GAS f32x4*)(x + (size_t)(has2 ? m2 : m) * D) + lane;
          f32x4 v[4], w[4]; float s = 0.f, s2 = 0.f;
#pragma unroll
          for (int j = 0; j < 4; ++j) { v[j] = xr[64 * j]; w[j] = xr2[64 * j]; }
#pragma unroll
          for (int j = 0; j < 4; ++j) { s += (v[j][0] * v[j][0] + v[j][1] * v[j][1]) + (v[j][2] * v[j][2] + v[j][3] * v[j][3]); s2 += (w[j][0] * w[j][0] + w[j][1] * w[j][1]) + (w[j][2] * w[j][2] + w[j][3] * w[j][3]); }
          s = wave_sum(s); s2 = wave_sum(s2);
          GAS unsigned long long* o8 = (GAS unsigned long long*)(xb + (size_t)m * D) + lane;
#pragma unroll
          for (int j = 0; j < 4; ++j) o8[64 * j] = (unsigned long long)pk2(v[j][0], v[j][1]) | ((unsigned long long)pk2(v[j][2], v[j][3]) << 32);
          if (lane < 16) ssq0[(size_t)m * 16 + lane] = (lane == 0) ? s : 0.f;
          if (has2) {
              GAS unsigned long long* p8 = (GAS unsigned long long*)(xb + (size_t)m2 * D) + lane;
#pragma unroll
              for (int j = 0; j < 4; ++j) p8[64 * j] = (unsigned long long)pk2(w[j][0], w[j][1]) | ((unsigned long long)pk2(w[j][2], w[j][3]) << 32);
              if (lane < 16) ssq0[(size_t)m2 * 16 + lane] = (lane == 0) ? s2 : 0.f;
          }
      } }
}

__device__ __forceinline__ void ld8(const GAS bf16* p, float (&v)[8]) {
    const v4u w = *(const GAS v4u*)p;
    v[0] = __uint_as_float(w.x << 16); v[1] = __uint_as_float(w.x & 0xffff0000u); v[2] = __uint_as_float(w.y << 16); v[3] = __uint_as_float(w.y & 0xffff0000u);
    v[4] = __uint_as_float(w.z << 16); v[5] = __uint_as_float(w.z & 0xffff0000u); v[6] = __uint_as_float(w.w << 16); v[7] = __uint_as_float(w.w & 0xffff0000u);
}
__device__ __forceinline__ void st8(GAS bf16* p, const float (&v)[8]) {
    v4u w; w.x = pk2(v[0], v[1]); w.y = pk2(v[2], v[3]); w.z = pk2(v[4], v[5]); w.w = pk2(v[6], v[7]); *(GAS v4u*)p = w;
}
__device__ __forceinline__ void phase_prep(tab_t tab, int tid) {
    asm volatile("" : "+v"(tid));
    GAS unsigned char* ws = WSP();
    const GAS bf16* PA = (const GAS bf16*)(ws + WS_PA); const GAS bf16* PB = (const GAS bf16*)(ws + WS_PB);
    GAS bf16* ZA = (GAS bf16*)(ws + WS_ZA); GAS bf16* LIN = (GAS bf16*)(ws + WS_LIN);
    const GAS float* cw = INP(7); const GAS float* mu = INP(9);
    const int gt = blockIdx.x * 512 + tid, NT = gridDim.x * 512;
    for (int it = gt; it < M * 64; it += NT) {
        const int m = it >> 6, c0 = (it & 63) * 8, t = m & (T - 1);
        float bb[8], c_[8], u_[8], acc[8], w0[8], w1[8], w2[8];
#pragma unroll
        for (int j = 0; j < 8; ++j) { w0[j] = cw[c0 + j]; w1[j] = cw[512 + c0 + j]; w2[j] = cw[1024 + c0 + j]; }
        const GAS bf16* row = PA + (size_t)m * 1536;
        ld8(row + c0, bb); ld8(row + 512 + c0, c_); ld8(row + 1024 + c0, u_);
#pragma unroll
        for (int j = 0; j < 8; ++j) acc[j] = w2[j] * (c_[j] * u_[j]);
        if (t >= 1) { ld8(row - 1536 + 512 + c0, c_); ld8(row - 1536 + 1024 + c0, u_);
#pragma unroll
            for (int j = 0; j < 8; ++j) acc[j] += w1[j] * (c_[j] * u_[j]); }
        if (t >= 2) { ld8(row - 3072 + 512 + c0, c_); ld8(row - 3072 + 1024 + c0, u_);
#pragma unroll
            for (int j = 0; j < 8; ++j) acc[j] += w0[j] * (c_[j] * u_[j]); }
#pragma unroll
        for (int j = 0; j < 8; ++j) acc[j] *= bb[j];
        st8(ZA + (size_t)m * 512 + c0, acc);
    }
    for (int it = gt; it < M * 32; it += NT) {
        const int m = it >> 5, c0 = (it & 31) * 8, t = m & (T - 1);
        float x[8], xp[8];
        const GAS bf16* row = PB + (size_t)m * 1792 + 1536 + c0;
        ld8(row, x);
        if (t >= 1) ld8(row - 1792, xp); else {
#pragma unroll
            for (int j = 0; j < 8; ++j) xp[j] = 0.f; }
#pragma unroll
        for (int j = 0; j < 8; ++j) { float v = x[j] + (xp[j] - x[j]) * mu[1536 + c0 + j]; x[j] = (c0 < 64) ? tanhf_(v) : ((c0 < 128) ? v : sigmf(v)); }
        st8(LIN + (size_t)m * 256 + c0, x);
    }
}

struct ScanCtx {
    const GAS bf16* PB; const GAS bf16* LOGW; const GAS bf16* ICLR; const GAS bf16* GG; GAS bf16* ZB; GAS float* PC; GAS float* NS;
    const GAS float* mu; const GAS float* k_k; const GAS float* k_a; const GAS float* r_k; const GAS float* lnw; const GAS float* lnb;
    GAS bf16* Q0; GAS bf16* Q1; GAS float* BON;
};
template <int CTRL> __device__ __forceinline__ float dppx(float x) {
    const int xi = __builtin_bit_cast(int, x);
    return __builtin_bit_cast(float, __builtin_amdgcn_update_dpp(xi, xi, CTRL, 0xF, 0xF, false));
}
__device__ __forceinline__ float wave_sum_dpp(float v) {
    v += dppx<0xB1>(v); v += dppx<0x4E>(v); v += dppx<0x141>(v); v += dppx<0x140>(v);
    const int vi = __builtin_bit_cast(int, v);
    const float s0 = __builtin_bit_cast(float, __builtin_amdgcn_readlane(vi, 0)), s1 = __builtin_bit_cast(float, __builtin_amdgcn_readlane(vi, 16));
    const float s2 = __builtin_bit_cast(float, __builtin_amdgcn_readlane(vi, 32)), s3 = __builtin_bit_cast(float, __builtin_amdgcn_readlane(vi, 48));
    return (s0 + s1) + (s2 + s3);
}
typedef float f32x2 __attribute__((ext_vector_type(2)));
#define LBAR() do { asm volatile("s_waitcnt lgkmcnt(0)" ::: "memory"); __builtin_amdgcn_s_barrier(); asm volatile("" ::: "memory"); } while (0)
struct Raw4 { unsigned r[5], k[5], v[5], lw[4], ic[4]; };
__device__ __forceinline__ void load_raw4(const ScanCtx& X, int ms, bool prev_valid, int hc, Raw4& q) {
#pragma unroll
    for (int j = 0; j < 5; ++j) {
        const int m = (j == 0 && !prev_valid) ? ms : (ms - 1 + j);
        const GAS bf16* row = X.PB + (size_t)m * 1792;
        q.r[j] = row[hc]; q.k[j] = row[512 + hc]; q.v[j] = row[1024 + hc];
    }
    if (!prev_valid) { q.r[0] = 0u; q.k[0] = 0u; q.v[0] = 0u; }
#pragma unroll
    for (int j = 0; j < 4; ++j) { q.lw[j] = X.LOGW[(size_t)(ms + j) * 512 + hc]; q.ic[j] = X.ICLR[(size_t)(ms + j) * 512 + hc]; }
}
template <int PASS, int MODE>
__device__ __forceinline__ void scan_pair(const ScanCtx& X, int cid, bool active, int role, LAS float* pl, int lane) {
    asm volatile("" : "+v"(lane));
    constexpr int R = (PASS == 0) ? 4 : 2;
    const int bh = cid >> 6, c = cid & 63, b = bh >> 3, h = bh & 7;
    const int m0 = b * T + c * 128;
    const int rg = lane >> 2, ks = lane & 3;
    const int hc = h * 64 + lane;
    const int row0 = (PASS == 0) ? rg * 4 : role * 32 + rg * 2;
    f32x2 S[R][8];
#pragma unroll
    for (int i = 0; i < R; ++i)
#pragma unroll
        for (int j = 0; j < 8; ++j) { S[i][j].x = (MODE == 0 && (row0 + i) == (ks * 16 + 2 * j)) ? 1.f : 0.f; S[i][j].y = (MODE == 0 && (row0 + i) == (ks * 16 + 2 * j + 1)) ? 1.f : 0.f; }
    if (MODE == 2 && c > 0 && active) {
        const GAS float* src = X.NS + (size_t)(cid - 1) * 4096;
#pragma unroll
        for (int i = 0; i < R; ++i)
#pragma unroll
            for (int q = 0; q < 4; ++q) { const f32x4 v = *(const GAS f32x4*)(src + (row0 + i) * 64 + ks * 16 + q * 4); S[i][2 * q] = (f32x2){v[0], v[1]}; S[i][2 * q + 1] = (f32x2){v[2], v[3]}; }
    }
    const float mu_r = X.mu[hc], mu_k = X.mu[512 + hc], mu_v = X.mu[1024 + hc];
    const float kk_c = X.k_k[hc], ka_c = X.k_a[hc], rk_c = X.r_k[hc], lnw = X.lnw[hc], lnb = X.lnb[hc];
    LAS float* LY = pl + 6400;
    const int s0 = role * 4;
    Raw4 cur;
    if (active) load_raw4(X, m0 + s0, !(c == 0 && role == 0), hc, cur);
    for (int sub = 0; sub < 16; ++sub) {
        const int mb = m0 + sub * 8;
        LAS float* vb = pl + (sub & 1) * 3200;
        LAS float* LA = vb; LAS float* LW = vb + 512; LAS float* LB = vb + 1024; LAS float* LK = vb + 1536; LAS float* LR = vb + 2048; LAS float* LV = vb + 2560; LAS float* LBon = vb + 3072;
        unsigned gq[4];
        if (active) {
#pragma unroll
            for (int j = 0; j < 4; ++j) {
                const int s = s0 + j;
                const float rc = __uint_as_float(cur.r[j + 1] << 16), kc = __uint_as_float(cur.k[j + 1] << 16), vc = __uint_as_float(cur.v[j + 1] << 16);
                const float rp = __uint_as_float(cur.r[j] << 16), kp = __uint_as_float(cur.k[j] << 16), vp = __uint_as_float(cur.v[j] << 16);
                const float r = rc + (rp - rc) * mu_r, k = kc + (kp - kc) * mu_k, v = vc + (vp - vc) * mu_v;
                const float lw = __uint_as_float(cur.lw[j] << 16), ic = __uint_as_float(cur.ic[j] << 16);
                float kk = k * kk_c; const float n2 = wave_sum_dpp(kk * kk); kk = kk * rsqrtf(fmaxf(n2, 1e-24f));
                const float k2 = k * (1.0f + (ic - 1.0f) * ka_c);
                LA[s * 64 + lane] = -kk; LW[s * 64 + lane] = __expf(lw); LB[s * 64 + lane] = kk * ic; LK[s * 64 + lane] = k2; LV[s * 64 + lane] = v;
                if (MODE == 2) { LR[s * 64 + lane] = r; const float bon = wave_sum_dpp(r * k2 * rk_c); if (lane == 0) LBon[s] = bon; }
                if (PASS == 0) { LR[s * 64 + lane] = r; const float bon = wave_sum_dpp(r * k2 * rk_c); if (lane == 0) X.BON[(size_t)(mb + s) * 8 + h] = bon; }
            }
            if (sub < 15) load_raw4(X, mb + 8 + s0, true, hc, cur);
            if (MODE == 2) {
#pragma unroll
                for (int j = 0; j < 4; ++j) gq[j] = X.GG[(size_t)(mb + s0 + j) * 512 + hc];
            }
        }
        LBAR();
        if (active) {
#pragma unroll 2
            for (int s = 0; s < 8; ++s) {
                f32x2 a2[8], w2[8], b2[8], k2[8], r2[8]; float vv[R];
#pragma unroll
                for (int q = 0; q < 4; ++q) {
                    const f32x4 ta = *(const LAS f32x4*)(LA + s * 64 + ks * 16 + 4 * q), tw = *(const LAS f32x4*)(LW + s * 64 + ks * 16 + 4 * q), tb = *(const LAS f32x4*)(LB + s * 64 + ks * 16 + 4 * q);
                    a2[2 * q] = (f32x2){ta[0], ta[1]}; a2[2 * q + 1] = (f32x2){ta[2], ta[3]}; w2[2 * q] = (f32x2){tw[0], tw[1]}; w2[2 * q + 1] = (f32x2){tw[2], tw[3]}; b2[2 * q] = (f32x2){tb[0], tb[1]}; b2[2 * q + 1] = (f32x2){tb[2], tb[3]};
                }
                if (MODE >= 1) {
#pragma unroll
                    for (int q = 0; q < 4; ++q) { const f32x4 tk = *(const LAS f32x4*)(LK + s * 64 + ks * 16 + 4 * q); k2[2 * q] = (f32x2){tk[0], tk[1]}; k2[2 * q + 1] = (f32x2){tk[2], tk[3]}; }
                    if (R == 4) { const f32x4 t = *(const LAS f32x4*)(LV + s * 64 + row0); vv[0] = t[0]; vv[1] = t[1]; vv[R - 2] = t[2]; vv[R - 1] = t[3]; }
                    else { const f32x2 t = *(const LAS f32x2*)(LV + s * 64 + row0); vv[0] = t[0]; vv[1] = t[1]; }
                }
                if (MODE == 2 || PASS == 0) {
#pragma unroll
                    for (int q = 0; q < 4; ++q) { const f32x4 tr = *(const LAS f32x4*)(LR + s * 64 + ks * 16 + 4 * q); r2[2 * q] = (f32x2){tr[0], tr[1]}; r2[2 * q + 1] = (f32x2){tr[2], tr[3]}; }
                }
                float sa[R];
#pragma unroll
                for (int i = 0; i < R; ++i) {
                    f32x2 p0 = S[i][0] * a2[0], p1 = S[i][1] * a2[1];
#pragma unroll
                    for (int j = 2; j < 8; j += 2) { p0 = S[i][j] * a2[j] + p0; p1 = S[i][j + 1] * a2[j + 1] + p1; }
                    p0 = p0 + p1; sa[i] = quad_sum(p0.x + p0.y);
                }
#pragma unroll
                for (int i = 0; i < R; ++i) {
                    const f32x2 sa2 = (f32x2){sa[i], sa[i]};
#pragma unroll
                    for (int j = 0; j < 8; ++j) {
                        f32x2 t = sa2 * b2[j] + S[i][j] * w2[j];
                        if (MODE >= 1) { const f32x2 v2 = (f32x2){vv[i], vv[i]}; t = v2 * k2[j] + t; }
                        S[i][j] = t;
                    }
                }
                if (MODE == 2) {
                    f32x2 y;
#pragma unroll
                    for (int i = 0; i < R; ++i) {
                        f32x2 p0 = S[i][0] * r2[0], p1 = S[i][1] * r2[1];
#pragma unroll
                        for (int j = 2; j < 8; j += 2) { p0 = S[i][j] * r2[j] + p0; p1 = S[i][j + 1] * r2[j + 1] + p1; }
                        p0 = p0 + p1; y[i & 1] = quad_sum(p0.x + p0.y);
                    }
                    if (ks == 0) *(LAS f32x2*)(LY + s * 64 + row0) = y;
                }
                if (PASS == 0) {
                    f32x4 y;
#pragma unroll
                    for (int i = 0; i < R; ++i) {
                        f32x2 p0 = S[i][0] * r2[0], p1 = S[i][1] * r2[1];
#pragma unroll
                        for (int j = 2; j < 8; j += 2) { p0 = S[i][j] * r2[j] + p0; p1 = S[i][j + 1] * r2[j + 1] + p1; }
                        p0 = p0 + p1; y[i & 3] = quad_sum(p0.x + p0.y);
                    }
                    if (ks == 0) *(LAS f32x4*)(LY + role * 512 + s * 64 + row0) = y;
                }
            }
        }
        if (PASS == 0 && active) {
            asm volatile("s_waitcnt lgkmcnt(0)" ::: "memory"); __builtin_amdgcn_wave_barrier();
            GAS bf16* dst = (MODE == 0) ? ((b == 0 ? X.Q0 : X.Q1) + (size_t)((mb & (T - 1))) * 512 + hc) : (X.ZB + (size_t)mb * 512 + hc);
#pragma unroll
            for (int s = 0; s < 8; ++s) dst[(size_t)s * 512] = (bf16)f2bf(LY[role * 512 + s * 64 + lane]);
        }
        if (MODE == 2) LBAR();
        if (MODE == 2) {
            if (active) {
#pragma unroll
                for (int j = 0; j < 4; ++j) {
                    const int s = s0 + j, m = mb + s;
                    const float y = LY[s * 64 + lane];
                    const float mean = wave_sum_dpp(y) * (1.0f / 64.0f); const float d = y - mean; const float var = wave_sum_dpp(d * d) * (1.0f / 64.0f);
                    float yn = d * rsqrtf(var + 64e-5f) * lnw + lnb;
                    yn += LBon[s] * LV[s * 64 + lane];
                    const float g = __uint_as_float(gq[j] << 16);
                    X.ZB[(size_t)m * 512 + hc] = (bf16)f2bf(yn * g);
                }
            }
        }
    }
    if (MODE <= 1 && active) {
        GAS float* dst = (MODE == 0 ? X.PC : X.NS) + (size_t)cid * 4096;
#pragma unroll
        for (int i = 0; i < R; ++i)
#pragma unroll
            for (int q = 0; q < 4; ++q) *(GAS f32x4*)(dst + (row0 + i) * 64 + ks * 16 + q * 4) = (f32x4){S[i][2 * q].x, S[i][2 * q].y, S[i][2 * q + 1].x, S[i][2 * q + 1].y};
    }
}
#define MF4(a, b, c) __builtin_amdgcn_mfma_f32_16x16x4f32((a), (b), (c), 0, 0, 0)
struct RawB { unsigned r[9], k[9], v[9], ic[8], lw[16]; };
__device__ __forceinline__ void load_rawb(const ScanCtx& X, int mblk, int role, bool prev_valid, int hc, RawB& q) {
    const int ms = mblk + role * 8;
#pragma unroll
    for (int j = 0; j < 9; ++j) {
        const int m = (j == 0 && !prev_valid) ? ms : (ms - 1 + j);
        const GAS bf16* row = X.PB + (size_t)m * 1792;
        q.r[j] = row[hc]; q.k[j] = row[512 + hc]; q.v[j] = row[1024 + hc];
    }
    if (!prev_valid) { q.r[0] = 0u; q.k[0] = 0u; q.v[0] = 0u; }
#pragma unroll
    for (int j = 0; j < 8; ++j) q.ic[j] = X.ICLR[(size_t)(ms + j) * 512 + hc];
#pragma unroll
    for (int j = 0; j < 16; ++j) q.lw[j] = X.LOGW[(size_t)(mblk + j) * 512 + hc];
}
#ifndef DBG_STAGE
#define DBG_STAGE 3
#endif
template <int MODE>
__device__ __forceinline__ void scan_a_mfma(const ScanCtx& X, int cid, bool active, LAS float* pl, int lane) {
    asm volatile("" : "+v"(lane));
    constexpr int role = MODE;
    const int bh = cid >> 6, c = cid & 63, b = bh >> 3, h = bh & 7;
    const int m0 = b * T + c * 128;
    const int l16 = lane & 15, lq = lane >> 4, hc = h * 64 + lane;
    LAS float* AT = pl; LAS float* BT = pl + 1024; LAS float* KT = pl + 2048; LAS float* RT = pl + 3072; LAS float* VT = pl + 4096;
    LAS float* LI = pl + 5120; LAS float* GK = pl + 5376; LAS float* HB = pl + 5632; LAS float* HK = pl + 5888; LAS float* GAM = pl + 6144;
    f32x4 S[4][4];
#pragma unroll
    for (int mb = 0; mb < 4; ++mb)
#pragma unroll
        for (int nb = 0; nb < 4; ++nb)
#pragma unroll
            for (int rr = 0; rr < 4; ++rr) S[mb][nb][rr] = (MODE == 0 && (16 * mb + 4 * lq + rr) == (16 * nb + l16)) ? 1.f : 0.f;
    const float mu_r = X.mu[hc], mu_k = X.mu[512 + hc], mu_v = X.mu[1024 + hc];
    const float kk_c = X.k_k[hc], ka_c = X.k_a[hc], rk_c = X.r_k[hc];
    RawB cur;
    if (active) load_rawb(X, m0, role, !(c == 0 && role == 0), hc, cur);
    for (int blk = 0; blk < 8; ++blk) {
        const int mblk = m0 + blk * 16;
        if (active) {
            float cl[17]; cl[0] = 0.f;
#pragma unroll
            for (int t = 0; t < 16; ++t) cl[t + 1] = cl[t] + __uint_as_float(cur.lw[t] << 16);
#pragma unroll
            for (int j = 0; j < 8; ++j) {
                const int t = role * 8 + j;
                const float rc = __uint_as_float(cur.r[j + 1] << 16), kc = __uint_as_float(cur.k[j + 1] << 16), vc = __uint_as_float(cur.v[j + 1] << 16);
                const float rp = __uint_as_float(cur.r[j] << 16), kp = __uint_as_float(cur.k[j] << 16), vp = __uint_as_float(cur.v[j] << 16);
                const float rr_ = rc + (rp - rc) * mu_r, k = kc + (kp - kc) * mu_k, v = vc + (vp - vc) * mu_v;
                const float ic = __uint_as_float(cur.ic[j] << 16);
                float kk = k * kk_c; const float n2 = wave_sum_dpp(kk * kk); kk = kk * rsqrtf(fmaxf(n2, 1e-24f));
                const float k2 = k * (1.0f + (ic - 1.0f) * ka_c);
                const float e_prev = __expf(cl[t]), e_cur = __expf(cl[t + 1]), i_cur = __expf(-cl[t + 1]);
                AT[t * 64 + lane] = -kk * e_prev; BT[t * 64 + lane] = kk * ic * i_cur; KT[t * 64 + lane] = k2 * i_cur; RT[t * 64 + lane] = rr_ * e_cur; VT[t * 64 + lane] = v;
                const float bon = wave_sum_dpp(rr_ * k2 * rk_c); if (lane == 0) X.BON[(size_t)(mblk + t) * 8 + h] = bon;
                asm volatile("" ::: "memory");
            }
            if (MODE == 0) GAM[lane] = __expf(cl[16]);
            if (blk < 7) load_rawb(X, mblk + 16, role, true, hc, cur);
        }
        LBAR();
        if (active && DBG_STAGE >= 2) {
            f32x4 a4[4], b4[4];
            if (MODE == 0) {
                f32x4 g = (f32x4){0.f, 0.f, 0.f, 0.f};
#pragma unroll
                for (int q = 0; q < 4; ++q) { a4[q] = *(const LAS f32x4*)(AT + l16 * 64 + 16 * lq + 4 * q); b4[q] = *(const LAS f32x4*)(BT + l16 * 64 + 16 * lq + 4 * q); }
#pragma unroll
                for (int kk = 0; kk < 16; ++kk) g = MF4(a4[kk >> 2][kk & 3], b4[kk >> 2][kk & 3], g);
#pragma unroll
                for (int rr = 0; rr < 4; ++rr) LI[(4 * lq + rr) * 16 + l16] = (l16 < 4 * lq + rr) ? g[rr] : 0.f;
#define WSYNC() do { asm volatile("s_waitcnt lgkmcnt(0)" ::: "memory"); __builtin_amdgcn_wave_barrier(); } while (0)
#define MM16(Am, Bm, cacc) do { const f32x4 a_ = *(const LAS f32x4*)((Am) + l16 * 16 + 4 * lq); _Pragma("unroll") for (int r_ = 0; r_ < 4; ++r_) cacc = MF4(a_[r_], (Bm)[(4 * lq + r_) * 16 + l16], cacc); } while (0)
#define ST16(Dm, cacc) do { _Pragma("unroll") for (int r_ = 0; r_ < 4; ++r_) (Dm)[(4 * lq + r_) * 16 + l16] = cacc[r_]; } while (0)
                LAS float* M2 = pl + 6208; LAS float* M4 = pl + 6464; LAS float* M8 = pl + 6720; LAS float* TT = pl + 6976;
                const f32x4 z4 = (f32x4){0.f, 0.f, 0.f, 0.f};
                WSYNC();
                f32x4 c2 = z4; MM16(LI, LI, c2); ST16(M2, c2);
                f32x4 t1;
#pragma unroll
                for (int rr = 0; rr < 4; ++rr) t1[rr] = LI[(4 * lq + rr) * 16 + l16] + ((4 * lq + rr) == l16 ? 1.f : 0.f);
                ST16(TT, t1);
                WSYNC();
                f32x4 c4 = z4; MM16(M2, M2, c4); ST16(M4, c4);
                f32x4 t2 = t1; MM16(TT, M2, t2);
                WSYNC();
                ST16(TT, t2);
                WSYNC();
                f32x4 c8 = z4; MM16(M4, M4, c8); ST16(M8, c8);
                f32x4 t4 = t2; MM16(TT, M4, t4);
                WSYNC();
                ST16(TT, t4);
                WSYNC();
                f32x4 t8 = t4; MM16(TT, M8, t8);
                WSYNC();
                ST16(LI, t8);
            } else {
                f32x4 r4[4], k4[4];
#pragma unroll
                for (int q = 0; q < 4; ++q) { a4[q] = *(const LAS f32x4*)(AT + l16 * 64 + 16 * lq + 4 * q); b4[q] = *(const LAS f32x4*)(BT + l16 * 64 + 16 * lq + 4 * q);
                                              r4[q] = *(const LAS f32x4*)(RT + l16 * 64 + 16 * lq + 4 * q); k4[q] = *(const LAS f32x4*)(KT + l16 * 64 + 16 * lq + 4 * q); }
                f32x4 gk = (f32x4){0.f, 0.f, 0.f, 0.f}, hb = gk, hk = gk;
#pragma unroll
                for (int kk = 0; kk < 16; ++kk) { gk = MF4(a4[kk >> 2][kk & 3], k4[kk >> 2][kk & 3], gk); hb = MF4(r4[kk >> 2][kk & 3], b4[kk >> 2][kk & 3], hb); hk = MF4(r4[kk >> 2][kk & 3], k4[kk >> 2][kk & 3], hk); }
#pragma unroll
                for (int rr = 0; rr < 4; ++rr) { const int t = 4 * lq + rr; GK[t * 16 + l16] = (l16 < t) ? gk[rr] : 0.f; HB[t * 16 + l16] = (l16 <= t) ? hb[rr] : 0.f; HK[t * 16 + l16] = (l16 <= t) ? hk[rr] : 0.f; }
            }
        }
        LBAR();
        if (active && DBG_STAGE >= 3) {
            f32x4 Wt[4], Ut[4], Yt[4];
#pragma unroll
            for (int nb = 0; nb < 4; ++nb) { Wt[nb] = (f32x4){0.f, 0.f, 0.f, 0.f}; Ut[nb] = Wt[nb]; Yt[nb] = Wt[nb]; }
#pragma unroll
            for (int mb = 0; mb < 4; ++mb) {
                const f32x4 at = *(const LAS f32x4*)(AT + l16 * 64 + 16 * mb + 4 * lq);
#pragma unroll
                for (int rr = 0; rr < 4; ++rr)
#pragma unroll
                    for (int nb = 0; nb < 4; ++nb) Wt[nb] = MF4(at[rr], S[mb][nb][rr], Wt[nb]);
            }
            if (MODE == 1) {
                const f32x4 gk = *(const LAS f32x4*)(GK + l16 * 16 + 4 * lq);
#pragma unroll
                for (int nb = 0; nb < 4; ++nb) {
#pragma unroll
                    for (int rr = 0; rr < 4; ++rr) Wt[nb] = MF4(gk[rr], VT[(4 * lq + rr) * 64 + 16 * nb + l16], Wt[nb]);
                }
            }
            { const f32x4 li = *(const LAS f32x4*)(LI + l16 * 16 + 4 * lq);
#pragma unroll
              for (int rr = 0; rr < 4; ++rr)
#pragma unroll
                  for (int nb = 0; nb < 4; ++nb) Ut[nb] = MF4(li[rr], Wt[nb][rr], Ut[nb]); }
#pragma unroll
            for (int mb = 0; mb < 4; ++mb) {
                const f32x4 rt = *(const LAS f32x4*)(RT + l16 * 64 + 16 * mb + 4 * lq);
#pragma unroll
                for (int rr = 0; rr < 4; ++rr)
#pragma unroll
                    for (int nb = 0; nb < 4; ++nb) Yt[nb] = MF4(rt[rr], S[mb][nb][rr], Yt[nb]);
            }
            { const f32x4 hb = *(const LAS f32x4*)(HB + l16 * 16 + 4 * lq);
#pragma unroll
              for (int rr = 0; rr < 4; ++rr)
#pragma unroll
                  for (int nb = 0; nb < 4; ++nb) Yt[nb] = MF4(hb[rr], Ut[nb][rr], Yt[nb]); }
            if (MODE == 1) {
                const f32x4 hk = *(const LAS f32x4*)(HK + l16 * 16 + 4 * lq);
#pragma unroll
                for (int nb = 0; nb < 4; ++nb) {
#pragma unroll
                    for (int rr = 0; rr < 4; ++rr) Yt[nb] = MF4(hk[rr], VT[(4 * lq + rr) * 64 + 16 * nb + l16], Yt[nb]);
                }
            }
            { GAS bf16* dst = (MODE == 0) ? ((b == 0 ? X.Q0 : X.Q1) + (size_t)(mblk & (T - 1)) * 512 + h * 64) : (X.ZB + (size_t)mblk * 512 + h * 64);
#pragma unroll
              for (int nb = 0; nb < 4; ++nb)
#pragma unroll
                  for (int rr = 0; rr < 4; ++rr) dst[(size_t)(4 * lq + rr) * 512 + 16 * nb + l16] = (bf16)f2bf(Yt[nb][rr]); }
#pragma unroll
            for (int mb = 0; mb < 4; ++mb) {
#pragma unroll
                for (int rr = 0; rr < 4; ++rr) {
                    const float ab = BT[(4 * lq + rr) * 64 + 16 * mb + l16];
#pragma unroll
                    for (int nb = 0; nb < 4; ++nb) S[mb][nb] = MF4(ab, Ut[nb][rr], S[mb][nb]);
                }
                if (MODE == 1) {
#pragma unroll
                    for (int rr = 0; rr < 4; ++rr) {
                        const float ak = KT[(4 * lq + rr) * 64 + 16 * mb + l16];
#pragma unroll
                        for (int nb = 0; nb < 4; ++nb) S[mb][nb] = MF4(ak, VT[(4 * lq + rr) * 64 + 16 * nb + l16], S[mb][nb]);
                    }
                }
                const f32x4 g = *(const LAS f32x4*)(GAM + 16 * mb + 4 * lq);
#pragma unroll
                for (int nb = 0; nb < 4; ++nb) { S[mb][nb] = S[mb][nb] * g;
#pragma unroll
                    for (int e_ = 0; e_ < 4; ++e_) S[mb][nb][e_] = (S[mb][nb][e_] != S[mb][nb][e_]) ? 0.f : S[mb][nb][e_]; }
            }
        }
        LBAR();
    }
    if (active) {
        GAS float* dst = (MODE == 0 ? X.PC : X.NS) + (size_t)cid * 4096;
#pragma unroll
        for (int mb = 0; mb < 4; ++mb)
#pragma unroll
            for (int nb = 0; nb < 4; ++nb) *(GAS f32x4*)(dst + (16 * nb + l16) * 64 + 16 * mb + 4 * lq) = S[mb][nb];
    }
}
__device__ __forceinline__ void scan_c2(const ScanCtx& X, int cid, int half, LAS float* wl, int lane) {
    asm volatile("" : "+v"(lane));
    const int bh = cid >> 6, c = cid & 63, b = bh >> 3, h = bh & 7;
    const int m0 = b * T + c * 128 + half * 64;
    const int l16 = lane & 15, lq = lane >> 4, hc = h * 64 + lane;
    const GAS bf16* Qb = (b == 0 ? X.Q0 : X.Q1) + (size_t)(c * 128 + half * 64) * 512 + h * 64;
    float Bv[4][16];
#pragma unroll
    for (int vb = 0; vb < 4; ++vb)
#pragma unroll
        for (int j = 0; j < 16; ++j) Bv[vb][j] = 0.f;
    if (c > 0) {
        const GAS float* Sc = X.NS + (size_t)(cid - 1) * 4096;
#pragma unroll
        for (int vb = 0; vb < 4; ++vb)
#pragma unroll
            for (int j = 0; j < 4; ++j) { const f32x4 t = *(const GAS f32x4*)(Sc + (vb * 16 + l16) * 64 + 16 * lq + 4 * j); Bv[vb][4 * j] = t[0]; Bv[vb][4 * j + 1] = t[1]; Bv[vb][4 * j + 2] = t[2]; Bv[vb][4 * j + 3] = t[3]; }
    }
    const float mu_v = X.mu[1024 + hc], lnw = X.lnw[hc], lnb = X.lnb[hc];
    unsigned short y0r[16]; v4u qa, qb; unsigned vraw[17], graw[16]; float bon[16];
#define C2_LOAD(tbn) do { const int mt_ = m0 + (tbn) * 16; \
        _Pragma("unroll") for (int vb = 0; vb < 4; ++vb) _Pragma("unroll") for (int rr = 0; rr < 4; ++rr) y0r[vb * 4 + rr] = X.ZB[(size_t)(mt_ + 4 * lq + rr) * 512 + h * 64 + vb * 16 + l16]; \
        { const GAS bf16* qrow = Qb + (size_t)((tbn) * 16 + l16) * 512 + 16 * lq; qa = *(const GAS v4u*)qrow; qb = *(const GAS v4u*)(qrow + 8); } \
        { const int mp = (mt_ & (T - 1)) ? mt_ - 1 : mt_; vraw[0] = X.PB[(size_t)mp * 1792 + 1024 + hc]; if (!(mt_ & (T - 1))) vraw[0] = 0u; } \
        _Pragma("unroll") for (int tt = 0; tt < 16; ++tt) { vraw[tt + 1] = X.PB[(size_t)(mt_ + tt) * 1792 + 1024 + hc]; graw[tt] = X.GG[(size_t)(mt_ + tt) * 512 + hc]; bon[tt] = X.BON[(size_t)(mt_ + tt) * 8 + h]; } } while (0)
    C2_LOAD(0);
    for (int tb = 0; tb < 4; ++tb) {
        const int mt = m0 + tb * 16;
        f32x4 acc[4];
#pragma unroll
        for (int vb = 0; vb < 4; ++vb)
#pragma unroll
            for (int rr = 0; rr < 4; ++rr) acc[vb][rr] = __uint_as_float((unsigned)y0r[vb * 4 + rr] << 16);
        if (c > 0) {
            float Av[16];
            Av[0] = __uint_as_float(qa.x << 16); Av[1] = __uint_as_float(qa.x & 0xffff0000u); Av[2] = __uint_as_float(qa.y << 16); Av[3] = __uint_as_float(qa.y & 0xffff0000u);
            Av[4] = __uint_as_float(qa.z << 16); Av[5] = __uint_as_float(qa.z & 0xffff0000u); Av[6] = __uint_as_float(qa.w << 16); Av[7] = __uint_as_float(qa.w & 0xffff0000u);
            Av[8] = __uint_as_float(qb.x << 16); Av[9] = __uint_as_float(qb.x & 0xffff0000u); Av[10] = __uint_as_float(qb.y << 16); Av[11] = __uint_as_float(qb.y & 0xffff0000u);
            Av[12] = __uint_as_float(qb.z << 16); Av[13] = __uint_as_float(qb.z & 0xffff0000u); Av[14] = __uint_as_float(qb.w << 16); Av[15] = __uint_as_float(qb.w & 0xffff0000u);
#pragma unroll
            for (int kk = 0; kk < 16; ++kk)
#pragma unroll
                for (int vb = 0; vb < 4; ++vb) acc[vb] = __builtin_amdgcn_mfma_f32_16x16x4f32(Av[kk], Bv[vb][kk], acc[vb], 0, 0, 0);
        }
        unsigned vr[17], gr[16]; float bn[16];
#pragma unroll
        for (int tt = 0; tt < 16; ++tt) { vr[tt] = vraw[tt]; gr[tt] = graw[tt]; bn[tt] = bon[tt]; }
        vr[16] = vraw[16];
        if (tb < 3) C2_LOAD(tb + 1);
#pragma unroll
        for (int vb = 0; vb < 4; ++vb)
#pragma unroll
            for (int rr = 0; rr < 4; ++rr) wl[(4 * lq + rr) * 64 + vb * 16 + l16] = acc[vb][rr];
        asm volatile("s_waitcnt lgkmcnt(0)" ::: "memory"); __builtin_amdgcn_wave_barrier();
#pragma unroll
        for (int tt = 0; tt < 16; ++tt) {
            const float y = wl[tt * 64 + lane];
            const float mean = wave_sum_dpp(y) * (1.0f / 64.0f), ex2 = wave_sum_dpp(y * y) * (1.0f / 64.0f); const float d = y - mean; const float var = fmaxf(ex2 - mean * mean, 0.f);
            float yn = d * rsqrtf(var + 64e-5f) * lnw + lnb;
            const float vc = __uint_as_float(vr[tt + 1] << 16), vp = __uint_as_float(vr[tt] << 16);
            yn += bn[tt] * (vc + (vp - vc) * mu_v);
            X.ZB[(size_t)(mt + tt) * 512 + hc] = (bf16)f2bf(yn * __uint_as_float(gr[tt] << 16));
        }
        asm volatile("s_waitcnt lgkmcnt(0)" ::: "memory"); __builtin_amdgcn_wave_barrier();
    }
#undef C2_LOAD
}
struct PbBuf { float p[16]; float n[4]; };
__device__ __forceinline__ void pb_load(const ScanCtx& X, int bh, int c, int qr, int cb, int l16, int lq, PbBuf& q) {
    const GAS float* P = X.PC + (size_t)(bh * 64 + c) * 4096 + (16 * lq) * 64 + cb * 16 + l16; const GAS float* N = X.NS + (size_t)(bh * 64 + c) * 4096 + (16 * qr + 4 * lq) * 64 + cb * 16 + l16;
#pragma unroll
    for (int kk = 0; kk < 16; ++kk) q.p[kk] = P[kk * 64];
#pragma unroll
    for (int r = 0; r < 4; ++r) q.n[r] = N[r * 64];
}
__device__ __forceinline__ void pb_step(const ScanCtx& X, LAS float* Sr, LAS float* Sw, int bh, int c, int qr, int cb, int l16, int lq, const PbBuf& q, bool worker) {
    if (worker) {
        f32x4 acc = (f32x4){q.n[0], q.n[1], q.n[2], q.n[3]};
        f32x4 av[4];
#pragma unroll
        for (int j = 0; j < 4; ++j) av[j] = *(const LAS f32x4*)(Sr + l16 * 68 + 16 * lq + 4 * j);
        f32x4 acc1 = (f32x4){0.f, 0.f, 0.f, 0.f};
#pragma unroll
        for (int kk = 0; kk < 16; kk += 2) { acc = __builtin_amdgcn_mfma_f32_16x16x4f32(av[kk >> 2][kk & 3], q.p[kk], acc, 0, 0, 0); acc1 = __builtin_amdgcn_mfma_f32_16x16x4f32(av[(kk + 1) >> 2][(kk + 1) & 3], q.p[kk + 1], acc1, 0, 0, 0); }
        acc = acc + acc1;
        GAS float* N = X.NS + (size_t)(bh * 64 + c) * 4096 + (16 * qr + 4 * lq) * 64 + cb * 16 + l16;
#pragma unroll
        for (int r = 0; r < 4; ++r) { Sw[(4 * lq + r) * 68 + cb * 16 + l16] = acc[r]; N[r * 64] = acc[r]; }
    }
    asm volatile("s_waitcnt lgkmcnt(0)" ::: "memory"); __builtin_amdgcn_s_barrier(); asm volatile("" ::: "memory");
}
__device__ __forceinline__ void scan_pass_b(const ScanCtx& X, LAS unsigned char* lds, int wb, int tid, int lane, int wave) {
    asm volatile("" : "+v"(lane), "+v"(tid));
    LAS float* S0 = (LAS float*)lds; LAS float* S1 = S0 + 16 * 68;
    for (int i = tid; i < 16 * 68; i += 512) S0[i] = 0.f;
    __syncthreads();
    const int xcd_ = wb & 7, slot_ = wb >> 3;
    const int bh = xcd_ * 2 + (slot_ >> 2), qr = slot_ & 3, cb = wave & 3, l16 = lane & 15, lq = lane >> 4; const bool wk = wave < 4;
    PbBuf q0, q1, q2, q3, q4, q5;
    if (wk) { pb_load(X, bh, 0, qr, cb, l16, lq, q0); pb_load(X, bh, 1, qr, cb, l16, lq, q1); pb_load(X, bh, 2, qr, cb, l16, lq, q2);
              pb_load(X, bh, 3, qr, cb, l16, lq, q3); pb_load(X, bh, 4, qr, cb, l16, lq, q4); pb_load(X, bh, 5, qr, cb, l16, lq, q5); }
    for (int c = 0; c < 60; c += 6) {
        pb_step(X, S0, S1, bh, c, qr, cb, l16, lq, q0, wk);     if (wk && c + 6 < 63) pb_load(X, bh, c + 6, qr, cb, l16, lq, q0);
        pb_step(X, S1, S0, bh, c + 1, qr, cb, l16, lq, q1, wk); if (wk && c + 7 < 63) pb_load(X, bh, c + 7, qr, cb, l16, lq, q1);
        pb_step(X, S0, S1, bh, c + 2, qr, cb, l16, lq, q2, wk); if (wk && c + 8 < 63) pb_load(X, bh, c + 8, qr, cb, l16, lq, q2);
        pb_step(X, S1, S0, bh, c + 3, qr, cb, l16, lq, q3, wk); if (wk && c + 9 < 63) pb_load(X, bh, c + 9, qr, cb, l16, lq, q3);
        pb_step(X, S0, S1, bh, c + 4, qr, cb, l16, lq, q4, wk); if (wk && c + 10 < 63) pb_load(X, bh, c + 10, qr, cb, l16, lq, q4);
        pb_step(X, S1, S0, bh, c + 5, qr, cb, l16, lq, q5, wk); if (wk && c + 11 < 63) pb_load(X, bh, c + 11, qr, cb, l16, lq, q5);
    }
    pb_step(X, S0, S1, bh, 60, qr, cb, l16, lq, q0, wk); pb_step(X, S1, S0, bh, 61, qr, cb, l16, lq, q1, wk); pb_step(X, S0, S1, bh, 62, qr, cb, l16, lq, q2, wk);
}

__device__ __forceinline__ void phase_final(tab_t tab, int lane, int wave) {
    asm volatile("" : "+v"(lane));
    GAS float* out = OUTP(); const GAS float* g = INP(26);
    const int gw = blockIdx.x * NWAVES + wave, NGW = gridDim.x * NWAVES;
    f32x4 gv[4];
#pragma unroll
    for (int j = 0; j < 4; ++j) gv[j] = ((const GAS f32x4*)g)[lane + 64 * j];
    for (int m = gw; m < M; m += 4 * NGW) {
        f32x4 v[4][4]; float s[4];
#pragma unroll
        for (int q = 0; q < 4; ++q) { const int mq = m + q * NGW; const GAS f32x4* xr = (const GAS f32x4*)(out + (size_t)(mq < M ? mq : m) * D) + lane;
#pragma unroll
            for (int j = 0; j < 4; ++j) v[q][j] = xr[64 * j]; }
#pragma unroll
        for (int q = 0; q < 4; ++q) { float t = 0.f;
#pragma unroll
            for (int j = 0; j < 4; ++j) t += (v[q][j][0] * v[q][j][0] + v[q][j][1] * v[q][j][1]) + (v[q][j][2] * v[q][j][2] + v[q][j][3] * v[q][j][3]);
            s[q] = rsqrtf(wave_sum_dpp(t) * (1.0f / D) + 1e-6f); }
#pragma unroll
        for (int q = 0; q < 4; ++q) { const int mq = m + q * NGW; if (mq < M) { GAS f32x4* xw = (GAS f32x4*)(out + (size_t)mq * D) + lane;
#pragma unroll
            for (int j = 0; j < 4; ++j) xw[64 * j] = v[q][j] * s[q] * gv[j]; } }
    }
}

#define RLX_AGENT __ATOMIC_RELAXED, __HIP_MEMORY_SCOPE_AGENT
#define XB_TMO      128
#define XB_XCNT(j)  (256  + 64 * (j))
#define XB_XSUB(j)  (1280 + 64 * (j))
#define XB_XGEN(j)  (2304 + 64 * (j))
#define XB_TOP      3328
#define XB_TOPGEN   3392
#define XCD_BAR_WORDS 3456
#define XB_SPIN_CAP (1u << 18)

__device__ __forceinline__ unsigned xb_ld(unsigned* p)              { return __hip_atomic_load(p, __ATOMIC_RELAXED, __HIP_MEMORY_SCOPE_AGENT); }
__device__ __forceinline__ unsigned xb_add(unsigned* p, unsigned v) { return __hip_atomic_fetch_add(p, v, __ATOMIC_RELAXED, __HIP_MEMORY_SCOPE_AGENT); }
__device__ __forceinline__ unsigned xb_xcc_id() { return (unsigned)__builtin_amdgcn_s_getreg((3 << 11) | 20) & 0xFu; }
#define XB_SPIN(cond, bar) do { unsigned _sp = 0; while (cond) { __builtin_amdgcn_s_sleep(1); \
    if ((++_sp & 255u) == 0u) { if (xb_ld(&(bar)[XB_TMO])) break; if (_sp > XB_SPIN_CAP) { atomicAdd(&(bar)[XB_TMO], 1u); break; } } } } while (0)

struct XcdBarrier {
    unsigned* bar; unsigned x;
    volatile LAS unsigned* st;
};

__device__ __forceinline__ XcdBarrier xcd_barrier_post(unsigned* bar, volatile LAS unsigned* st) {
    XcdBarrier b; b.bar = bar; b.x = xb_xcc_id(); b.st = st;
    if (threadIdx.x == 0) (void)xb_add(&bar[XB_XCNT(b.x)], 1u);
    return b;
}
__device__ __forceinline__ void xcd_barrier_complete(unsigned* bar, unsigned x, unsigned& nloc, unsigned& nx) {
    const unsigned G = gridDim.x * gridDim.y * gridDim.z;
    unsigned sum, cnt, mine, sp = 0u;
    for (;;) {
        sum = 0u; cnt = 0u; mine = 0u;
#pragma unroll
        for (unsigned j = 0; j < 16; ++j) { const unsigned c = xb_ld(&bar[XB_XCNT(j)]); sum += c; cnt += (c > 0u) ? 1u : 0u; mine = (j == x) ? c : mine; }
        if (sum == G) break;
        __builtin_amdgcn_s_sleep(1);
        if ((++sp & 255u) == 0u) { if (xb_ld(&bar[XB_TMO])) break; if (sp > XB_SPIN_CAP) { atomicAdd(&bar[XB_TMO], 1u); break; } }
    }
    nloc = mine > 0u ? mine : 1u; nx = cnt > 0u ? cnt : 1u;
}

__device__ __forceinline__ void xcd_barrier(const XcdBarrier& b) {
    asm volatile("s_waitcnt vmcnt(0)" ::: "memory");
    __syncthreads();
    if (threadIdx.x == 0) {
        unsigned* bar = b.bar;
        __builtin_amdgcn_s_waitcnt(0);
        unsigned nloc = b.st[0], nx = b.st[1];
        if (nloc == 0u) { xcd_barrier_complete(bar, b.x, nloc, nx); b.st[0] = nloc; b.st[1] = nx; }
        const unsigned old = xb_add(&bar[XB_XSUB(b.x)], 1u);
        const unsigned gen = old / nloc;
        if (old + 1u == (gen + 1u) * nloc) {
            __builtin_amdgcn_fence(__ATOMIC_RELEASE, "agent");
            asm volatile("s_waitcnt vmcnt(0)" ::: "memory");
            const unsigned og = xb_add(&bar[XB_TOP], 1u);
            const unsigned tg = og / nx;
            if (og + 1u == (tg + 1u) * nx) xb_add(&bar[XB_TOPGEN], 1u);
            else XB_SPIN(xb_ld(&bar[XB_TOPGEN]) == tg, bar);
            __builtin_amdgcn_fence(__ATOMIC_ACQUIRE, "agent");
            xb_add(&bar[XB_XGEN(b.x)], 1u);
            asm volatile("s_waitcnt vmcnt(0)" ::: "memory");
        } else {
            XB_SPIN(xb_ld(&bar[XB_XGEN(b.x)]) == gen, bar);
            __builtin_amdgcn_fence(__ATOMIC_ACQUIRE, "agent");
            asm volatile("s_waitcnt vmcnt(0)" ::: "memory");
        }
    }
    __syncthreads();
}

__device__ __forceinline__ ScanCtx make_scan_ctx(tab_t tab) {
    GAS unsigned char* ws = WSP();
    ScanCtx X; X.PB = (const GAS bf16*)(ws + WS_PB); X.LOGW = (const GAS bf16*)(ws + WS_LOGW); X.ICLR = (const GAS bf16*)(ws + WS_ICLR); X.GG = (const GAS bf16*)(ws + WS_GG); X.ZB = (GAS bf16*)(ws + WS_ZB);
    X.PC = (GAS float*)(ws + WS_PC); X.NS = (GAS float*)(ws + WS_NS); X.Q0 = (GAS bf16*)(ws + WS_Q0); X.Q1 = (GAS bf16*)(ws + WS_Q1); X.BON = (GAS float*)(ws + WS_BON); X.mu = INP(9); X.k_k = INP(15); X.k_a = INP(16); X.r_k = INP(17); X.lnw = INP(18); X.lnb = INP(19);
    return X;
}
__global__ void __launch_bounds__(NWAVES * 64, 2) fwd(Args a) {
    extern __shared__ __attribute__((aligned(16))) unsigned char lds_raw[];
    LAS unsigned char* lds = (LAS unsigned char*)lds_raw;
    const int tid = threadIdx.x, lane = tid & 63, wave = __builtin_amdgcn_readfirstlane(tid >> 6);
    const int G = gridDim.x;
    { LAS unsigned long long* tw = (LAS unsigned long long*)(lds + TAB_OFF);
      if (tid == 0) {
#pragma unroll
          for (int i = 0; i < 27; ++i) tw[i] = (unsigned long long)a.in[i];
          tw[27] = (unsigned long long)a.out; tw[28] = (unsigned long long)a.ws; }
      if (tid < 2) ((LAS unsigned*)(lds + MISC_OFF))[tid] = 0u;
      __syncthreads(); }
    (void)xcd_barrier_post((unsigned*)a.ws + CW_BAR, (volatile LAS unsigned*)(lds + MISC_OFF));
    const tab_t tab = (tab_t)(lds + TAB_OFF);
    const int ph_lo = a.ph_lo, ph_hi = a.ph_hi;

    unsigned long long tp0 = 0, tp1 = 0;
    for (int p = ph_lo; p < ph_hi; ++p) {
      if (PROBE_TIMEPH >= 0 && p == PROBE_TIMEPH) tp0 = __builtin_amdgcn_s_memrealtime();
      if (PROBE_TIMEPH >= 0 && p == PROBE_TIMEPH + 1) tp1 = __builtin_amdgcn_s_memrealtime();
      for (int rep = 0; rep <= ((PROBE_REPMASK >> p) & 1); ++rep) {
        pg8::Gemm g{nullptr, nullptr, M, 0, 0}; bool isg = false;
        switch (p) {
        case 0: phase_prologue(tab, lds, tid, lane, wave); break;
        case 4: phase_prep(tab, tid); break;
        case 6: { const ScanCtx X = make_scan_ctx(tab); const int pi = wave & 3, role = wave >> 2; LAS float* pl = (LAS float*)lds + pi * SCAN_WAVE_FLOATS;
                  for (int base = 0; base < 1024; base += 4 * G) { const int cid = base + pi * G + (int)blockIdx.x; const bool act = cid < 1024;
                      if (role == 0) scan_a_mfma<0>(X, act ? cid : 0, act, pl, lane); else scan_a_mfma<1>(X, act ? cid : 0, act, pl, lane); } } break;
        case 7: if (blockIdx.x < 64) { const ScanCtx X = make_scan_ctx(tab); if (PROBE_TIMEPH == 107) tp0 = __builtin_amdgcn_s_memrealtime(); scan_pass_b(X, lds, (int)blockIdx.x, tid, lane, wave); if (PROBE_TIMEPH == 107) tp1 = __builtin_amdgcn_s_memrealtime(); }
                else weights_set1(tab, lds, lane, wave, ((int)blockIdx.x - 64) * NWAVES + wave, (G - 64) * NWAVES);
                break;
        case 8: { const ScanCtx X = make_scan_ctx(tab); LAS float* wl = (LAS float*)lds + wave * 1024;
                  for (int task = wave * G + (int)blockIdx.x; task < 2048; task += NWAVES * G) scan_c2(X, task >> 1, task & 1, wl, lane); } break;
        case 15: phase_final(tab, lane, wave); break;
        default: {
            GAS unsigned char* ws = WSP(); isg = true;
            const size_t aoff = (p == 2 || p == 14) ? WS_HID : (p == 5) ? WS_LIN : (p == 10) ? WS_ZA : (p == 11) ? WS_ZB : (p == 12) ? WS_MRG : WS_XB;
            const size_t boff = (p == 1) ? WS_W1GU : (p == 2) ? WS_W1D : (p == 3) ? WS_WIN : (p == 5) ? WS_WL : (p == 9) ? (WS_WIN + (size_t)3328 * D * 2) : (p == 10) ? WS_WOA : (p == 11) ? WS_WOB : (p == 12) ? WS_WO : (p == 13) ? WS_W2GU : WS_W2D;
            const int N = (p == 1 || p == 13) ? 2 * FF : (p == 3) ? 3328 : (p == 5) ? 1536 : (p == 9) ? 2048 : D;
            const int K = (p == 2 || p == 14) ? FF : (p == 5) ? 256 : (p == 10 || p == 11) ? 512 : D;
            typedef const unsigned short* gen_cbf16p; g = pg8::Gemm{(gen_cbf16p)(ws + aoff), (gen_cbf16p)(ws + boff), M, N, K}; } break;
        }
        if (isg) { pg8::Epi E{p, tab}; pg8::StaticOrder S; S.init(M, g.N, G, (int)blockIdx.x); pg8::gemm_phase<pg8::Epi, pg8::StaticOrder, true, true>(lds, g, S, E); }
      }
        if (p + 1 < ph_hi) { for (int sr = 0; sr < PROBE_SYNCREP; ++sr) {
            if (ph_hi > NPH) { __syncthreads(); cg::this_grid().sync(); }
            else { XcdBarrier bar; bar.bar = (unsigned*)WSP() + CW_BAR; bar.x = xb_xcc_id(); bar.st = (volatile LAS unsigned*)(lds + MISC_OFF); xcd_barrier(bar); } } }
    }
    if (PROBE_TIMEPH >= 0 && blockIdx.x == 0) { const unsigned long long span = (tp1 - tp0) * 9ull, t2 = __builtin_amdgcn_s_memrealtime(); while (__builtin_amdgcn_s_memrealtime() - t2 < span) __builtin_amdgcn_s_sleep(8); }
}

extern "C" void kernel_launch(void* const* d_in, const int* in_sizes, int n_in, void* d_out, int out_size, void* d_ws, size_t ws_size, hipStream_t stream) {
    static int grid = 0;
    if (grid == 0) {
        if (n_in != 27 || in_sizes[0] != M * D || out_size != M * D || ws_size < WS_END) { fprintf(stderr, "kernel_launch: unexpected shapes (n_in %d, in0 %d, out %d, ws %zu)\n", n_in, n_in > 0 ? in_sizes[0] : -1, out_size, ws_size); grid = -1; return; }
        int dev = 0, cus = 0, per_cu = 0;
        if (hipGetDevice(&dev) != hipSuccess || hipDeviceGetAttribute(&cus, hipDeviceAttributeMultiprocessorCount, dev) != hipSuccess) { grid = -1; return; }
        if (hipFuncSetAttribute((const void*)fwd, hipFuncAttributeMaxDynamicSharedMemorySize, LDS_BYTES) != hipSuccess) { fprintf(stderr, "kernel_launch: hipFuncSetAttribute failed\n"); grid = -1; return; }
        if (hipOccupancyMaxActiveBlocksPerMultiprocessor(&per_cu, (const void*)fwd, NWAVES * 64, LDS_BYTES) != hipSuccess || per_cu < 1) { fprintf(stderr, "kernel_launch: occupancy query says %d blocks per CU: this kernel cannot be resident, nothing launched\n", per_cu); (void)hipGetLastError(); grid = -1; return; }
        grid = cus * 1;
    }
    if (grid < 0) return;
    if (hipMemsetAsync(d_ws, 0, CTL_ZERO_BYTES, stream) != hipSuccess) { fprintf(stderr, "kernel_launch: hipMemsetAsync failed\n"); return; }
    Args a{};
    for (int i = 0; i < 27; ++i) a.in[i] = (const float*)d_in[i];
    a.out = (float*)d_out; a.ws = (unsigned char*)d_ws;
#if MK_PER_PHASE
    for (int p = 0; p < NPH; ++p) { a.ph_lo = p; a.ph_hi = p + 1; hipLaunchKernelGGL(fwd, dim3(grid), dim3(NWAVES * 64), LDS_BYTES, stream, a); }
#else
    a.ph_lo = 0; a.ph_hi = NPH;
    void* args[] = {&a};
    hipError_t e = hipLaunchCooperativeKernel((const void*)fwd, dim3(grid), dim3(NWAVES * 64), args, LDS_BYTES, stream);
    if (e != hipSuccess) fprintf(stderr, "kernel_launch: cooperative launch failed: %s (grid %d)\n", hipGetErrorString(e), grid);
#endif
}
```

```cpp
#include <hip/hip_runtime.h>
#include <hip/hip_cooperative_groups.h>
#include <cstdio>
#include <cstdint>
namespace cg = cooperative_groups;

#ifndef MK_PER_PHASE
#define MK_PER_PHASE 0
#endif
#ifndef PROBE_REPMASK
#define PROBE_REPMASK 0
#endif
#define PROBE_SYNCREP 1
#define PROBE_PBDRY 0
#define PROBE_TIMEPH -1
constexpr int NWAVES = 8;
constexpr int T = 8192, D = 1024, M = 16384, FF = 2816, NPH = 16;
constexpr size_t MiB = 1u << 20;
constexpr size_t WS_W1GU = 1 * MiB, WS_W1D = 12 * MiB, WS_W2GU = 17 * MiB + MiB / 2, WS_W2D = 28 * MiB + MiB / 2, WS_WIN = 34 * MiB, WS_WOA = 44 * MiB + MiB / 2,
                 WS_WOB = 45 * MiB + MiB / 2, WS_WO = 46 * MiB + MiB / 2, WS_WL = 48 * MiB + MiB / 2;
constexpr size_t WS_XB = 50 * MiB, WS_SSQ0 = 82 * MiB, WS_SSQ1 = 83 * MiB, WS_SSQ2 = 84 * MiB, WS_R = 85 * MiB;
constexpr size_t WS_HID = WS_R, WS_PA = WS_R, WS_PB = WS_R + 48 * MiB, WS_ZA = WS_R + 104 * MiB, WS_LIN = WS_R + 120 * MiB, WS_NS = WS_R + 128 * MiB, WS_ZB = WS_R + 144 * MiB;
constexpr size_t WS_LOGW = WS_R, WS_ICLR = WS_R + 16 * MiB, WS_GG = WS_R + 32 * MiB;
constexpr size_t WS_PC = WS_W1GU;
constexpr size_t WS_SG = WS_R, WS_MRG = WS_R + 64 * MiB;
constexpr size_t WS_Q0 = WS_LIN, WS_Q1 = WS_R + 160 * MiB, WS_BON = WS_SSQ0;
constexpr size_t WS_END = WS_R + 168 * MiB;
static_assert(WS_END <= 256 * MiB, "workspace map");
constexpr int CW_BAR = 4096; constexpr size_t CTL_ZERO_BYTES = 65536;
constexpr int MISC_OFF = 131072 + 512;
constexpr int LDS_BYTES = 147456;
constexpr int SCAN_WAVE_FLOATS = 7424;

#define LAS __attribute__((address_space(3)))
#define GAS __attribute__((address_space(1)))
typedef unsigned short bf16;
typedef unsigned v4u __attribute__((ext_vector_type(4)));
typedef float f32x4 __attribute__((ext_vector_type(4)));
typedef float f32x16 __attribute__((ext_vector_type(16)));
#define LDS_WAIT() asm volatile("s_waitcnt lgkmcnt(0)" ::: "memory")
__device__ __forceinline__ unsigned f2bf(float f) { unsigned u = __builtin_bit_cast(unsigned, f); return (u + 0x7fffu + ((u >> 16) & 1u)) >> 16; }
__device__ __forceinline__ unsigned pk2(float lo, float hi) { return f2bf(lo) | (f2bf(hi) << 16); }
__device__ __forceinline__ float bf2f(bf16 h) { return __uint_as_float((unsigned)h << 16); }
__device__ __forceinline__ float wave_sum(float v) {
#pragma unroll
    for (int o = 1; o < 64; o <<= 1) v += __shfl_xor(v, o);
    return v;
}
__device__ __forceinline__ float dppf(float x, int ctrl_is_xor2) {
    const int xi = __builtin_bit_cast(int, x);
    const int r = ctrl_is_xor2 ? __builtin_amdgcn_update_dpp(xi, xi, 0x4E, 0xF, 0xF, false) : __builtin_amdgcn_update_dpp(xi, xi, 0xB1, 0xF, 0xF, false);
    return __builtin_bit_cast(float, r);
}
__device__ __forceinline__ float quad_sum(float x) { x += dppf(x, 0); x += dppf(x, 1); return x; }
__device__ __forceinline__ float sigmf(float x) { return __builtin_amdgcn_rcpf(1.0f + __expf(-x)); }
__device__ __forceinline__ float tanhf_(float x) { return 1.0f - 2.0f * __builtin_amdgcn_rcpf(1.0f + __expf(2.0f * x)); }

constexpr int TAB_OFF = 131072 + 1024;
typedef LAS const unsigned long long* tab_t;
__device__ __forceinline__ unsigned long long ldptr_(tab_t tab, int i) {
    const unsigned long long v = tab[i];
    const unsigned lo = __builtin_amdgcn_readfirstlane((unsigned)v), hi = __builtin_amdgcn_readfirstlane((unsigned)(v >> 32));
    return ((unsigned long long)hi << 32) | lo;
}
#define INP(i) ((const GAS float*)ldptr_(tab, (i)))
#define OUTP() ((GAS float*)ldptr_(tab, 27))
#define WSP() ((GAS unsigned char*)ldptr_(tab, 28))
namespace pg8 {
#define PG8_LAS __attribute__((address_space(3)))
typedef unsigned short bf16_t;
typedef short bf16x8 __attribute__((ext_vector_type(8)));
typedef float f32x4 __attribute__((ext_vector_type(4)));
typedef unsigned u32x4 __attribute__((ext_vector_type(4)));
constexpr int BM = 256, BK = 64, HALF = 128, HTB = HALF * BK * 2  , STAGE_BYTES = 8 * HTB, NXCD = 8, WGM = 8;

__host__ __device__ __forceinline__ int lds_byte(int r, int c) { const int st = (r >> 4) * 2 + (c >> 5), rr = r & 15, cc = c & 31, ob = rr * 64 + cc * 2; return st * 1024 + (ob ^ (((ob >> 9) & 1) << 5)); }
__host__ __device__ __forceinline__ void stage_rc(int b, int& R, int& C) { const int st = b / 1024, sb = b % 1024, swz = sb ^ (((sb >> 9) & 1) << 5); R = (st >> 1) * 16 + swz / 64; C = (st & 1) * 32 + (swz % 64) / 2; }
__host__ __device__ __forceinline__ int perm32(int rho) { const int n = rho >> 4, i = rho & 15; return 8 * (i >> 2) + 4 * n + (i & 3); }

struct Unit { int pm, pn; };
struct Gemm { const bf16_t* A; const bf16_t* Bt; int M, N, K; };

struct StaticOrder {
    int nM, nN, nwg, G, c, pair;
    __host__ __device__ void init(int M, int N, int G_, int c_, int pair_ = 0) { nM = M / BM; nN = N / BM; nwg = nM * nN; G = G_; c = c_; pair = pair_; }
    __host__ __device__ bool next(int i0, Unit& u) const {
        const int i = pair ? (i0 >> 1) : i0; const int shift = pair ? pair * (i0 & 1) : 0;
        const long L = (long)i * G + c; if (L >= nwg) return false;
        int wgid = (int)L; { const int q = nwg / NXCD, r = nwg % NXCD, xcd = wgid % NXCD, off = wgid / NXCD; wgid = (xcd < r ? xcd * (q + 1) : r * (q + 1) + (xcd - r) * q) + off; }
        const int nig = WGM * nN, gid = wgid / nig, fm = gid * WGM, gsz = (nM - fm) < WGM ? (nM - fm) : WGM;
        u.pm = fm + ((wgid % nig) % gsz); u.pn = (wgid % nig) / gsz + shift; return true;
    }
    __device__ __forceinline__ void a_ready(const Unit&) const {}
    __device__ __forceinline__ void done(const Unit&) const {}
};
__device__ __forceinline__ unsigned cvt_pk_bf16(float lo, float hi) { unsigned r; asm volatile("v_cvt_pk_bf16_f32 %0, %1, %2" : "=v"(r) : "v"(lo), "v"(hi)); return r; }
__device__ __forceinline__ float sigm(float x) { return __builtin_amdgcn_rcpf(1.0f + __expf(-x)); }
__device__ __forceinline__ void store8(GAS bf16_t* p, f32x4 a, f32x4 b) {
    u32x4 w; w.x = cvt_pk_bf16(a[0], a[1]); w.y = cvt_pk_bf16(a[2], a[3]); w.z = cvt_pk_bf16(b[0], b[1]); w.w = cvt_pk_bf16(b[2], b[3]);
    *(GAS u32x4*)p = w;
}
__device__ __forceinline__ void load8(const GAS bf16_t* p, f32x4& a, f32x4& b) {
    const u32x4 w = *(const GAS u32x4*)p;
    a[0] = __uint_as_float(w.x << 16); a[1] = __uint_as_float(w.x & 0xffff0000u); a[2] = __uint_as_float(w.y << 16); a[3] = __uint_as_float(w.y & 0xffff0000u);
    b[0] = __uint_as_float(w.z << 16); b[1] = __uint_as_float(w.z & 0xffff0000u); b[2] = __uint_as_float(w.w << 16); b[3] = __uint_as_float(w.w & 0xffff0000u);
}
enum { EM_SWIGLU = 0, EM_RESID = 1, EM_PAB = 2, EM_LORA = 3, EM_GATES = 4, EM_MERGE1 = 5, EM_MERGE2 = 6 };
struct Epi {
    static constexpr bool PERM = true, AFTER_DRAIN = false;
    int p; tab_t tab;
    __device__ __forceinline__ void operator()(const f32x4 (&acc)[2][2][4][2], const Unit& u, int wr, int wc, int fr, int fq) const {
        GAS unsigned char* ws = WSP();
        const int mode = (p == 1 || p == 13) ? EM_SWIGLU : (p == 2 || p == 12 || p == 14) ? EM_RESID : (p == 3) ? EM_PAB : (p == 5) ? EM_LORA : (p == 9) ? EM_GATES : (p == 10) ? EM_MERGE1 : EM_MERGE2;
        const GAS float* ssq = (const GAS float*)(ws + (p == 1 ? WS_SSQ0 : (p == 13 ? WS_SSQ2 : WS_SSQ1)));
        GAS bf16_t* o0 = nullptr; GAS bf16_t* o1 = nullptr; GAS bf16_t* o2 = nullptr; const GAS float* base = nullptr; GAS float* outf = nullptr; GAS float* ssq_out = nullptr; float scale = 1.f;
        const GAS bf16_t* sg = (const GAS bf16_t*)(ws + WS_SG); const GAS float* q0 = nullptr; const GAS float* q1 = nullptr;
        if (mode == EM_SWIGLU) o0 = (GAS bf16_t*)(ws + WS_HID);
        else if (mode == EM_RESID) { outf = OUTP(); base = (p == 2) ? INP(0) : (const GAS float*)outf; o0 = (p == 14) ? nullptr : (GAS bf16_t*)(ws + WS_XB);
                                     ssq_out = (p == 14) ? nullptr : (GAS float*)(ws + (p == 2 ? WS_SSQ1 : WS_SSQ2)); scale = (p == 12) ? 1.0f : 0.5f; }
        else if (mode == EM_PAB) { o0 = (GAS bf16_t*)(ws + WS_PA); o1 = (GAS bf16_t*)(ws + WS_PB); }
        else if (mode == EM_LORA) { o0 = (GAS bf16_t*)(ws + WS_LOGW); o1 = (GAS bf16_t*)(ws + WS_ICLR); o2 = (GAS bf16_t*)(ws + WS_GG); q0 = INP(10); q1 = INP(12); }
        else if (mode == EM_GATES) o0 = (GAS bf16_t*)(ws + WS_SG);
        else o0 = (GAS bf16_t*)(ws + WS_MRG);
        const int rowb = u.pm * BM + wr * 64 + fr;
        const int cw = wc * 32 + 8 * fq;
#pragma unroll
        for (int ai = 0; ai < 2; ++ai)
#pragma unroll
            for (int m = 0; m < 4; ++m) {
                const size_t row = (size_t)(rowb + ai * HALF + m * 16);
                float s = 1.f;
                if (mode == EM_SWIGLU || mode == EM_PAB || mode == EM_GATES) {
                    const GAS f32x4* q = (const GAS f32x4*)(ssq + row * 16);
                    const f32x4 a = q[0], b = q[1], c = q[2], d = q[3];
                    const f32x4 t = (a + b) + (c + d);
                    s = rsqrtf(((t[0] + t[1]) + (t[2] + t[3])) * (1.0f / 1024.0f) + 1e-6f);
                }
                if (mode == EM_SWIGLU) {
                    f32x4 h0, h1;
#pragma unroll
                    for (int j = 0; j < 4; ++j) {
                        const float g0 = acc[ai][0][m][0][j] * s, u0 = acc[ai][1][m][0][j] * s;
                        const float g1 = acc[ai][0][m][1][j] * s, u1 = acc[ai][1][m][1][j] * s;
                        h0[j] = g0 * sigm(g0) * u0; h1[j] = g1 * sigm(g1) * u1;
                    }
                    store8(o0 + row * 2816 + u.pn * 128 + cw, h0, h1);
                } else if (mode == EM_RESID) {
                    float part = 0.f;
#pragma unroll
                    for (int bj = 0; bj < 2; ++bj) {
                        const size_t off = row * 1024 + u.pn * 256 + bj * HALF + cw;
                        const f32x4 b0 = *(const GAS f32x4*)(base + off), b1 = *(const GAS f32x4*)(base + off + 4);
                        const f32x4 v0 = b0 + acc[ai][bj][m][0] * scale, v1 = b1 + acc[ai][bj][m][1] * scale;
                        *(GAS f32x4*)(outf + off) = v0; *(GAS f32x4*)(outf + off + 4) = v1;
                        if (o0) store8(o0 + off, v0, v1);
                        part += (v0[0] * v0[0] + v0[1] * v0[1]) + (v0[2] * v0[2] + v0[3] * v0[3]) + (v1[0] * v1[0] + v1[1] * v1[1]) + (v1[2] * v1[2] + v1[3] * v1[3]);
                    }
                    if (ssq_out) { part += __shfl_xor(part, 16); part += __shfl_xor(part, 32); if (fq == 0) ssq_out[row * 16 + u.pn * 4 + wc] = part; }
                } else {
#pragma unroll
                    for (int bj = 0; bj < 2; ++bj) {
                        const int col = u.pn * 256 + bj * HALF + cw;
                        f32x4 v0 = acc[ai][bj][m][0], v1 = acc[ai][bj][m][1];
                        if (mode == EM_PAB) {
                            v0 = v0 * s; v1 = v1 * s;
                            if (u.pn < 6) store8(o0 + row * 1536 + col, v0, v1); else store8(o1 + row * 1792 + (col - 1536), v0, v1);
                        } else if (mode == EM_LORA) {
                            const int sel = u.pn >> 1, c = col & 511;
                            if (sel == 0) {
                                const f32x4 p0 = *(const GAS f32x4*)(q0 + c), p1 = *(const GAS f32x4*)(q0 + c + 4);
#pragma unroll
                                for (int j = 0; j < 4; ++j) { v0[j] = -0.6065306597f * sigm(p0[j] + v0[j]); v1[j] = -0.6065306597f * sigm(p1[j] + v1[j]); }
                                store8(o0 + row * 512 + c, v0, v1);
                            } else if (sel == 1) {
                                const f32x4 p0 = *(const GAS f32x4*)(q1 + c), p1 = *(const GAS f32x4*)(q1 + c + 4);
#pragma unroll
                                for (int j = 0; j < 4; ++j) { v0[j] = sigm(p0[j] + v0[j]); v1[j] = sigm(p1[j] + v1[j]); }
                                store8(o1 + row * 512 + c, v0, v1);
                            } else store8(o2 + row * 512 + c, v0, v1);
                        } else if (mode == EM_GATES) {
#pragma unroll
                            for (int j = 0; j < 4; ++j) { v0[j] = sigm(v0[j] * s); v1[j] = sigm(v1[j] * s); }
                            store8(o0 + row * 2048 + col, v0, v1);
                        } else if (mode == EM_MERGE1) {
                            f32x4 g0, g1; load8(sg + row * 2048 + col, g0, g1);
                            store8(o0 + row * 1024 + col, g0 * v0, g1 * v1);
                        } else {
                            f32x4 g0, g1, m0, m1; load8(sg + row * 2048 + 1024 + col, g0, g1); load8(o0 + row * 1024 + col, m0, m1);
                            store8(o0 + row * 1024 + col, m0 + g0 * v0, m1 + g1 * v1);
                        }
                    }
                }
            }
    }
};

template <class Epi, class Sched, bool ALIGN_EPI = false, bool SP2 = false>
__device__ __forceinline__ void gemm_phase(PG8_LAS unsigned char* lds, const Gemm g, const Sched& S, const Epi& E) {
    const int tid = threadIdx.x, wid = __builtin_amdgcn_readfirstlane(tid >> 6), lane = tid & 63, wr = wid >> 2, wc = wid & 3, fr = lane & 15, fq = lane >> 4;
    const int K = g.K, nt = K / BK;
    unsigned voffA[2], voffB[2];
#pragma unroll
    for (int i = 0; i < 2; ++i) { int R, C; stage_rc(tid * 16 + i * 8192, R, C); const int Rb = Epi::PERM ? ((R & ~31) + perm32(R & 31)) : R;
        voffA[i] = (unsigned)(R * K + C) * 2u; voffB[i] = (unsigned)(Rb * K + C) * 2u; }
    const size_t kstep = (size_t)(BK * 2);
    const size_t hstep = (size_t)HALF * K * 2;
    const size_t tstep = 2 * hstep;
    const unsigned ldsw = (unsigned)wid * 1024u;
    const int aoff = lds_byte(wr * 64 + fr, fq * 8), boff = lds_byte(wc * 32 + fr, fq * 8);
#define PG8_SA(b, h) (((b) * 2 + (h)) * HTB)
#define PG8_SB(b, h) ((4 + (b) * 2 + (h)) * HTB)
#define PG8_STAGE(bufoff, gbase, voff) do { _Pragma("unroll") for (int _i = 0; _i < 2; ++_i) \
        __builtin_amdgcn_global_load_lds((const unsigned*)((const char*)(gbase) + (voff)[_i]), (PG8_LAS unsigned*)(lds + (bufoff) + ldsw + _i * 8192), 16, 0, 0); } while (0)
#define PG8_LDA(dst, b, h) do { _Pragma("unroll") for (int m = 0; m < 4; ++m) _Pragma("unroll") for (int k = 0; k < 2; ++k) dst[m][k] = *(const PG8_LAS bf16x8*)(lds + PG8_SA(b, h) + aoff + m * 2048 + k * 1024); } while (0)
#define PG8_LDB(dst, b, h) do { _Pragma("unroll") for (int n = 0; n < 2; ++n) _Pragma("unroll") for (int k = 0; k < 2; ++k) dst[n][k] = *(const PG8_LAS bf16x8*)(lds + PG8_SB(b, h) + boff + n * 2048 + k * 1024); } while (0)
#define PG8_MMA(ai, bj, At, Bt) do { __builtin_amdgcn_s_setprio(1); _Pragma("unroll") for (int m = 0; m < 4; ++m) _Pragma("unroll") for (int n = 0; n < 2; ++n) _Pragma("unroll") for (int k = 0; k < 2; ++k) \
        acc[ai][bj][m][n] = __builtin_amdgcn_mfma_f32_16x16x32_bf16(Bt[n][k], At[m][k], acc[ai][bj][m][n], 0, 0, 0); __builtin_amdgcn_s_setprio(0); } while (0)
#define PG8_WAIT_V(n) asm volatile("s_waitcnt vmcnt(" #n ")" ::: "memory")
#define PG8_WAIT_L(n) asm volatile("s_waitcnt lgkmcnt(" #n ")" ::: "memory")
#define PG8_BAR __builtin_amdgcn_s_barrier()
#define PG8_SCHED __builtin_amdgcn_sched_barrier(0)
    Unit cur, nxt; int ui = 0;
    if (!S.next(0, cur)) return;
    f32x4 acc[2][2][4][2];
#pragma unroll
    for (int a = 0; a < 2; ++a)
#pragma unroll
        for (int b = 0; b < 2; ++b)
#pragma unroll
            for (int m = 0; m < 4; ++m)
#pragma unroll
                for (int n = 0; n < 2; ++n) acc[a][b][m][n] = (f32x4){0.f, 0.f, 0.f, 0.f};
    bf16x8 At[4][2], B0[2][2], B1[2][2];
    const char* cA = (const char*)g.A + (size_t)cur.pm * tstep; const char* cB = (const char*)g.Bt + (size_t)cur.pn * tstep;
    S.a_ready(cur);
    if constexpr (SP2) {
        PG8_STAGE(PG8_SB(0, 0), cB, voffB); PG8_STAGE(PG8_SB(0, 1), cB + hstep, voffB); PG8_STAGE(PG8_SA(0, 0), cA, voffA); PG8_STAGE(PG8_SA(0, 1), cA + hstep, voffA);
        if (wr == 1) PG8_BAR;
        PG8_WAIT_V(2); PG8_BAR;
        PG8_STAGE(PG8_SB(1, 0), cB + kstep, voffB); PG8_STAGE(PG8_SA(1, 0), cA + kstep, voffA); PG8_STAGE(PG8_SB(1, 1), cB + hstep + kstep, voffB);
        PG8_WAIT_V(6); PG8_BAR;
    } else {
        PG8_STAGE(PG8_SB(0, 0), cB, voffB); PG8_STAGE(PG8_SA(0, 0), cA, voffA); PG8_STAGE(PG8_SB(0, 1), cB + hstep, voffB); PG8_STAGE(PG8_SA(0, 1), cA + hstep, voffA);
        if (wr == 1) PG8_BAR;
        PG8_WAIT_V(4); PG8_BAR;
        PG8_STAGE(PG8_SB(1, 0), cB + kstep, voffB); PG8_STAGE(PG8_SA(1, 0), cA + kstep, voffA); PG8_STAGE(PG8_SB(1, 1), cB + hstep + kstep, voffB);
        PG8_WAIT_V(6); PG8_BAR;
    }
    for (;;) {
        const bool has_next = S.next(ui + 1, nxt);
        const char* nA = has_next ? (const char*)g.A + (size_t)nxt.pm * tstep : cA; const char* nB = has_next ? (const char*)g.Bt + (size_t)nxt.pn * tstep : cB;
        for (int t = 0; t < nt; t += 2) {
            const bool last = (t == nt - 2);
            const char* a1 = cA + (size_t)(t + 1) * kstep;
            const char* a2 = last ? nA : cA + (size_t)(t + 2) * kstep; const char* b2 = last ? nB : cB + (size_t)(t + 2) * kstep;
            const char* a3 = a2 + kstep; const char* b3 = b2 + kstep;
            if (last && has_next) S.a_ready(nxt);
            if constexpr (SP2) {
            PG8_LDB(B0, 0, 0); PG8_LDB(B1, 0, 1); PG8_SCHED; PG8_LDA(At, 0, 0); PG8_STAGE(PG8_SA(1, 1), a1 + hstep, voffA);
            PG8_WAIT_V(8); PG8_WAIT_L(0); PG8_BAR; PG8_MMA(0, 0, At, B0); PG8_MMA(0, 1, At, B1); PG8_BAR; PG8_SCHED;
            PG8_LDA(At, 0, 1); PG8_STAGE(PG8_SB(0, 0), b2, voffB); PG8_STAGE(PG8_SB(0, 1), b2 + hstep, voffB); PG8_STAGE(PG8_SA(0, 0), a2, voffA);
            PG8_WAIT_V(8); PG8_WAIT_L(0); PG8_BAR; PG8_MMA(1, 0, At, B0); PG8_MMA(1, 1, At, B1); PG8_BAR; PG8_SCHED;
            PG8_LDB(B0, 1, 0); PG8_LDB(B1, 1, 1); PG8_SCHED; PG8_LDA(At, 1, 0); PG8_STAGE(PG8_SA(0, 1), a2 + hstep, voffA);
            PG8_WAIT_V(8); PG8_WAIT_L(0); PG8_BAR; PG8_MMA(0, 0, At, B0); PG8_MMA(0, 1, At, B1); PG8_BAR; PG8_SCHED;
            PG8_LDA(At, 1, 1); PG8_STAGE(PG8_SB(1, 0), b3, voffB); PG8_STAGE(PG8_SB(1, 1), b3 + hstep, voffB); PG8_STAGE(PG8_SA(1, 0), a3, voffA);
            PG8_WAIT_V(8); PG8_WAIT_L(0); PG8_BAR; PG8_MMA(1, 0, At, B0); PG8_MMA(1, 1, At, B1); PG8_BAR; PG8_SCHED;
            } else {
            PG8_LDB(B0, 0, 0); PG8_SCHED; PG8_LDA(At, 0, 0); PG8_STAGE(PG8_SA(1, 1), a1 + hstep, voffA);
            PG8_WAIT_L(8); PG8_BAR; PG8_WAIT_L(0); PG8_MMA(0, 0, At, B0); PG8_BAR; PG8_SCHED;
            PG8_LDB(B1, 0, 1); PG8_STAGE(PG8_SB(0, 0), b2, voffB);
            PG8_BAR; PG8_WAIT_L(0); PG8_MMA(0, 1, At, B1); PG8_BAR;
            PG8_LDA(At, 0, 1); PG8_STAGE(PG8_SA(0, 0), a2, voffA);
            PG8_BAR; PG8_WAIT_L(0); PG8_MMA(1, 0, At, B0); PG8_BAR; PG8_SCHED;
            PG8_STAGE(PG8_SB(0, 1), b2 + hstep, voffB);
            PG8_WAIT_V(6); PG8_BAR; PG8_MMA(1, 1, At, B1); PG8_BAR;
            PG8_LDB(B0, 1, 0); PG8_SCHED; PG8_LDA(At, 1, 0); PG8_STAGE(PG8_SA(0, 1), a2 + hstep, voffA);
            PG8_WAIT_L(8); PG8_BAR; PG8_WAIT_L(0); PG8_MMA(0, 0, At, B0); PG8_BAR; PG8_SCHED;
            PG8_LDB(B1, 1, 1); PG8_STAGE(PG8_SB(1, 0), b3, voffB);
            PG8_BAR; PG8_WAIT_L(0); PG8_MMA(0, 1, At, B1); PG8_BAR;
            PG8_LDA(At, 1, 1); PG8_STAGE(PG8_SA(1, 0), a3, voffA);
            PG8_BAR; PG8_WAIT_L(0); PG8_MMA(1, 0, At, B0); PG8_BAR; PG8_SCHED;
            PG8_STAGE(PG8_SB(1, 1), b3 + hstep, voffB);
            PG8_WAIT_V(6); PG8_BAR; PG8_MMA(1, 1, At, B1); PG8_BAR;
            }
        }
        if constexpr (ALIGN_EPI) { if (wr == 0) PG8_BAR; }
        if constexpr (!Epi::AFTER_DRAIN) { E(acc, cur, wr, wc, fr, fq); S.done(cur); }
        if (!has_next) break;
#pragma unroll
        for (int a = 0; a < 2; ++a)
#pragma unroll
            for (int b = 0; b < 2; ++b)
#pragma unroll
                for (int m = 0; m < 4; ++m)
#pragma unroll
                    for (int n = 0; n < 2; ++n) acc[a][b][m][n] = (f32x4){0.f, 0.f, 0.f, 0.f};
        cur = nxt; cA = nA; cB = nB; ++ui;
        if constexpr (ALIGN_EPI) { if (wr == 1) PG8_BAR; }
    }
    PG8_WAIT_V(0);
    if constexpr (!ALIGN_EPI) { if (wr == 0) PG8_BAR; }
    PG8_BAR;
    if constexpr (Epi::AFTER_DRAIN) { E.fused(acc, cur, wr, wc, fr, fq, lds, wid, lane); S.done(cur); }
#undef PG8_SA
#undef PG8_SB
#undef PG8_STAGE
#undef PG8_LDA
#undef PG8_LDB
#undef PG8_MMA
#undef PG8_WAIT_V
#undef PG8_WAIT_L
#undef PG8_BAR
#undef PG8_SCHED
}
}
struct Args { const float* in[27]; float* out; unsigned char* ws; int ph_lo, ph_hi; };

__device__ __forceinline__ void transpose_item(const GAS float* W, int K, int N, GAS bf16* WT, const GAS float* gain, int il, LAS float* scr, int item, int lane) {
    const int nblk = N / 32, kb = item / nblk, nb = item % nblk, k0 = 64 * kb, n0 = 32 * nb;
    float v[32];
    const GAS float* src = W + (size_t)(k0 + (lane >> 5)) * N + n0 + (lane & 31);
#pragma unroll
    for (int i = 0; i < 32; ++i) v[i] = src[(size_t)(2 * i) * N];
    if (gain) {
        float gg[32];
#pragma unroll
        for (int i = 0; i < 32; ++i) gg[i] = gain[k0 + 2 * i + (lane >> 5)];
#pragma unroll
        for (int i = 0; i < 32; ++i) v[i] *= gg[i];
    }
#pragma unroll
    for (int i = 0; i < 32; ++i) scr[(2 * i + (lane >> 5)) * 33 + (lane & 31)] = v[i];
    LDS_WAIT(); asm volatile("" ::: "memory");
    const int drow0 = il ? (((n0 >> 7) << 8) + (n0 & 127) + (il == 2 ? 128 : 0)) : n0;
    const int c = lane & 7;
#pragma unroll
    for (int j = 0; j < 4; ++j) { const int n = (lane >> 3) + 8 * j; const LAS float* s = scr + (8 * c) * 33 + n;
        v4u o; o.x = pk2(s[0 * 33], s[1 * 33]); o.y = pk2(s[2 * 33], s[3 * 33]); o.z = pk2(s[4 * 33], s[5 * 33]); o.w = pk2(s[6 * 33], s[7 * 33]);
        *(GAS v4u*)(WT + (size_t)(drow0 + n) * K + k0 + 8 * c) = o; }
    LDS_WAIT(); asm volatile("" ::: "memory");
}
__device__ __forceinline__ void weights_set1(tab_t tab, LAS unsigned char* lds, int lane, int wave, int gw, int NGW) {
    asm volatile("" : "+v"(lane));
    GAS unsigned char* ws = WSP();
    LAS float* scr = (LAS float*)(lds + wave * 16384);
    constexpr int I_GU = (D / 64) * (FF / 32), I_DN = (FF / 64) * (D / 32), I_OA = (512 / 64) * (D / 32), I_O = (D / 64) * (D / 32);
    constexpr int NITEMS = 2 * I_GU + I_DN + 2 * I_OA + I_O;
    for (int it = gw; it < NITEMS; it += NGW) {
        int r = it;
        if (r < I_GU) { transpose_item(INP(23), D, FF, (GAS bf16*)(ws + WS_W2GU), INP(22), 1, scr, r, lane); continue; } r -= I_GU;
        if (r < I_GU) { transpose_item(INP(24), D, FF, (GAS bf16*)(ws + WS_W2GU), INP(22), 2, scr, r, lane); continue; } r -= I_GU;
        if (r < I_DN) { transpose_item(INP(25), FF, D, (GAS bf16*)(ws + WS_W2D), nullptr, 0, scr, r, lane); continue; } r -= I_DN;
        if (r < I_OA) { transpose_item(INP(8), 512, D, (GAS bf16*)(ws + WS_WOA), nullptr, 0, scr, r, lane); continue; } r -= I_OA;
        if (r < I_OA) { transpose_item(INP(20), 512, D, (GAS bf16*)(ws + WS_WOB), nullptr, 0, scr, r, lane); continue; } r -= I_OA;
        transpose_item(INP(21), D, D, (GAS bf16*)(ws + WS_WO), nullptr, 0, scr, r, lane);
    }
}
__device__ __forceinline__ void phase_prologue(tab_t tab, LAS unsigned char* lds, int tid, int lane, int wave) {
    asm volatile("" : "+v"(lane), "+v"(tid));
    GAS unsigned char* ws = WSP();
    LAS float* scr = (LAS float*)(lds + wave * 16384);
    const int G = gridDim.x, gw = blockIdx.x * NWAVES + wave, NGW = G * NWAVES;
    constexpr int I_GU = (D / 64) * (FF / 32), I_DN = (FF / 64) * (D / 32), I_IN = (D / 64) * (5376 / 32);
    constexpr int NITEMS = 2 * I_GU + I_DN + I_IN;
    for (int it = gw; it < NITEMS; it += NGW) {
        int r = it;
        if (r < I_GU) { transpose_item(INP(2), D, FF, (GAS bf16*)(ws + WS_W1GU), INP(1), 1, scr, r, lane); continue; } r -= I_GU;
        if (r < I_GU) { transpose_item(INP(3), D, FF, (GAS bf16*)(ws + WS_W1GU), INP(1), 2, scr, r, lane); continue; } r -= I_GU;
        if (r < I_DN) { transpose_item(INP(4), FF, D, (GAS bf16*)(ws + WS_W1D), nullptr, 0, scr, r, lane); continue; } r -= I_DN;
        transpose_item(INP(6), D, 5376, (GAS bf16*)(ws + WS_WIN), INP(5), 0, scr, r, lane);
    }
    { GAS bf16* WL = (GAS bf16*)(ws + WS_WL); const GAS float* wdu = INP(11); const GAS float* wiu = INP(13); const GAS float* wgu = INP(14);
      for (int idx = blockIdx.x * 512 + tid; idx < 1536 * 256; idx += G * 512) {
          const int n = idx >> 8, kc = idx & 255; float v = 0.f;
          if (n < 512) { if (kc < 64) v = wdu[kc * 512 + n]; }
          else if (n < 1024) { if (kc >= 64 && kc < 128) v = wiu[(kc - 64) * 512 + (n - 512)]; }
          else { if (kc >= 128) v = wgu[(kc - 128) * 512 + (n - 1024)]; }
          WL[idx] = (bf16)f2bf(v); } }
    { const GAS float* x = INP(0); GAS bf16* xb = (GAS bf16*)(ws + WS_XB); GAS float* ssq0 = (GAS float*)(ws + WS_SSQ0);
      for (int m = gw; m < M; m += 2 * NGW) {
          const int m2 = m + NGW; const bool has2 = m2 < M;
          const GAS f32x4* xr = (const GAS f32x4*)(x + (size_t)m * D) + lane; const GAS f32x4* xr2 = (const GAS f32x4*)(x + (size_t)(has2 ? m2 : m) * D) + lane;
          f32x4 v[4], w[4]; float s = 0.f, s2 = 0.f;
#pragma unroll
          for (int j = 0; j < 4; ++j) { v[j] = xr[64 * j]; w[j] = xr2[64 * j]; }
#pragma unroll
          for (int j = 0; j < 4; ++j) { s += (v[j][0] * v[j][0] + v[j][1] * v[j][1]) + (v[j][2] * v[j][2] + v[j][3] * v[j][3]); s2 += (w[j][0] * w[j][0] + w[j][1] * w[j][1]) + (w[j][2] * w[j][2] + w[j][3] * w[j][3]); }
          s = wave_sum(s); s2 = wave_sum(s2);
          GAS unsigned long long* o8 = (GAS unsigned long long*)(xb + (size_t)m * D) + lane;
#pragma unroll
          for (int j = 0; j < 4; ++j) o8[64 * j] = (unsigned long long)pk2(v[j][0], v[j][1]) | ((unsigned long long)pk2(v[j][2], v[j][3]) << 32);
          if (lane < 16) ssq0[(size_t)m * 16 + lane] = (lane == 0) ? s : 0.f;
          if (has2) {
              GAS unsigned long long* p8 = (GAS unsigned long long*)(xb + (size_t)m2 * D) + lane;
#pragma unroll
              for (int j = 0; j < 4; ++j) p8[64 * j] = (unsigned long long)pk2(w[j][0], w[j][1]) | ((unsigned long long)pk2(w[j][2], w[j][3]) << 32);
              if (lane < 16) ssq0[(size_t)m2 * 16 + lane] = (lane == 0) ? s2 : 0.f;
          }
      } }
}

__device__ __forceinline__ void ld8(const GAS bf16* p, float (&v)[8]) {
    const v4u w = *(const GAS v4u*)p;
    v[0] = __uint_as_float(w.x << 16); v[1] = __uint_as_float(w.x & 0xffff0000u); v[2] = __uint_as_float(w.y << 16); v[3] = __uint_as_float(w.y & 0xffff0000u);
    v[4] = __uint_as_float(w.z << 16); v[5] = __uint_as_float(w.z & 0xffff0000u); v[6] = __uint_as_float(w.w << 16); v[7] = __uint_as_float(w.w & 0xffff0000u);
}
__device__ __forceinline__ void st8(GAS bf16* p, const float (&v)[8]) {
    v4u w; w.x = pk2(v[0], v[1]); w.y = pk2(v[2], v[3]); w.z = pk2(v[4], v[5]); w.w = pk2(v[6], v[7]); *(GAS v4u*)p = w;
}
__device__ __forceinline__ void phase_prep(tab_t tab, int tid) {
    asm volatile("" : "+v"(tid));
    GAS unsigned char* ws = WSP();
    const GAS bf16* PA = (const GAS bf16*)(ws + WS_PA); const GAS bf16* PB = (const GAS bf16*)(ws + WS_PB);
    GAS bf16* ZA = (GAS bf16*)(ws + WS_ZA); GAS bf16* LIN = (GAS bf16*)(ws + WS_LIN);
    const GAS float* cw = INP(7); const GAS float* mu = INP(9);
    const int gt = blockIdx.x * 512 + tid, NT = gridDim.x * 512;
    for (int it = gt; it < M * 64; it += NT) {
        const int m = it >> 6, c0 = (it & 63) * 8, t = m & (T - 1);
        float bb[8], c_[8], u_[8], acc[8], w0[8], w1[8], w2[8];
#pragma unroll
        for (int j = 0; j < 8; ++j) { w0[j] = cw[c0 + j]; w1[j] = cw[512 + c0 + j]; w2[j] = cw[1024 + c0 + j]; }
        const GAS bf16* row = PA + (size_t)m * 1536;
        ld8(row + c0, bb); ld8(row + 512 + c0, c_); ld8(row + 1024 + c0, u_);
#pragma unroll
        for (int j = 0; j < 8; ++j) acc[j] = w2[j] * (c_[j] * u_[j]);
        if (t >= 1) { ld8(row - 1536 + 512 + c0, c_); ld8(row - 1536 + 1024 + c0, u_);
#pragma unroll
            for (int j = 0; j < 8; ++j) acc[j] += w1[j] * (c_[j] * u_[j]); }
        if (t >= 2) { ld8(row - 3072 + 512 + c0, c_); ld8(row - 3072 + 1024 + c0, u_);
#pragma unroll
            for (int j = 0; j < 8; ++j) acc[j] += w0[j] * (c_[j] * u_[j]); }
#pragma unroll
        for (int j = 0; j < 8; ++j) acc[j] *= bb[j];
        st8(ZA + (size_t)m * 512 + c0, acc);
    }
    for (int it = gt; it < M * 32; it += NT) {
        const int m = it >> 5, c0 = (it & 31) * 8, t = m & (T - 1);
        float x[8], xp[8];
        const GAS bf16* row = PB + (size_t)m * 1792 + 1536 + c0;
        ld8(row, x);
        if (t >= 1) ld8(row - 1792, xp); else {
#pragma unroll
            for (int j = 0; j < 8; ++j) xp[j] = 0.f; }
#pragma unroll
        for (int j = 0; j < 8; ++j) { float v = x[j] + (xp[j] - x[j]) * mu[1536 + c0 + j]; x[j] = (c0 < 64) ? tanhf_(v) : ((c0 < 128) ? v : sigmf(v)); }
        st8(LIN + (size_t)m * 256 + c0, x);
    }
}

struct ScanCtx {
    const GAS bf16* PB; const GAS bf16* LOGW; const GAS bf16* ICLR; const GAS bf16* GG; GAS bf16* ZB; GAS float* PC; GAS float* NS;
    const GAS float* mu; const GAS float* k_k; const GAS float* k_a; const GAS float* r_k; const GAS float* lnw; const GAS float* lnb;
    GAS bf16* Q0; GAS bf16* Q1; GAS float* BON;
};
template <int CTRL> __device__ __forceinline__ float dppx(float x) {
    const int xi = __builtin_bit_cast(int, x);
    return __builtin_bit_cast(float, __builtin_amdgcn_update_dpp(xi, xi, CTRL, 0xF, 0xF, false));
}
__device__ __forceinline__ float wave_sum_dpp(float v) {
    v += dppx<0xB1>(v); v += dppx<0x4E>(v); v += dppx<0x141>(v); v += dppx<0x140>(v);
    const int vi = __builtin_bit_cast(int, v);
    const float s0 = __builtin_bit_cast(float, __builtin_amdgcn_readlane(vi, 0)), s1 = __builtin_bit_cast(float, __builtin_amdgcn_readlane(vi, 16));
    const float s2 = __builtin_bit_cast(float, __builtin_amdgcn_readlane(vi, 32)), s3 = __builtin_bit_cast(float, __builtin_amdgcn_readlane(vi, 48));
    return (s0 + s1) + (s2 + s3);
}
typedef float f32x2 __attribute__((ext_vector_type(2)));
#define LBAR() do { asm volatile("s_waitcnt lgkmcnt(0)" ::: "memory"); __builtin_amdgcn_s_barrier(); asm volatile("" ::: "memory"); } while (0)
struct Raw4 { unsigned r[5], k[5], v[5], lw[4], ic[4]; };
__device__ __forceinline__ void load_raw4(const ScanCtx& X, int ms, bool prev_valid, int hc, Raw4& q) {
#pragma unroll
    for (int j = 0; j < 5; ++j) {
        const int m = (j == 0 && !prev_valid) ? ms : (ms - 1 + j);
        const GAS bf16* row = X.PB + (size_t)m * 1792;
        q.r[j] = row[hc]; q.k[j] = row[512 + hc]; q.v[j] = row[1024 + hc];
    }
    if (!prev_valid) { q.r[0] = 0u; q.k[0] = 0u; q.v[0] = 0u; }
#pragma unroll
    for (int j = 0; j < 4; ++j) { q.lw[j] = X.LOGW[(size_t)(ms + j) * 512 + hc]; q.ic[j] = X.ICLR[(size_t)(ms + j) * 512 + hc]; }
}
template <int PASS, int MODE>
__device__ __forceinline__ void scan_pair(const ScanCtx& X, int cid, bool active, int role, LAS float* pl, int lane) {
    asm volatile("" : "+v"(lane));
    constexpr int R = (PASS == 0) ? 4 : 2;
    const int bh = cid >> 6, c = cid & 63, b = bh >> 3, h = bh & 7;
    const int m0 = b * T + c * 128;
    const int rg = lane >> 2, ks = lane & 3;
    const int hc = h * 64 + lane;
    const int row0 = (PASS == 0) ? rg * 4 : role * 32 + rg * 2;
    f32x2 S[R][8];
#pragma unroll
    for (int i = 0; i < R; ++i)
#pragma unroll
        for (int j = 0; j < 8; ++j) { S[i][j].x = (MODE == 0 && (row0 + i) == (ks * 16 + 2 * j)) ? 1.f : 0.f; S[i][j].y = (MODE == 0 && (row0 + i) == (ks * 16 + 2 * j + 1)) ? 1.f : 0.f; }
    if (MODE == 2 && c > 0 && active) {
        const GAS float* src = X.NS + (size_t)(cid - 1) * 4096;
#pragma unroll
        for (int i = 0; i < R; ++i)
#pragma unroll
            for (int q = 0; q < 4; ++q) { const f32x4 v = *(const GAS f32x4*)(src + (row0 + i) * 64 + ks * 16 + q * 4); S[i][2 * q] = (f32x2){v[0], v[1]}; S[i][2 * q + 1] = (f32x2){v[2], v[3]}; }
    }
    const float mu_r = X.mu[hc], mu_k = X.mu[512 + hc], mu_v = X.mu[1024 + hc];
    const float kk_c = X.k_k[hc], ka_c = X.k_a[hc], rk_c = X.r_k[hc], lnw = X.lnw[hc], lnb = X.lnb[hc];
    LAS float* LY = pl + 6400;
    const int s0 = role * 4;
    Raw4 cur;
    if (active) load_raw4(X, m0 + s0, !(c == 0 && role == 0), hc, cur);
    for (int sub = 0; sub < 16; ++sub) {
        const int mb = m0 + sub * 8;
        LAS float* vb = pl + (sub & 1) * 3200;
        LAS float* LA = vb; LAS float* LW = vb + 512; LAS float* LB = vb + 1024; LAS float* LK = vb + 1536; LAS float* LR = vb + 2048; LAS float* LV = vb + 2560; LAS float* LBon = vb + 3072;
        unsigned gq[4];
        if (active) {
#pragma unroll
            for (int j = 0; j < 4; ++j) {
                const int s = s0 + j;
                const float rc = __uint_as_float(cur.r[j + 1] << 16), kc = __uint_as_float(cur.k[j + 1] << 16), vc = __uint_as_float(cur.v[j + 1] << 16);
                const float rp = __uint_as_float(cur.r[j] << 16), kp = __uint_as_float(cur.k[j] << 16), vp = __uint_as_float(cur.v[j] << 16);
                const float r = rc + (rp - rc) * mu_r, k = kc + (kp - kc) * mu_k, v = vc + (vp - vc) * mu_v;
                const float lw = __uint_as_float(cur.lw[j] << 16), ic = __uint_as_float(cur.ic[j] << 16);
                float kk = k * kk_c; const float n2 = wave_sum_dpp(kk * kk); kk = kk * rsqrtf(fmaxf(n2, 1e-24f));
                const float k2 = k * (1.0f + (ic - 1.0f) * ka_c);
                LA[s * 64 + lane] = -kk; LW[s * 64 + lane] = __expf(lw); LB[s * 64 + lane] = kk * ic; LK[s * 64 + lane] = k2; LV[s * 64 + lane] = v;
                if (MODE == 2) { LR[s * 64 + lane] = r; const float bon = wave_sum_dpp(r * k2 * rk_c); if (lane == 0) LBon[s] = bon; }
                if (PASS == 0) { LR[s * 64 + lane] = r; const float bon = wave_sum_dpp(r * k2 * rk_c); if (lane == 0) X.BON[(size_t)(mb + s) * 8 + h] = bon; }
            }
            if (sub < 15) load_raw4(X, mb + 8 + s0, true, hc, cur);
            if (MODE == 2) {
#pragma unroll
                for (int j = 0; j < 4; ++j) gq[j] = X.GG[(size_t)(mb + s0 + j) * 512 + hc];
            }
        }
        LBAR();
        if (active) {
#pragma unroll 2
            for (int s = 0; s < 8; ++s) {
                f32x2 a2[8], w2[8], b2[8], k2[8], r2[8]; float vv[R];
#pragma unroll
                for (int q = 0; q < 4; ++q) {
                    const f32x4 ta = *(const LAS f32x4*)(LA + s * 64 + ks * 16 + 4 * q), tw = *(const LAS f32x4*)(LW + s * 64 + ks * 16 + 4 * q), tb = *(const LAS f32x4*)(LB + s * 64 + ks * 16 + 4 * q);
                    a2[2 * q] = (f32x2){ta[0], ta[1]}; a2[2 * q + 1] = (f32x2){ta[2], ta[3]}; w2[2 * q] = (f32x2){tw[0], tw[1]}; w2[2 * q + 1] = (f32x2){tw[2], tw[3]}; b2[2 * q] = (f32x2){tb[0], tb[1]}; b2[2 * q + 1] = (f32x2){tb[2], tb[3]};
                }
                if (MODE >= 1) {
#pragma unroll
                    for (int q = 0; q < 4; ++q) { const f32x4 tk = *(const LAS f32x4*)(LK + s * 64 + ks * 16 + 4 * q); k2[2 * q] = (f32x2){tk[0], tk[1]}; k2[2 * q + 1] = (f32x2){tk[2], tk[3]}; }
                    if (R == 4) { const f32x4 t = *(const LAS f32x4*)(LV + s * 64 + row0); vv[0] = t[0]; vv[1] = t[1]; vv[R - 2] = t[2]; vv[R - 1] = t[3]; }
                    else { const f32x2 t = *(const LAS f32x2*)(LV + s * 64 + row0); vv[0] = t[0]; vv[1] = t[1]; }
                }
                if (MODE == 2 || PASS == 0) {
#pragma unroll
                    for (int q = 0; q < 4; ++q) { const f32x4 tr = *(const LAS f32x4*)(LR + s * 64 + ks * 16 + 4 * q); r2[2 * q] = (f32x2){tr[0], tr[1]}; r2[2 * q + 1] = (f32x2){tr[2], tr[3]}; }
                }
                float sa[R];
#pragma unroll
                for (int i = 0; i < R; ++i) {
                    f32x2 p0 = S[i][0] * a2[0], p1 = S[i][1] * a2[1];
#pragma unroll
                    for (int j = 2; j < 8; j += 2) { p0 = S[i][j] * a2[j] + p0; p1 = S[i][j + 1] * a2[j + 1] + p1; }
                    p0 = p0 + p1; sa[i] = quad_sum(p0.x + p0.y);
                }
#pragma unroll
                for (int i = 0; i < R; ++i) {
                    const f32x2 sa2 = (f32x2){sa[i], sa[i]};
#pragma unroll
                    for (int j = 0; j < 8; ++j) {
                        f32x2 t = sa2 * b2[j] + S[i][j] * w2[j];
                        if (MODE >= 1) { const f32x2 v2 = (f32x2){vv[i], vv[i]}; t = v2 * k2[j] + t; }
                        S[i][j] = t;
                    }
                }
                if (MODE == 2) {
                    f32x2 y;
#pragma unroll
                    for (int i = 0; i < R; ++i) {
                        f32x2 p0 = S[i][0] * r2[0], p1 = S[i][1] * r2[1];
#pragma unroll
                        for (int j = 2; j < 8; j += 2) { p0 = S[i][j] * r2[j] + p0; p1 = S[i][j + 1] * r2[j + 1] + p1; }
                        p0 = p0 + p1; y[i & 1] = quad_sum(p0.x + p0.y);
                    }
                    if (ks == 0) *(LAS f32x2*)(LY + s * 64 + row0) = y;
                }
                if (PASS == 0) {
                    f32x4 y;
#pragma unroll
                    for (int i = 0; i < R; ++i) {
                        f32x2 p0 = S[i][0] * r2[0], p1 = S[i][1] * r2[1];
#pragma unroll
                        for (int j = 2; j < 8; j += 2) { p0 = S[i][j] * r2[j] + p0; p1 = S[i][j + 1] * r2[j + 1] + p1; }
                        p0 = p0 + p1; y[i & 3] = quad_sum(p0.x + p0.y);
                    }
                    if (ks == 0) *(LAS f32x4*)(LY + role * 512 + s * 64 + row0) = y;
                }
            }
        }
        if (PASS == 0 && active) {
            asm volatile("s_waitcnt lgkmcnt(0)" ::: "memory"); __builtin_amdgcn_wave_barrier();
            GAS bf16* dst = (MODE == 0) ? ((b == 0 ? X.Q0 : X.Q1) + (size_t)((mb & (T - 1))) * 512 + hc) : (X.ZB + (size_t)mb * 512 + hc);
#pragma unroll
            for (int s = 0; s < 8; ++s) dst[(size_t)s * 512] = (bf16)f2bf(LY[role * 512 + s * 64 + lane]);
        }
        if (MODE == 2) LBAR();
        if (MODE == 2) {
            if (active) {
#pragma unroll
                for (int j = 0; j < 4; ++j) {
                    const int s = s0 + j, m = mb + s;
                    const float y = LY[s * 64 + lane];
                    const float mean = wave_sum_dpp(y) * (1.0f / 64.0f); const float d = y - mean; const float var = wave_sum_dpp(d * d) * (1.0f / 64.0f);
                    float yn = d * rsqrtf(var + 64e-5f) * lnw + lnb;
                    yn += LBon[s] * LV[s * 64 + lane];
                    const float g = __uint_as_float(gq[j] << 16);
                    X.ZB[(size_t)m * 512 + hc] = (bf16)f2bf(yn * g);
                }
            }
        }
    }
    if (MODE <= 1 && active) {
        GAS float* dst = (MODE == 0 ? X.PC : X.NS) + (size_t)cid * 4096;
#pragma unroll
        for (int i = 0; i < R; ++i)
#pragma unroll
            for (int q = 0; q < 4; ++q) *(GAS f32x4*)(dst + (row0 + i) * 64 + ks * 16 + q * 4) = (f32x4){S[i][2 * q].x, S[i][2 * q].y, S[i][2 * q + 1].x, S[i][2 * q + 1].y};
    }
}
#define MF4(a, b, c) __builtin_amdgcn_mfma_f32_16x16x4f32((a), (b), (c), 0, 0, 0)
struct RawB { unsigned r[9], k[9], v[9], ic[8], lw[16]; };
__device__ __forceinline__ void load_rawb(const ScanCtx& X, int mblk, int role, bool prev_valid, int hc, RawB& q) {
    const int ms = mblk + role * 8;
#pragma unroll
    for (int j = 0; j < 9; ++j) {
        const int m = (j == 0 && !prev_valid) ? ms : (ms - 1 + j);
        const GAS bf16* row = X.PB + (size_t)m * 1792;
        q.r[j] = row[hc]; q.k[j] = row[512 + hc]; q.v[j] = row[1024 + hc];
    }
    if (!prev_valid) { q.r[0] = 0u; q.k[0] = 0u; q.v[0] = 0u; }
#pragma unroll
    for (int j = 0; j < 8; ++j) q.ic[j] = X.ICLR[(size_t)(ms + j) * 512 + hc];
#pragma unroll
    for (int j = 0; j < 16; ++j) q.lw[j] = X.LOGW[(size_t)(mblk + j) * 512 + hc];
}
#ifndef DBG_STAGE
#define DBG_STAGE 3
#endif
template <int MODE>
__device__ __forceinline__ void scan_a_mfma(const ScanCtx& X, int cid, bool active, LAS float* pl, int lane) {
    asm volatile("" : "+v"(lane));
    constexpr int role = MODE;
    const int bh = cid >> 6, c = cid & 63, b = bh >> 3, h = bh & 7;
    const int m0 = b * T + c * 128;
    const int l16 = lane & 15, lq = lane >> 4, hc = h * 64 + lane;
    LAS float* AT = pl; LAS float* BT = pl + 1024; LAS float* KT = pl + 2048; LAS float* RT = pl + 3072; LAS float* VT = pl + 4096;
    LAS float* LI = pl + 5120; LAS float* GK = pl + 5376; LAS float* HB = pl + 5632; LAS float* HK = pl + 5888; LAS float* GAM = pl + 6144;
    f32x4 S[4][4];
#pragma unroll
    for (int mb = 0; mb < 4; ++mb)
#pragma unroll
        for (int nb = 0; nb < 4; ++nb)
#pragma unroll
            for (int rr = 0; rr < 4; ++rr) S[mb][nb][rr] = (MODE == 0 && (16 * mb + 4 * lq + rr) == (16 * nb + l16)) ? 1.f : 0.f;
    const float mu_r = X.mu[hc], mu_k = X.mu[512 + hc], mu_v = X.mu[1024 + hc];
    const float kk_c = X.k_k[hc], ka_c = X.k_a[hc], rk_c = X.r_k[hc];
    RawB cur;
    if (active) load_rawb(X, m0, role, !(c == 0 && role == 0), hc, cur);
    for (int blk = 0; blk < 8; ++blk) {
        const int mblk = m0 + blk * 16;
        if (active) {
            float cl[17]; cl[0] = 0.f;
#pragma unroll
            for (int t = 0; t < 16; ++t) cl[t + 1] = cl[t] + __uint_as_float(cur.lw[t] << 16);
#pragma unroll
            for (int j = 0; j < 8; ++j) {
                const int t = role * 8 + j;
                const float rc = __uint_as_float(cur.r[j + 1] << 16), kc = __uint_as_float(cur.k[j + 1] << 16), vc = __uint_as_float(cur.v[j + 1] << 16);
                const float rp = __uint_as_float(cur.r[j] << 16), kp = __uint_as_float(cur.k[j] << 16), vp = __uint_as_float(cur.v[j] << 16);
                const float rr_ = rc + (rp - rc) * mu_r, k = kc + (kp - kc) * mu_k, v = vc + (vp - vc) * mu_v;
                const float ic = __uint_as_float(cur.ic[j] << 16);
                float kk = k * kk_c; const float n2 = wave_sum_dpp(kk * kk); kk = kk * rsqrtf(fmaxf(n2, 1e-24f));
                const float k2 = k * (1.0f + (ic - 1.0f) * ka_c);
                const float e_prev = __expf(cl[t]), e_cur = __expf(cl[t + 1]), i_cur = __expf(-cl[t + 1]);
                AT[t * 64 + lane] = -kk * e_prev; BT[t * 64 + lane] = kk * ic * i_cur; KT[t * 64 + lane] = k2 * i_cur; RT[t * 64 + lane] = rr_ * e_cur; VT[t * 64 + lane] = v;
                const float bon = wave_sum_dpp(rr_ * k2 * rk_c); if (lane == 0) X.BON[(size_t)(mblk + t) * 8 + h] = bon;
                asm volatile("" ::: "memory");
            }
            if (MODE == 0) GAM[lane] = __expf(cl[16]);
            if (blk < 7) load_rawb(X, mblk + 16, role, true, hc, cur);
        }
        LBAR();
        if (active && DBG_STAGE >= 2) {
            f32x4 a4[4], b4[4];
            if (MODE == 0) {
                f32x4 g = (f32x4){0.f, 0.f, 0.f, 0.f};
#pragma unroll
                for (int q = 0; q < 4; ++q) { a4[q] = *(const LAS f32x4*)(AT + l16 * 64 + 16 * lq + 4 * q); b4[q] = *(const LAS f32x4*)(BT + l16 * 64 + 16 * lq + 4 * q); }
#pragma unroll
                for (int kk = 0; kk < 16; ++kk) g = MF4(a4[kk >> 2][kk & 3], b4[kk >> 2][kk & 3], g);
#pragma unroll
                for (int rr = 0; rr < 4; ++rr) LI[(4 * lq + rr) * 16 + l16] = (l16 < 4 * lq + rr) ? g[rr] : 0.f;
#define WSYNC() do { asm volatile("s_waitcnt lgkmcnt(0)" ::: "memory"); __builtin_amdgcn_wave_barrier(); } while (0)
#define MM16(Am, Bm, cacc) do { const f32x4 a_ = *(const LAS f32x4*)((Am) + l16 * 16 + 4 * lq); _Pragma("unroll") for (int r_ = 0; r_ < 4; ++r_) cacc = MF4(a_[r_], (Bm)[(4 * lq + r_) * 16 + l16], cacc); } while (0)
#define ST16(Dm, cacc) do { _Pragma("unroll") for (int r_ = 0; r_ < 4; ++r_) (Dm)[(4 * lq + r_) * 16 + l16] = cacc[r_]; } while (0)
                LAS float* M2 = pl + 6208; LAS float* M4 = pl + 6464; LAS float* M8 = pl + 6720; LAS float* TT = pl + 6976;
                const f32x4 z4 = (f32x4){0.f, 0.f, 0.f, 0.f};
                WSYNC();
                f32x4 c2 = z4; MM16(LI, LI, c2); ST16(M2, c2);
                f32x4 t1;
#pragma unroll
                for (int rr = 0; rr < 4; ++rr) t1[rr] = LI[(4 * lq + rr) * 16 + l16] + ((4 * lq + rr) == l16 ? 1.f : 0.f);
                ST16(TT, t1);
                WSYNC();
                f32x4 c4 = z4; MM16(M2, M2, c4); ST16(M4, c4);
                f32x4 t2 = t1; MM16(TT, M2, t2);
                WSYNC();
                ST16(TT, t2);
                WSYNC();
                f32x4 c8 = z4; MM16(M4, M4, c8); ST16(M8, c8);
                f32x4 t4 = t2; MM16(TT, M4, t4);
                WSYNC();
                ST16(TT, t4);
                WSYNC();
                f32x4 t8 = t4; MM16(TT, M8, t8);
                WSYNC();
                ST16(LI, t8);
            } else {
                f32x4 r4[4], k4[4];
#pragma unroll
                for (int q = 0; q < 4; ++q) { a4[q] = *(const LAS f32x4*)(AT + l16 * 64 + 16 * lq + 4 * q); b4[q] = *(const LAS f32x4*)(BT + l16 * 64 + 16 * lq + 4 * q);
                                              r4[q] = *(const LAS f32x4*)(RT + l16 * 64 + 16 * lq + 4 * q); k4[q] = *(const LAS f32x4*)(KT + l16 * 64 + 16 * lq + 4 * q); }
                f32x4 gk = (f32x4){0.f, 0.f, 0.f, 0.f}, hb = gk, hk = gk;
#pragma unroll
                for (int kk = 0; kk < 16; ++kk) { gk = MF4(a4[kk >> 2][kk & 3], k4[kk >> 2][kk & 3], gk); hb = MF4(r4[kk >> 2][kk & 3], b4[kk >> 2][kk & 3], hb); hk = MF4(r4[kk >> 2][kk & 3], k4[kk >> 2][kk & 3], hk); }
#pragma unroll
                for (int rr = 0; rr < 4; ++rr) { const int t = 4 * lq + rr; GK[t * 16 + l16] = (l16 < t) ? gk[rr] : 0.f; HB[t * 16 + l16] = (l16 <= t) ? hb[rr] : 0.f; HK[t * 16 + l16] = (l16 <= t) ? hk[rr] : 0.f; }
            }
        }
        LBAR();
        if (active && DBG_STAGE >= 3) {
            f32x4 Wt[4], Ut[4], Yt[4];
#pragma unroll
            for (int nb = 0; nb < 4; ++nb) { Wt[nb] = (f32x4){0.f, 0.f, 0.f, 0.f}; Ut[nb] = Wt[nb]; Yt[nb] = Wt[nb]; }
#pragma unroll
            for (int mb = 0; mb < 4; ++mb) {
                const f32x4 at = *(const LAS f32x4*)(AT + l16 * 64 + 16 * mb + 4 * lq);
#pragma unroll
                for (int rr = 0; rr < 4; ++rr)
#pragma unroll
                    for (int nb = 0; nb < 4; ++nb) Wt[nb] = MF4(at[rr], S[mb][nb][rr], Wt[nb]);
            }
            if (MODE == 1) {
                const f32x4 gk = *(const LAS f32x4*)(GK + l16 * 16 + 4 * lq);
#pragma unroll
                for (int nb = 0; nb < 4; ++nb) {
#pragma unroll
                    for (int rr = 0; rr < 4; ++rr) Wt[nb] = MF4(gk[rr], VT[(4 * lq + rr) * 64 + 16 * nb + l16], Wt[nb]);
                }
            }
            { const f32x4 li = *(const LAS f32x4*)(LI + l16 * 16 + 4 * lq);
#pragma unroll
              for (int rr = 0; rr < 4; ++rr)
#pragma unroll
                  for (int nb = 0; nb < 4; ++nb) Ut[nb] = MF4(li[rr], Wt[nb][rr], Ut[nb]); }
#pragma unroll
            for (int mb = 0; mb < 4; ++mb) {
                const f32x4 rt = *(const LAS f32x4*)(RT + l16 * 64 + 16 * mb + 4 * lq);
#pragma unroll
                for (int rr = 0; rr < 4; ++rr)
#pragma unroll
                    for (int nb = 0; nb < 4; ++nb) Yt[nb] = MF4(rt[rr], S[mb][nb][rr], Yt[nb]);
            }
            { const f32x4 hb = *(const LAS f32x4*)(HB + l16 * 16 + 4 * lq);
#pragma unroll
              for (int rr = 0; rr < 4; ++rr)
#pragma unroll
                  for (int nb = 0; nb < 4; ++nb) Yt[nb] = MF4(hb[rr], Ut[nb][rr], Yt[nb]); }
            if (MODE == 1) {
                const f32x4 hk = *(const LAS f32x4*)(HK + l16 * 16 + 4 * lq);
#pragma unroll
                for (int nb = 0; nb < 4; ++nb) {
#pragma unroll
                    for (int rr = 0; rr < 4; ++rr) Yt[nb] = MF4(hk[rr], VT[(4 * lq + rr) * 64 + 16 * nb + l16], Yt[nb]);
                }
            }
            { GAS bf16* dst = (MODE == 0) ? ((b == 0 ? X.Q0 : X.Q1) + (size_t)(mblk & (T - 1)) * 512 + h * 64) : (X.ZB + (size_t)mblk * 512 + h * 64);
#pragma unroll
              for (int nb = 0; nb < 4; ++nb)
#pragma unroll
                  for (int rr = 0; rr < 4; ++rr) dst[(size_t)(4 * lq + rr) * 512 + 16 * nb + l16] = (bf16)f2bf(Yt[nb][rr]); }
#pragma unroll
            for (int mb = 0; mb < 4; ++mb) {
#pragma unroll
                for (int rr = 0; rr < 4; ++rr) {
                    const float ab = BT[(4 * lq + rr) * 64 + 16 * mb + l16];
#pragma unroll
                    for (int nb = 0; nb < 4; ++nb) S[mb][nb] = MF4(ab, Ut[nb][rr], S[mb][nb]);
                }
                if (MODE == 1) {
#pragma unroll
                    for (int rr = 0; rr < 4; ++rr) {
                        const float ak = KT[(4 * lq + rr) * 64 + 16 * mb + l16];
#pragma unroll
                        for (int nb = 0; nb < 4; ++nb) S[mb][nb] = MF4(ak, VT[(4 * lq + rr) * 64 + 16 * nb + l16], S[mb][nb]);
                    }
                }
                const f32x4 g = *(const LAS f32x4*)(GAM + 16 * mb + 4 * lq);
#pragma unroll
                for (int nb = 0; nb < 4; ++nb) { S[mb][nb] = S[mb][nb] * g;
#pragma unroll
                    for (int e_ = 0; e_ < 4; ++e_) S[mb][nb][e_] = (S[mb][nb][e_] != S[mb][nb][e_]) ? 0.f : S[mb][nb][e_]; }
            }
        }
        LBAR();
    }
    if (active) {
        GAS float* dst = (MODE == 0 ? X.PC : X.NS) + (size_t)cid * 4096;
#pragma unroll
        for (int mb = 0; mb < 4; ++mb)
#pragma unroll
            for (int nb = 0; nb < 4; ++nb) *(GAS f32x4*)(dst + (16 * nb + l16) * 64 + 16 * mb + 4 * lq) = S[mb][nb];
    }
}
__device__ __forceinline__ void scan_c2(const ScanCtx& X, int cid, int half, LAS float* wl, int lane) {
    asm volatile("" : "+v"(lane));
    const int bh = cid >> 6, c = cid & 63, b = bh >> 3, h = bh & 7;
    const int m0 = b * T + c * 128 + half * 64;
    const int l16 = lane & 15, lq = lane >> 4, hc = h * 64 + lane;
    const GAS bf16* Qb = (b == 0 ? X.Q0 : X.Q1) + (size_t)(c * 128 + half * 64) * 512 + h * 64;
    float Bv[4][16];
#pragma unroll
    for (int vb = 0; vb < 4; ++vb)
#pragma unroll
        for (int j = 0; j < 16; ++j) Bv[vb][j] = 0.f;
    if (c > 0) {
        const GAS float* Sc = X.NS + (size_t)(cid - 1) * 4096;
#pragma unroll
        for (int vb = 0; vb < 4; ++vb)
#pragma unroll
            for (int j = 0; j < 4; ++j) { const f32x4 t = *(const GAS f32x4*)(Sc + (vb * 16 + l16) * 64 + 16 * lq + 4 * j); Bv[vb][4 * j] = t[0]; Bv[vb][4 * j + 1] = t[1]; Bv[vb][4 * j + 2] = t[2]; Bv[vb][4 * j + 3] = t[3]; }
    }
    const float mu_v = X.mu[1024 + hc], lnw = X.lnw[hc], lnb = X.lnb[hc];
    unsigned short y0r[16]; v4u qa, qb; unsigned vraw[17], graw[16]; float bon[16];
#define C2_LOAD(tbn) do { const int mt_ = m0 + (tbn) * 16; \
        _Pragma("unroll") for (int vb = 0; vb < 4; ++vb) _Pragma("unroll") for (int rr = 0; rr < 4; ++rr) y0r[vb * 4 + rr] = X.ZB[(size_t)(mt_ + 4 * lq + rr) * 512 + h * 64 + vb * 16 + l16]; \
        { const GAS bf16* qrow = Qb + (size_t)((tbn) * 16 + l16) * 512 + 16 * lq; qa = *(const GAS v4u*)qrow; qb = *(const GAS v4u*)(qrow + 8); } \
        { const int mp = (mt_ & (T - 1)) ? mt_ - 1 : mt_; vraw[0] = X.PB[(size_t)mp * 1792 + 1024 + hc]; if (!(mt_ & (T - 1))) vraw[0] = 0u; } \
        _Pragma("unroll") for (int tt = 0; tt < 16; ++tt) { vraw[tt + 1] = X.PB[(size_t)(mt_ + tt) * 1792 + 1024 + hc]; graw[tt] = X.GG[(size_t)(mt_ + tt) * 512 + hc]; bon[tt] = X.BON[(size_t)(mt_ + tt) * 8 + h]; } } while (0)
    C2_LOAD(0);
    for (int tb = 0; tb < 4; ++tb) {
        const int mt = m0 + tb * 16;
        f32x4 acc[4];
#pragma unroll
        for (int vb = 0; vb < 4; ++vb)
#pragma unroll
            for (int rr = 0; rr < 4; ++rr) acc[vb][rr] = __uint_as_float((unsigned)y0r[vb * 4 + rr] << 16);
        if (c > 0) {
            float Av[16];
            Av[0] = __uint_as_float(qa.x << 16); Av[1] = __uint_as_float(qa.x & 0xffff0000u); Av[2] = __uint_as_float(qa.y << 16); Av[3] = __uint_as_float(qa.y & 0xffff0000u);
            Av[4] = __uint_as_float(qa.z << 16); Av[5] = __uint_as_float(qa.z & 0xffff0000u); Av[6] = __uint_as_float(qa.w << 16); Av[7] = __uint_as_float(qa.w & 0xffff0000u);
            Av[8] = __uint_as_float(qb.x << 16); Av[9] = __uint_as_float(qb.x & 0xffff0000u); Av[10] = __uint_as_float(qb.y << 16); Av[11] = __uint_as_float(qb.y & 0xffff0000u);
            Av[12] = __uint_as_float(qb.z << 16); Av[13] = __uint_as_float(qb.z & 0xffff0000u); Av[14] = __uint_as_float(qb.w << 16); Av[15] = __uint_as_float(qb.w & 0xffff0000u);
#pragma unroll
            for (int kk = 0; kk < 16; ++kk)
#pragma unroll
                for (int vb = 0; vb < 4; ++vb) acc[vb] = __builtin_amdgcn_mfma_f32_16x16x4f32(Av[kk], Bv[vb][kk], acc[vb], 0, 0, 0);
        }
        unsigned vr[17], gr[16]; float bn[16];
#pragma unroll
        for (int tt = 0; tt < 16; ++tt) { vr[tt] = vraw[tt]; gr[tt] = graw[tt]; bn[tt] = bon[tt]; }
        vr[16] = vraw[16];
        if (tb < 3) C2_LOAD(tb + 1);
#pragma unroll
        for (int vb = 0; vb < 4; ++vb)
#pragma unroll
            for (int rr = 0; rr < 4; ++rr) wl[(4 * lq + rr) * 64 + vb * 16 + l16] = acc[vb][rr];
        asm volatile("s_waitcnt lgkmcnt(0)" ::: "memory"); __builtin_amdgcn_wave_barrier();
#pragma unroll
        for (int tt = 0; tt < 16; ++tt) {
            const float y = wl[tt * 64 + lane];
            const float mean = wave_sum_dpp(y) * (1.0f / 64.0f), ex2 = wave_sum_dpp(y * y) * (1.0f / 64.0f); const float d = y - mean; const float var = fmaxf(ex2 - mean * mean, 0.f);
            float yn = d * rsqrtf(var + 64e-5f) * lnw + lnb;
            const float vc = __uint_as_float(vr[tt + 1] << 16), vp = __uint_as_float(vr[tt] << 16);
            yn += bn[tt] * (vc + (vp - vc) * mu_v);
            X.ZB[(size_t)(mt + tt) * 512 + hc] = (bf16)f2bf(yn * __uint_as_float(gr[tt] << 16));
        }
        asm volatile("s_waitcnt lgkmcnt(0)" ::: "memory"); __builtin_amdgcn_wave_barrier();
    }
#undef C2_LOAD
}
struct PbBuf { float p[16]; float n[4]; };
__device__ __forceinline__ void pb_load(const ScanCtx& X, int bh, int c, int qr, int cb, int l16, int lq, PbBuf& q) {
    const GAS float* P = X.PC + (size_t)(bh * 64 + c) * 4096 + (16 * lq) * 64 + cb * 16 + l16; const GAS float* N = X.NS + (size_t)(bh * 64 + c) * 4096 + (16 * qr + 4 * lq) * 64 + cb * 16 + l16;
#pragma unroll
    for (int kk = 0; kk < 16; ++kk) q.p[kk] = P[kk * 64];
#pragma unroll
    for (int r = 0; r < 4; ++r) q.n[r] = N[r * 64];
}
__device__ __forceinline__ void pb_step(const ScanCtx& X, LAS float* Sr, LAS float* Sw, int bh, int c, int qr, int cb, int l16, int lq, const PbBuf& q, bool worker) {
    if (worker) {
        f32x4 acc = (f32x4){q.n[0], q.n[1], q.n[2], q.n[3]};
        f32x4 av[4];
#pragma unroll
        for (int j = 0; j < 4; ++j) av[j] = *(const LAS f32x4*)(Sr + l16 * 68 + 16 * lq + 4 * j);
        f32x4 acc1 = (f32x4){0.f, 0.f, 0.f, 0.f};
#pragma unroll
        for (int kk = 0; kk < 16; kk += 2) { acc = __builtin_amdgcn_mfma_f32_16x16x4f32(av[kk >> 2][kk & 3], q.p[kk], acc, 0, 0, 0); acc1 = __builtin_amdgcn_mfma_f32_16x16x4f32(av[(kk + 1) >> 2][(kk + 1) & 3], q.p[kk + 1], acc1, 0, 0, 0); }
        acc = acc + acc1;
        GAS float* N = X.NS + (size_t)(bh * 64 + c) * 4096 + (16 * qr + 4 * lq) * 64 + cb * 16 + l16;
#pragma unroll
        for (int r = 0; r < 4; ++r) { Sw[(4 * lq + r) * 68 + cb * 16 + l16] = acc[r]; N[r * 64] = acc[r]; }
    }
    asm volatile("s_waitcnt lgkmcnt(0)" ::: "memory"); __builtin_amdgcn_s_barrier(); asm volatile("" ::: "memory");
}
__device__ __forceinline__ void scan_pass_b(const ScanCtx& X, LAS unsigned char* lds, int wb, int tid, int lane, int wave) {
    asm volatile("" : "+v"(lane), "+v"(tid));
    LAS float* S0 = (LAS float*)lds; LAS float* S1 = S0 + 16 * 68;
    for (int i = tid; i < 16 * 68; i += 512) S0[i] = 0.f;
    __syncthreads();
    const int bh = wb >> 2, qr = wb & 3, cb = wave & 3, l16 = lane & 15, lq = lane >> 4; const bool wk = wave < 4;
    PbBuf q0, q1, q2, q3, q4, q5;
    if (wk) { pb_load(X, bh, 0, qr, cb, l16, lq, q0); pb_load(X, bh, 1, qr, cb, l16, lq, q1); pb_load(X, bh, 2, qr, cb, l16, lq, q2);
              pb_load(X, bh, 3, qr, cb, l16, lq, q3); pb_load(X, bh, 4, qr, cb, l16, lq, q4); pb_load(X, bh, 5, qr, cb, l16, lq, q5); }
    for (int c = 0; c < 60; c += 6) {
        pb_step(X, S0, S1, bh, c, qr, cb, l16, lq, q0, wk);     if (wk && c + 6 < 63) pb_load(X, bh, c + 6, qr, cb, l16, lq, q0);
        pb_step(X, S1, S0, bh, c + 1, qr, cb, l16, lq, q1, wk); if (wk && c + 7 < 63) pb_load(X, bh, c + 7, qr, cb, l16, lq, q1);
        pb_step(X, S0, S1, bh, c + 2, qr, cb, l16, lq, q2, wk); if (wk && c + 8 < 63) pb_load(X, bh, c + 8, qr, cb, l16, lq, q2);
        pb_step(X, S1, S0, bh, c + 3, qr, cb, l16, lq, q3, wk); if (wk && c + 9 < 63) pb_load(X, bh, c + 9, qr, cb, l16, lq, q3);
        pb_step(X, S0, S1, bh, c + 4, qr, cb, l16, lq, q4, wk); if (wk && c + 10 < 63) pb_load(X, bh, c + 10, qr, cb, l16, lq, q4);
        pb_step(X, S1, S0, bh, c + 5, qr, cb, l16, lq, q5, wk); if (wk && c + 11 < 63) pb_load(X, bh, c + 11, qr, cb, l16, lq, q5);
    }
    pb_step(X, S0, S1, bh, 60, qr, cb, l16, lq, q0, wk); pb_step(X, S1, S0, bh, 61, qr, cb, l16, lq, q1, wk); pb_step(X, S0, S1, bh, 62, qr, cb, l16, lq, q2, wk);
}

__device__ __forceinline__ void phase_final(tab_t tab, int lane, int wave) {
    asm volatile("" : "+v"(lane));
    GAS float* out = OUTP(); const GAS float* g = INP(26);
    const int gw = blockIdx.x * NWAVES + wave, NGW = gridDim.x * NWAVES;
    f32x4 gv[4];
#pragma unroll
    for (int j = 0; j < 4; ++j) gv[j] = ((const GAS f32x4*)g)[lane + 64 * j];
    for (int m = gw; m < M; m += 4 * NGW) {
        f32x4 v[4][4]; float s[4];
#pragma unroll
        for (int q = 0; q < 4; ++q) { const int mq = m + q * NGW; const GAS f32x4* xr = (const GAS f32x4*)(out + (size_t)(mq < M ? mq : m) * D) + lane;
#pragma unroll
            for (int j = 0; j < 4; ++j) v[q][j] = xr[64 * j]; }
#pragma unroll
        for (int q = 0; q < 4; ++q) { float t = 0.f;
#pragma unroll
            for (int j = 0; j < 4; ++j) t += (v[q][j][0] * v[q][j][0] + v[q][j][1] * v[q][j][1]) + (v[q][j][2] * v[q][j][2] + v[q][j][3] * v[q][j][3]);
            s[q] = rsqrtf(wave_sum_dpp(t) * (1.0f / D) + 1e-6f); }
#pragma unroll
        for (int q = 0; q < 4; ++q) { const int mq = m + q * NGW; if (mq < M) { GAS f32x4* xw = (GAS f32x4*)(out + (size_t)mq * D) + lane;
#pragma unroll
            for (int j = 0; j < 4; ++j) xw[64 * j] = v[q][j] * s[q] * gv[j]; } }
    }
}

#define RLX_AGENT __ATOMIC_RELAXED, __HIP_MEMORY_SCOPE_AGENT
#define XB_TMO      128
#define XB_XCNT(j)  (256  + 64 * (j))
#define XB_XSUB(j)  (1280 + 64 * (j))
#define XB_XGEN(j)  (2304 + 64 * (j))
#define XB_TOP      3328
#define XB_TOPGEN   3392
#define XCD_BAR_WORDS 3456
#define XB_SPIN_CAP (1u << 18)

__device__ __forceinline__ unsigned xb_ld(unsigned* p)              { return __hip_atomic_load(p, __ATOMIC_RELAXED, __HIP_MEMORY_SCOPE_AGENT); }
__device__ __forceinline__ unsigned xb_add(unsigned* p, unsigned v) { return __hip_atomic_fetch_add(p, v, __ATOMIC_RELAXED, __HIP_MEMORY_SCOPE_AGENT); }
__device__ __forceinline__ unsigned xb_xcc_id() { return (unsigned)__builtin_amdgcn_s_getreg((3 << 11) | 20) & 0xFu; }
#define XB_SPIN(cond, bar) do { unsigned _sp = 0; while (cond) { __builtin_amdgcn_s_sleep(1); \
    if ((++_sp & 255u) == 0u) { if (xb_ld(&(bar)[XB_TMO])) break; if (_sp > XB_SPIN_CAP) { atomicAdd(&(bar)[XB_TMO], 1u); break; } } } } while (0)

struct XcdBarrier {
    unsigned* bar; unsigned x;
    volatile LAS unsigned* st;
};

__device__ __forceinline__ XcdBarrier xcd_barrier_post(unsigned* bar, volatile LAS unsigned* st) {
    XcdBarrier b; b.bar = bar; b.x = xb_xcc_id(); b.st = st;
    if (threadIdx.x == 0) (void)xb_add(&bar[XB_XCNT(b.x)], 1u);
    return b;
}
__device__ __forceinline__ void xcd_barrier_complete(unsigned* bar, unsigned x, unsigned& nloc, unsigned& nx) {
    const unsigned G = gridDim.x * gridDim.y * gridDim.z;
    unsigned sum, cnt, mine, sp = 0u;
    for (;;) {
        sum = 0u; cnt = 0u; mine = 0u;
#pragma unroll
        for (unsigned j = 0; j < 16; ++j) { const unsigned c = xb_ld(&bar[XB_XCNT(j)]); sum += c; cnt += (c > 0u) ? 1u : 0u; mine = (j == x) ? c : mine; }
        if (sum == G) break;
        __builtin_amdgcn_s_sleep(1);
        if ((++sp & 255u) == 0u) { if (xb_ld(&bar[XB_TMO])) break; if (sp > XB_SPIN_CAP) { atomicAdd(&bar[XB_TMO], 1u); break; } }
    }
    nloc = mine > 0u ? mine : 1u; nx = cnt > 0u ? cnt : 1u;
}

__device__ __forceinline__ void xcd_barrier(const XcdBarrier& b) {
    asm volatile("s_waitcnt vmcnt(0)" ::: "memory");
    __syncthreads();
    if (threadIdx.x == 0) {
        unsigned* bar = b.bar;
        __builtin_amdgcn_s_waitcnt(0);
        unsigned nloc = b.st[0], nx = b.st[1];
        if (nloc == 0u) { xcd_barrier_complete(bar, b.x, nloc, nx); b.st[0] = nloc; b.st[1] = nx; }
        const unsigned old = xb_add(&bar[XB_XSUB(b.x)], 1u);
        const unsigned gen = old / nloc;
        if (old + 1u == (gen + 1u) * nloc) {
            __builtin_amdgcn_fence(__ATOMIC_RELEASE, "agent");
            asm volatile("s_waitcnt vmcnt(0)" ::: "memory");
            const unsigned og = xb_add(&bar[XB_TOP], 1u);
            const unsigned tg = og / nx;
            if (og + 1u == (tg + 1u) * nx) xb_add(&bar[XB_TOPGEN], 1u);
            else XB_SPIN(xb_ld(&bar[XB_TOPGEN]) == tg, bar);
            __builtin_amdgcn_fence(__ATOMIC_ACQUIRE, "agent");
            xb_add(&bar[XB_XGEN(b.x)], 1u);
            asm volatile("s_waitcnt vmcnt(0)" ::: "memory");
        } else {
            XB_SPIN(xb_ld(&bar[XB_XGEN(b.x)]) == gen, bar);
            __builtin_amdgcn_fence(__ATOMIC_ACQUIRE, "agent");
            asm volatile("s_waitcnt vmcnt(0)" ::: "memory");
        }
    }
    __syncthreads();
}

__device__ __forceinline__ ScanCtx make_scan_ctx(tab_t tab) {
    GAS unsigned char* ws = WSP();
    ScanCtx X; X.PB = (const GAS bf16*)(ws + WS_PB); X.LOGW = (const GAS bf16*)(ws + WS_LOGW); X.ICLR = (const GAS bf16*)(ws + WS_ICLR); X.GG = (const GAS bf16*)(ws + WS_GG); X.ZB = (GAS bf16*)(ws + WS_ZB);
    X.PC = (GAS float*)(ws + WS_PC); X.NS = (GAS float*)(ws + WS_NS); X.Q0 = (GAS bf16*)(ws + WS_Q0); X.Q1 = (GAS bf16*)(ws + WS_Q1); X.BON = (GAS float*)(ws + WS_BON); X.mu = INP(9); X.k_k = INP(15); X.k_a = INP(16); X.r_k = INP(17); X.lnw = INP(18); X.lnb = INP(19);
    return X;
}
__global__ void __launch_bounds__(NWAVES * 64, 2) fwd(Args a) {
    extern __shared__ __attribute__((aligned(16))) unsigned char lds_raw[];
    LAS unsigned char* lds = (LAS unsigned char*)lds_raw;
    const int tid = threadIdx.x, lane = tid & 63, wave = __builtin_amdgcn_readfirstlane(tid >> 6);
    const int G = gridDim.x;
    { LAS unsigned long long* tw = (LAS unsigned long long*)(lds + TAB_OFF);
      if (tid == 0) {
#pragma unroll
          for (int i = 0; i < 27; ++i) tw[i] = (unsigned long long)a.in[i];
          tw[27] = (unsigned long long)a.out; tw[28] = (unsigned long long)a.ws; }
      if (tid < 2) ((LAS unsigned*)(lds + MISC_OFF))[tid] = 0u;
      __syncthreads(); }
    (void)xcd_barrier_post((unsigned*)a.ws + CW_BAR, (volatile LAS unsigned*)(lds + MISC_OFF));
    const tab_t tab = (tab_t)(lds + TAB_OFF);
    const int ph_lo = a.ph_lo, ph_hi = a.ph_hi;

    unsigned long long tp0 = 0, tp1 = 0;
    for (int p = ph_lo; p < ph_hi; ++p) {
      if (PROBE_TIMEPH >= 0 && p == PROBE_TIMEPH) tp0 = __builtin_amdgcn_s_memrealtime();
      if (PROBE_TIMEPH >= 0 && p == PROBE_TIMEPH + 1) tp1 = __builtin_amdgcn_s_memrealtime();
      for (int rep = 0; rep <= ((PROBE_REPMASK >> p) & 1); ++rep) {
        pg8::Gemm g{nullptr, nullptr, M, 0, 0}; bool isg = false;
        switch (p) {
        case 0: phase_prologue(tab, lds, tid, lane, wave); break;
        case 4: phase_prep(tab, tid); break;
        case 6: { const ScanCtx X = make_scan_ctx(tab); const int pi = wave & 3, role = wave >> 2; LAS float* pl = (LAS float*)lds + pi * SCAN_WAVE_FLOATS;
                  for (int base = 0; base < 1024; base += 4 * G) { const int cid = base + pi * G + (int)blockIdx.x; const bool act = cid < 1024;
                      if (role == 0) scan_a_mfma<0>(X, act ? cid : 0, act, pl, lane); else scan_a_mfma<1>(X, act ? cid : 0, act, pl, lane); } } break;
        case 7: if (blockIdx.x < 64) { const ScanCtx X = make_scan_ctx(tab); if (PROBE_TIMEPH == 107) tp0 = __builtin_amdgcn_s_memrealtime(); scan_pass_b(X, lds, (int)blockIdx.x, tid, lane, wave); if (PROBE_TIMEPH == 107) tp1 = __builtin_amdgcn_s_memrealtime(); }
                else weights_set1(tab, lds, lane, wave, ((int)blockIdx.x - 64) * NWAVES + wave, (G - 64) * NWAVES);
                break;
        case 8: { const ScanCtx X = make_scan_ctx(tab); LAS float* wl = (LAS float*)lds + wave * 1024;
                  for (int task = wave * G + (int)blockIdx.x; task < 2048; task += NWAVES * G) scan_c2(X, task >> 1, task & 1, wl, lane); } break;
        case 15: phase_final(tab, lane, wave); break;
        default: {
            GAS unsigned char* ws = WSP(); isg = true;
            const size_t aoff = (p == 2 || p == 14) ? WS_HID : (p == 5) ? WS_LIN : (p == 10) ? WS_ZA : (p == 11) ? WS_ZB : (p == 12) ? WS_MRG : WS_XB;
            const size_t boff = (p == 1) ? WS_W1GU : (p == 2) ? WS_W1D : (p == 3) ? WS_WIN : (p == 5) ? WS_WL : (p == 9) ? (WS_WIN + (size_t)3328 * D * 2) : (p == 10) ? WS_WOA : (p == 11) ? WS_WOB : (p == 12) ? WS_WO : (p == 13) ? WS_W2GU : WS_W2D;
            const int N = (p == 1 || p == 13) ? 2 * FF : (p == 3) ? 3328 : (p == 5) ? 1536 : (p == 9) ? 2048 : D;
            const int K = (p == 2 || p == 14) ? FF : (p == 5) ? 256 : (p == 10 || p == 11) ? 512 : D;
            typedef const unsigned short* gen_cbf16p; g = pg8::Gemm{(gen_cbf16p)(ws + aoff), (gen_cbf16p)(ws + boff), M, N, K}; } break;
        }
        if (isg) { pg8::Epi E{p, tab}; pg8::StaticOrder S; if (p == 9) S.init(M, D, G, (int)blockIdx.x, 4); else S.init(M, g.N, G, (int)blockIdx.x);     pg8::gemm_phase<pg8::Epi, pg8::StaticOrder, true, true>(lds, g, S, E); }
      }
        if (p + 1 < ph_hi && p != 9 && p != 10) { for (int sr = 0; sr < PROBE_SYNCREP; ++sr) {
            if (ph_hi > NPH) { __syncthreads(); cg::this_grid().sync(); }
            else { XcdBarrier bar; bar.bar = (unsigned*)WSP() + CW_BAR; bar.x = xb_xcc_id(); bar.st = (volatile LAS unsigned*)(lds + MISC_OFF); xcd_barrier(bar); } } }
    }
    if (PROBE_TIMEPH >= 0 && blockIdx.x == 0) { const unsigned long long span = (tp1 - tp0) * 9ull, t2 = __builtin_amdgcn_s_memrealtime(); while (__builtin_amdgcn_s_memrealtime() - t2 < span) __builtin_amdgcn_s_sleep(8); }
}

extern "C" void kernel_launch(void* const* d_in, const int* in_sizes, int n_in, void* d_out, int out_size, void* d_ws, size_t ws_size, hipStream_t stream) {
    static int grid = 0;
    if (grid == 0) {
        if (n_in != 27 || in_sizes[0] != M * D || out_size != M * D || ws_size < WS_END) { fprintf(stderr, "kernel_launch: unexpected shapes (n_in %d, in0 %d, out %d, ws %zu)\n", n_in, n_in > 0 ? in_sizes[0] : -1, out_size, ws_size); grid = -1; return; }
        int dev = 0, cus = 0, per_cu = 0;
        if (hipGetDevice(&dev) != hipSuccess || hipDeviceGetAttribute(&cus, hipDeviceAttributeMultiprocessorCount, dev) != hipSuccess) { grid = -1; return; }
        if (hipFuncSetAttribute((const void*)fwd, hipFuncAttributeMaxDynamicSharedMemorySize, LDS_BYTES) != hipSuccess) { fprintf(stderr, "kernel_launch: hipFuncSetAttribute failed\n"); grid = -1; return; }
        if (hipOccupancyMaxActiveBlocksPerMultiprocessor(&per_cu, (const void*)fwd, NWAVES * 64, LDS_BYTES) != hipSuccess || per_cu < 1) { fprintf(stderr, "kernel_launch: occupancy query says %d blocks per CU: this kernel cannot be resident, nothing launched\n", per_cu); (void)hipGetLastError(); grid = -1; return; }
        grid = cus * 1;
    }
    if (grid < 0) return;
    if (hipMemsetAsync(d_ws, 0, CTL_ZERO_BYTES, stream) != hipSuccess) { fprintf(stderr, "kernel_launch: hipMemsetAsync failed\n"); return; }
    Args a{};
    for (int i = 0; i < 27; ++i) a.in[i] = (const float*)d_in[i];
    a.out = (float*)d_out; a.ws = (unsigned char*)d_ws;
#if MK_PER_PHASE
    for (int p = 0; p < NPH; ++p) { a.ph_lo = p; a.ph_hi = p + 1; hipLaunchKernelGGL(fwd, dim3(grid), dim3(NWAVES * 64), LDS_BYTES, stream, a); }
#else
    a.ph_lo = 0; a.ph_hi = NPH;
    void* args[] = {&a};
    hipError_t e = hipLaunchCooperativeKernel((const void*)fwd, dim3(grid), dim3(NWAVES * 64), args, LDS_BYTES, stream);
    if (e != hipSuccess) fprintf(stderr, "kernel_launch: cooperative launch failed: %s (grid %d)\n", hipGetErrorString(e), grid);
#endif
}
```

```cpp
#include <hip/hip_runtime.h>
#include <hip/hip_cooperative_groups.h>
#include <cstdio>
#include <cstdint>
namespace cg = cooperative_groups;

#ifndef MK_PER_PHASE
#define MK_PER_PHASE 0
#endif
#ifndef PROBE_REPMASK
#define PROBE_REPMASK 0
#endif
#define PROBE_SYNCREP 1
#define PROBE_PBDRY 0
#define PROBE_TIMEPH -1
constexpr int NWAVES = 8;
constexpr int T = 8192, D = 1024, M = 16384, FF = 2816, NPH = 16;
constexpr size_t MiB = 1u << 20;
constexpr size_t WS_W1GU = 1 * MiB, WS_W1D = 12 * MiB, WS_W2GU = 17 * MiB + MiB / 2, WS_W2D = 28 * MiB + MiB / 2, WS_WIN = 34 * MiB, WS_WOA = 44 * MiB + MiB / 2,
                 WS_WOB = 45 * MiB + MiB / 2, WS_WO = 46 * MiB + MiB / 2, WS_WL = 48 * MiB + MiB / 2;
constexpr size_t WS_XB = 50 * MiB, WS_SSQ0 = 82 * MiB, WS_SSQ1 = 83 * MiB, WS_SSQ2 = 84 * MiB, WS_R = 85 * MiB;
constexpr size_t WS_HID = WS_R, WS_PA = WS_R, WS_PB = WS_R + 48 * MiB, WS_ZA = WS_R + 104 * MiB, WS_LIN = WS_R + 120 * MiB, WS_NS = WS_R + 128 * MiB, WS_ZB = WS_R + 144 * MiB;
constexpr size_t WS_LOGW = WS_R, WS_ICLR = WS_R + 16 * MiB, WS_GG = WS_R + 32 * MiB;
constexpr size_t WS_PC = WS_W1GU;
constexpr size_t WS_SG = WS_R, WS_MRG = WS_R + 64 * MiB;
constexpr size_t WS_Q0 = WS_LIN, WS_Q1 = WS_R + 160 * MiB, WS_BON = WS_SSQ0;
constexpr size_t WS_END = WS_R + 168 * MiB;
static_assert(WS_END <= 256 * MiB, "workspace map");
constexpr int CW_BAR = 4096, CW_PANEL = 8192; constexpr size_t CTL_ZERO_BYTES = 65536;
constexpr int MISC_OFF = 131072 + 512;
constexpr int LDS_BYTES = 147456;
constexpr int SCAN_WAVE_FLOATS = 7424;

#define LAS __attribute__((address_space(3)))
#define GAS __attribute__((address_space(1)))
typedef unsigned short bf16;
typedef unsigned v4u __attribute__((ext_vector_type(4)));
typedef float f32x4 __attribute__((ext_vector_type(4)));
typedef float f32x16 __attribute__((ext_vector_type(16)));
#define LDS_WAIT() asm volatile("s_waitcnt lgkmcnt(0)" ::: "memory")
__device__ __forceinline__ unsigned f2bf(float f) { unsigned u = __builtin_bit_cast(unsigned, f); return (u + 0x7fffu + ((u >> 16) & 1u)) >> 16; }
__device__ __forceinline__ unsigned pk2(float lo, float hi) { return f2bf(lo) | (f2bf(hi) << 16); }
__device__ __forceinline__ float bf2f(bf16 h) { return __uint_as_float((unsigned)h << 16); }
__device__ __forceinline__ float wave_sum(float v) {
#pragma unroll
    for (int o = 1; o < 64; o <<= 1) v += __shfl_xor(v, o);
    return v;
}
__device__ __forceinline__ float dppf(float x, int ctrl_is_xor2) {
    const int xi = __builtin_bit_cast(int, x);
    const int r = ctrl_is_xor2 ? __builtin_amdgcn_update_dpp(xi, xi, 0x4E, 0xF, 0xF, false) : __builtin_amdgcn_update_dpp(xi, xi, 0xB1, 0xF, 0xF, false);
    return __builtin_bit_cast(float, r);
}
__device__ __forceinline__ float quad_sum(float x) { x += dppf(x, 0); x += dppf(x, 1); return x; }
__device__ __forceinline__ float wave_sum_fast(float v) {
    v += dppf(v, 0); v += dppf(v, 1);
    { const int xi = __builtin_bit_cast(int, v); v += __builtin_bit_cast(float, __builtin_amdgcn_update_dpp(xi, xi, 0x141, 0xF, 0xF, false)); }
    { const int xi = __builtin_bit_cast(int, v); v += __builtin_bit_cast(float, __builtin_amdgcn_update_dpp(xi, xi, 0x140, 0xF, 0xF, false)); }
    const int vi = __builtin_bit_cast(int, v);
    return (__builtin_bit_cast(float, __builtin_amdgcn_readlane(vi, 0)) + __builtin_bit_cast(float, __builtin_amdgcn_readlane(vi, 16))) + (__builtin_bit_cast(float, __builtin_amdgcn_readlane(vi, 32)) + __builtin_bit_cast(float, __builtin_amdgcn_readlane(vi, 48)));
}
__device__ __forceinline__ float sigmf(float x) { return __builtin_amdgcn_rcpf(1.0f + __expf(-x)); }
__device__ __forceinline__ float tanhf_(float x) { return 1.0f - 2.0f * __builtin_amdgcn_rcpf(1.0f + __expf(2.0f * x)); }

constexpr int TAB_OFF = 131072 + 1024;
typedef LAS const unsigned long long* tab_t;
__device__ __forceinline__ unsigned long long ldptr_(tab_t tab, int i) {
    const unsigned long long v = tab[i];
    const unsigned lo = __builtin_amdgcn_readfirstlane((unsigned)v), hi = __builtin_amdgcn_readfirstlane((unsigned)(v >> 32));
    return ((unsigned long long)hi << 32) | lo;
}
#define INP(i) ((const GAS float*)ldptr_(tab, (i)))
#define OUTP() ((GAS float*)ldptr_(tab, 27))
#define WSP() ((GAS unsigned char*)ldptr_(tab, 28))
namespace pg8 {
#define PG8_LAS __attribute__((address_space(3)))
typedef unsigned short bf16_t;
typedef short bf16x8 __attribute__((ext_vector_type(8)));
typedef float f32x4 __attribute__((ext_vector_type(4)));
typedef unsigned u32x4 __attribute__((ext_vector_type(4)));
constexpr int BM = 256, BK = 64, HALF = 128, HTB = HALF * BK * 2  , STAGE_BYTES = 8 * HTB, NXCD = 8, WGM = 8;

__host__ __device__ __forceinline__ int lds_byte(int r, int c) { const int st = (r >> 4) * 2 + (c >> 5), rr = r & 15, cc = c & 31, ob = rr * 64 + cc * 2; return st * 1024 + (ob ^ (((ob >> 9) & 1) << 5)); }
__host__ __device__ __forceinline__ void stage_rc(int b, int& R, int& C) { const int st = b / 1024, sb = b % 1024, swz = sb ^ (((sb >> 9) & 1) << 5); R = (st >> 1) * 16 + swz / 64; C = (st & 1) * 32 + (swz % 64) / 2; }
__host__ __device__ __forceinline__ int perm32(int rho) { const int n = rho >> 4, i = rho & 15; return 8 * (i >> 2) + 4 * n + (i & 3); }

struct Unit { int pm, pn; };
struct Gemm { const bf16_t* A; const bf16_t* Bt; int M, N, K; };

struct StaticOrder {
    int nM, nN, nwg, G, c, pair;
    __host__ __device__ void init(int M, int N, int G_, int c_, int pair_ = 0) { nM = M / BM; nN = N / BM; nwg = nM * nN; G = G_; c = c_; pair = pair_; }
    __host__ __device__ bool next(int i0, Unit& u) const {
        const int i = pair ? (i0 >> 1) : i0; const int shift = pair ? pair * (i0 & 1) : 0;
        const long L = (long)i * G + c; if (L >= nwg) return false;
        int wgid = (int)L; { const int q = nwg / NXCD, r = nwg % NXCD, xcd = wgid % NXCD, off = wgid / NXCD; wgid = (xcd < r ? xcd * (q + 1) : r * (q + 1) + (xcd - r) * q) + off; }
        const int nig = WGM * nN, gid = wgid / nig, fm = gid * WGM, gsz = (nM - fm) < WGM ? (nM - fm) : WGM;
        u.pm = fm + ((wgid % nig) % gsz); u.pn = (wgid % nig) / gsz + shift; return true;
    }
    __device__ __forceinline__ void a_ready(const Unit&) const {}
    __device__ __forceinline__ void done(const Unit&) const {}
};
__device__ __forceinline__ unsigned cvt_pk_bf16(float lo, float hi) { unsigned r; asm volatile("v_cvt_pk_bf16_f32 %0, %1, %2" : "=v"(r) : "v"(lo), "v"(hi)); return r; }
__device__ __forceinline__ float sigm(float x) { return __builtin_amdgcn_rcpf(1.0f + __expf(-x)); }
__device__ __forceinline__ void store8(GAS bf16_t* p, f32x4 a, f32x4 b) {
    u32x4 w; w.x = cvt_pk_bf16(a[0], a[1]); w.y = cvt_pk_bf16(a[2], a[3]); w.z = cvt_pk_bf16(b[0], b[1]); w.w = cvt_pk_bf16(b[2], b[3]);
    *(GAS u32x4*)p = w;
}
__device__ __forceinline__ void load8(const GAS bf16_t* p, f32x4& a, f32x4& b) {
    const u32x4 w = *(const GAS u32x4*)p;
    a[0] = __uint_as_float(w.x << 16); a[1] = __uint_as_float(w.x & 0xffff0000u); a[2] = __uint_as_float(w.y << 16); a[3] = __uint_as_float(w.y & 0xffff0000u);
    b[0] = __uint_as_float(w.z << 16); b[1] = __uint_as_float(w.z & 0xffff0000u); b[2] = __uint_as_float(w.w << 16); b[3] = __uint_as_float(w.w & 0xffff0000u);
}
enum { EM_SWIGLU = 0, EM_RESID = 1, EM_PAB = 2, EM_LORA = 3, EM_GATES = 4, EM_MERGE1 = 5, EM_MERGE2 = 6 };
struct Epi {
    static constexpr bool PERM = true, AFTER_DRAIN = false;
    int p; tab_t tab;
    __device__ __forceinline__ void operator()(const f32x4 (&acc)[2][2][4][2], const Unit& u, int wr, int wc, int fr, int fq) const {
        GAS unsigned char* ws = WSP();
        const int mode = (p == 1 || p == 13) ? EM_SWIGLU : (p == 2 || p == 12 || p == 14) ? EM_RESID : (p == 3) ? EM_PAB : (p == 5) ? EM_LORA : (p == 9) ? EM_GATES : (p == 10) ? EM_MERGE1 : EM_MERGE2;
        const GAS float* ssq = (const GAS float*)(ws + (p == 1 ? WS_SSQ0 : (p == 13 ? WS_SSQ2 : WS_SSQ1)));
        GAS bf16_t* o0 = nullptr; GAS bf16_t* o1 = nullptr; GAS bf16_t* o2 = nullptr; const GAS float* base = nullptr; GAS float* outf = nullptr; GAS float* ssq_out = nullptr; float scale = 1.f;
        const GAS bf16_t* sg = (const GAS bf16_t*)(ws + WS_SG); const GAS float* q0 = nullptr; const GAS float* q1 = nullptr;
        if (mode == EM_SWIGLU) o0 = (GAS bf16_t*)(ws + WS_HID);
        else if (mode == EM_RESID) { outf = OUTP(); base = (p == 2) ? INP(0) : (const GAS float*)outf; o0 = (p == 14) ? nullptr : (GAS bf16_t*)(ws + WS_XB);
                                     ssq_out = (p == 14) ? nullptr : (GAS float*)(ws + (p == 2 ? WS_SSQ1 : WS_SSQ2)); scale = (p == 12) ? 1.0f : 0.5f; }
        else if (mode == EM_PAB) { o0 = (GAS bf16_t*)(ws + WS_PA); o1 = (GAS bf16_t*)(ws + WS_PB); }
        else if (mode == EM_LORA) { o0 = (GAS bf16_t*)(ws + WS_LOGW); o1 = (GAS bf16_t*)(ws + WS_ICLR); o2 = (GAS bf16_t*)(ws + WS_GG); q0 = INP(10); q1 = INP(12); }
        else if (mode == EM_GATES) o0 = (GAS bf16_t*)(ws + WS_SG);
        else o0 = (GAS bf16_t*)(ws + WS_MRG);
        const int rowb = u.pm * BM + wr * 64 + fr;
        const int cw = wc * 32 + 8 * fq;
#pragma unroll
        for (int ai = 0; ai < 2; ++ai)
#pragma unroll
            for (int m = 0; m < 4; ++m) {
                const size_t row = (size_t)(rowb + ai * HALF + m * 16);
                float s = 1.f;
                if (mode == EM_SWIGLU || mode == EM_PAB || mode == EM_GATES) {
                    const GAS f32x4* q = (const GAS f32x4*)(ssq + row * 16);
                    const f32x4 a = q[0], b = q[1], c = q[2], d = q[3];
                    const f32x4 t = (a + b) + (c + d);
                    s = rsqrtf(((t[0] + t[1]) + (t[2] + t[3])) * (1.0f / 1024.0f) + 1e-6f);
                }
                if (mode == EM_SWIGLU) {
                    f32x4 h0, h1;
#pragma unroll
                    for (int j = 0; j < 4; ++j) {
                        const float g0 = acc[ai][0][m][0][j] * s, u0 = acc[ai][1][m][0][j] * s;
                        const float g1 = acc[ai][0][m][1][j] * s, u1 = acc[ai][1][m][1][j] * s;
                        h0[j] = g0 * sigm(g0) * u0; h1[j] = g1 * sigm(g1) * u1;
                    }
                    store8(o0 + row * 2816 + u.pn * 128 + cw, h0, h1);
                } else if (mode == EM_RESID) {
                    float part = 0.f;
#pragma unroll
                    for (int bj = 0; bj < 2; ++bj) {
                        const size_t off = row * 1024 + u.pn * 256 + bj * HALF + cw;
                        const f32x4 b0 = *(const GAS f32x4*)(base + off), b1 = *(const GAS f32x4*)(base + off + 4);
                        const f32x4 v0 = b0 + acc[ai][bj][m][0] * scale, v1 = b1 + acc[ai][bj][m][1] * scale;
                        *(GAS f32x4*)(outf + off) = v0; *(GAS f32x4*)(outf + off + 4) = v1;
                        if (o0) store8(o0 + off, v0, v1);
                        part += (v0[0] * v0[0] + v0[1] * v0[1]) + (v0[2] * v0[2] + v0[3] * v0[3]) + (v1[0] * v1[0] + v1[1] * v1[1]) + (v1[2] * v1[2] + v1[3] * v1[3]);
                    }
                    if (ssq_out) { part += __shfl_xor(part, 16); part += __shfl_xor(part, 32); if (fq == 0) ssq_out[row * 16 + u.pn * 4 + wc] = part; }
                } else {
#pragma unroll
                    for (int bj = 0; bj < 2; ++bj) {
                        const int col = u.pn * 256 + bj * HALF + cw;
                        f32x4 v0 = acc[ai][bj][m][0], v1 = acc[ai][bj][m][1];
                        if (mode == EM_PAB) {
                            v0 = v0 * s; v1 = v1 * s;
                            if (u.pn < 6) store8(o0 + row * 1536 + col, v0, v1); else store8(o1 + row * 1792 + (col - 1536), v0, v1);
                        } else if (mode == EM_LORA) {
                            const int sel = u.pn >> 1, c = col & 511;
                            if (sel == 0) {
                                const f32x4 p0 = *(const GAS f32x4*)(q0 + c), p1 = *(const GAS f32x4*)(q0 + c + 4);
#pragma unroll
                                for (int j = 0; j < 4; ++j) { v0[j] = -0.6065306597f * sigm(p0[j] + v0[j]); v1[j] = -0.6065306597f * sigm(p1[j] + v1[j]); }
                                store8(o0 + row * 512 + c, v0, v1);
                            } else if (sel == 1) {
                                const f32x4 p0 = *(const GAS f32x4*)(q1 + c), p1 = *(const GAS f32x4*)(q1 + c + 4);
#pragma unroll
                                for (int j = 0; j < 4; ++j) { v0[j] = sigm(p0[j] + v0[j]); v1[j] = sigm(p1[j] + v1[j]); }
                                store8(o1 + row * 512 + c, v0, v1);
                            } else store8(o2 + row * 512 + c, v0, v1);
                        } else if (mode == EM_GATES) {
#pragma unroll
                            for (int j = 0; j < 4; ++j) { v0[j] = sigm(v0[j] * s); v1[j] = sigm(v1[j] * s); }
                            store8(o0 + row * 2048 + col, v0, v1);
                        } else if (mode == EM_MERGE1) {
                            f32x4 g0, g1; load8(sg + row * 2048 + col, g0, g1);
                            store8(o0 + row * 1024 + col, g0 * v0, g1 * v1);
                        } else {
                            f32x4 g0, g1, m0, m1; load8(sg + row * 2048 + 1024 + col, g0, g1); load8(o0 + row * 1024 + col, m0, m1);
                            store8(o0 + row * 1024 + col, m0 + g0 * v0, m1 + g1 * v1);
                        }
                    }
                }
            }
    }
};

template <class Epi, class Sched, bool ALIGN_EPI = false, bool SP2 = false>
__device__ __forceinline__ void gemm_phase(PG8_LAS unsigned char* lds, const Gemm g, const Sched& S, const Epi& E) {
    const int tid = threadIdx.x, wid = __builtin_amdgcn_readfirstlane(tid >> 6), lane = tid & 63, wr = wid >> 2, wc = wid & 3, fr = lane & 15, fq = lane >> 4;
    const int K = g.K, nt = K / BK;
    unsigned voffA[2], voffB[2];
#pragma unroll
    for (int i = 0; i < 2; ++i) { int R, C; stage_rc(tid * 16 + i * 8192, R, C); const int Rb = Epi::PERM ? ((R & ~31) + perm32(R & 31)) : R;
        voffA[i] = (unsigned)(R * K + C) * 2u; voffB[i] = (unsigned)(Rb * K + C) * 2u; }
    const size_t kstep = (size_t)(BK * 2);
    const size_t hstep = (size_t)HALF * K * 2;
    const size_t tstep = 2 * hstep;
    const unsigned ldsw = (unsigned)wid * 1024u;
    const int aoff = lds_byte(wr * 64 + fr, fq * 8), boff = lds_byte(wc * 32 + fr, fq * 8);
#define PG8_SA(b, h) (((b) * 2 + (h)) * HTB)
#define PG8_SB(b, h) ((4 + (b) * 2 + (h)) * HTB)
#define PG8_STAGE(bufoff, gbase, voff) do { _Pragma("unroll") for (int _i = 0; _i < 2; ++_i) \
        __builtin_amdgcn_global_load_lds((const unsigned*)((const char*)(gbase) + (voff)[_i]), (PG8_LAS unsigned*)(lds + (bufoff) + ldsw + _i * 8192), 16, 0, 0); } while (0)
#define PG8_LDA(dst, b, h) do { _Pragma("unroll") for (int m = 0; m < 4; ++m) _Pragma("unroll") for (int k = 0; k < 2; ++k) dst[m][k] = *(const PG8_LAS bf16x8*)(lds + PG8_SA(b, h) + aoff + m * 2048 + k * 1024); } while (0)
#define PG8_LDB(dst, b, h) do { _Pragma("unroll") for (int n = 0; n < 2; ++n) _Pragma("unroll") for (int k = 0; k < 2; ++k) dst[n][k] = *(const PG8_LAS bf16x8*)(lds + PG8_SB(b, h) + boff + n * 2048 + k * 1024); } while (0)
#define PG8_MMA(ai, bj, At, Bt) do { __builtin_amdgcn_s_setprio(1); _Pragma("unroll") for (int m = 0; m < 4; ++m) _Pragma("unroll") for (int n = 0; n < 2; ++n) _Pragma("unroll") for (int k = 0; k < 2; ++k) \
        acc[ai][bj][m][n] = __builtin_amdgcn_mfma_f32_16x16x32_bf16(Bt[n][k], At[m][k], acc[ai][bj][m][n], 0, 0, 0); __builtin_amdgcn_s_setprio(0); } while (0)
#define PG8_WAIT_V(n) asm volatile("s_waitcnt vmcnt(" #n ")" ::: "memory")
#define PG8_WAIT_L(n) asm volatile("s_waitcnt lgkmcnt(" #n ")" ::: "memory")
#define PG8_BAR __builtin_amdgcn_s_barrier()
#define PG8_SCHED __builtin_amdgcn_sched_barrier(0)
    Unit cur, nxt; int ui = 0;
    if (!S.next(0, cur)) return;
    f32x4 acc[2][2][4][2];
#pragma unroll
    for (int a = 0; a < 2; ++a)
#pragma unroll
        for (int b = 0; b < 2; ++b)
#pragma unroll
            for (int m = 0; m < 4; ++m)
#pragma unroll
                for (int n = 0; n < 2; ++n) acc[a][b][m][n] = (f32x4){0.f, 0.f, 0.f, 0.f};
    bf16x8 At[4][2], B0[2][2], B1[2][2];
    const char* cA = (const char*)g.A + (size_t)cur.pm * tstep; const char* cB = (const char*)g.Bt + (size_t)cur.pn * tstep;
    S.a_ready(cur);
    if constexpr (SP2) {
        PG8_STAGE(PG8_SB(0, 0), cB, voffB); PG8_STAGE(PG8_SB(0, 1), cB + hstep, voffB); PG8_STAGE(PG8_SA(0, 0), cA, voffA); PG8_STAGE(PG8_SA(0, 1), cA + hstep, voffA);
        if (wr == 1) PG8_BAR;
        PG8_WAIT_V(2); PG8_BAR;
        PG8_STAGE(PG8_SB(1, 0), cB + kstep, voffB); PG8_STAGE(PG8_SA(1, 0), cA + kstep, voffA); PG8_STAGE(PG8_SB(1, 1), cB + hstep + kstep, voffB);
        PG8_WAIT_V(6); PG8_BAR;
    } else {
        PG8_STAGE(PG8_SB(0, 0), cB, voffB); PG8_STAGE(PG8_SA(0, 0), cA, voffA); PG8_STAGE(PG8_SB(0, 1), cB + hstep, voffB); PG8_STAGE(PG8_SA(0, 1), cA + hstep, voffA);
        if (wr == 1) PG8_BAR;
        PG8_WAIT_V(4); PG8_BAR;
        PG8_STAGE(PG8_SB(1, 0), cB + kstep, voffB); PG8_STAGE(PG8_SA(1, 0), cA + kstep, voffA); PG8_STAGE(PG8_SB(1, 1), cB + hstep + kstep, voffB);
        PG8_WAIT_V(6); PG8_BAR;
    }
    for (;;) {
        const bool has_next = S.next(ui + 1, nxt);
        const char* nA = has_next ? (const char*)g.A + (size_t)nxt.pm * tstep : cA; const char* nB = has_next ? (const char*)g.Bt + (size_t)nxt.pn * tstep : cB;
        for (int t = 0; t < nt; t += 2) {
            const bool last = (t == nt - 2);
            const char* a1 = cA + (size_t)(t + 1) * kstep;
            const char* a2 = last ? nA : cA + (size_t)(t + 2) * kstep; const char* b2 = last ? nB : cB + (size_t)(t + 2) * kstep;
            const char* a3 = a2 + kstep; const char* b3 = b2 + kstep;
            if (last && has_next) S.a_ready(nxt);
            if constexpr (SP2) {
            PG8_LDB(B0, 0, 0); PG8_LDB(B1, 0, 1); PG8_SCHED; PG8_LDA(At, 0, 0); PG8_STAGE(PG8_SA(1, 1), a1 + hstep, voffA);
            PG8_WAIT_V(8); PG8_WAIT_L(0); PG8_BAR; PG8_MMA(0, 0, At, B0); PG8_MMA(0, 1, At, B1); PG8_BAR; PG8_SCHED;
            PG8_LDA(At, 0, 1); PG8_STAGE(PG8_SB(0, 0), b2, voffB); PG8_STAGE(PG8_SB(0, 1), b2 + hstep, voffB); PG8_STAGE(PG8_SA(0, 0), a2, voffA);
            PG8_WAIT_V(8); PG8_WAIT_L(0); PG8_BAR; PG8_MMA(1, 0, At, B0); PG8_MMA(1, 1, At, B1); PG8_BAR; PG8_SCHED;
            PG8_LDB(B0, 1, 0); PG8_LDB(B1, 1, 1); PG8_SCHED; PG8_LDA(At, 1, 0); PG8_STAGE(PG8_SA(0, 1), a2 + hstep, voffA);
            PG8_WAIT_V(8); PG8_WAIT_L(0); PG8_BAR; PG8_MMA(0, 0, At, B0); PG8_MMA(0, 1, At, B1); PG8_BAR; PG8_SCHED;
            PG8_LDA(At, 1, 1); PG8_STAGE(PG8_SB(1, 0), b3, voffB); PG8_STAGE(PG8_SB(1, 1), b3 + hstep, voffB); PG8_STAGE(PG8_SA(1, 0), a3, voffA);
            PG8_WAIT_V(8); PG8_WAIT_L(0); PG8_BAR; PG8_MMA(1, 0, At, B0); PG8_MMA(1, 1, At, B1); PG8_BAR; PG8_SCHED;
            } else {
            PG8_LDB(B0, 0, 0); PG8_SCHED; PG8_LDA(At, 0, 0); PG8_STAGE(PG8_SA(1, 1), a1 + hstep, voffA);
            PG8_WAIT_L(8); PG8_BAR; PG8_WAIT_L(0); PG8_MMA(0, 0, At, B0); PG8_BAR; PG8_SCHED;
            PG8_LDB(B1, 0, 1); PG8_STAGE(PG8_SB(0, 0), b2, voffB);
            PG8_BAR; PG8_WAIT_L(0); PG8_MMA(0, 1, At, B1); PG8_BAR;
            PG8_LDA(At, 0, 1); PG8_STAGE(PG8_SA(0, 0), a2, voffA);
            PG8_BAR; PG8_WAIT_L(0); PG8_MMA(1, 0, At, B0); PG8_BAR; PG8_SCHED;
            PG8_STAGE(PG8_SB(0, 1), b2 + hstep, voffB);
            PG8_WAIT_V(6); PG8_BAR; PG8_MMA(1, 1, At, B1); PG8_BAR;
            PG8_LDB(B0, 1, 0); PG8_SCHED; PG8_LDA(At, 1, 0); PG8_STAGE(PG8_SA(0, 1), a2 + hstep, voffA);
            PG8_WAIT_L(8); PG8_BAR; PG8_WAIT_L(0); PG8_MMA(0, 0, At, B0); PG8_BAR; PG8_SCHED;
            PG8_LDB(B1, 1, 1); PG8_STAGE(PG8_SB(1, 0), b3, voffB);
            PG8_BAR; PG8_WAIT_L(0); PG8_MMA(0, 1, At, B1); PG8_BAR;
            PG8_LDA(At, 1, 1); PG8_STAGE(PG8_SA(1, 0), a3, voffA);
            PG8_BAR; PG8_WAIT_L(0); PG8_MMA(1, 0, At, B0); PG8_BAR; PG8_SCHED;
            PG8_STAGE(PG8_SB(1, 1), b3 + hstep, voffB);
            PG8_WAIT_V(6); PG8_BAR; PG8_MMA(1, 1, At, B1); PG8_BAR;
            }
        }
        if constexpr (ALIGN_EPI) { if (wr == 0) PG8_BAR; }
        if constexpr (!Epi::AFTER_DRAIN) { E(acc, cur, wr, wc, fr, fq); S.done(cur); }
        if (!has_next) break;
#pragma unroll
        for (int a = 0; a < 2; ++a)
#pragma unroll
            for (int b = 0; b < 2; ++b)
#pragma unroll
                for (int m = 0; m < 4; ++m)
#pragma unroll
                    for (int n = 0; n < 2; ++n) acc[a][b][m][n] = (f32x4){0.f, 0.f, 0.f, 0.f};
        cur = nxt; cA = nA; cB = nB; ++ui;
        if constexpr (ALIGN_EPI) { if (wr == 1) PG8_BAR; }
    }
    PG8_WAIT_V(0);
    if constexpr (!ALIGN_EPI) { if (wr == 0) PG8_BAR; }
    PG8_BAR;
    if constexpr (Epi::AFTER_DRAIN) { E.fused(acc, cur, wr, wc, fr, fq, lds, wid, lane); S.done(cur); }
#undef PG8_SA
#undef PG8_SB
#undef PG8_STAGE
#undef PG8_LDA
#undef PG8_LDB
#undef PG8_MMA
#undef PG8_WAIT_V
#undef PG8_WAIT_L
#undef PG8_BAR
#undef PG8_SCHED
}
}
struct Args { const float* in[27]; float* out; unsigned char* ws; int ph_lo, ph_hi; };

__device__ __forceinline__ void transpose_item(const GAS float* W, int K, int N, GAS bf16* WT, const GAS float* gain, int il, LAS float* scr, int item, int lane) {
    const int nblk = N / 32, kb = item / nblk, nb = item % nblk, k0 = 64 * kb, n0 = 32 * nb;
    float v[32];
    const GAS float* src = W + (size_t)(k0 + (lane >> 5)) * N + n0 + (lane & 31);
#pragma unroll
    for (int i = 0; i < 32; ++i) v[i] = src[(size_t)(2 * i) * N];
    if (gain) {
        float gg[32];
#pragma unroll
        for (int i = 0; i < 32; ++i) gg[i] = gain[k0 + 2 * i + (lane >> 5)];
#pragma unroll
        for (int i = 0; i < 32; ++i) v[i] *= gg[i];
    }
#pragma unroll
    for (int i = 0; i < 32; ++i) scr[(2 * i + (lane >> 5)) * 33 + (lane & 31)] = v[i];
    LDS_WAIT(); asm volatile("" ::: "memory");
    const int drow0 = il ? (((n0 >> 7) << 8) + (n0 & 127) + (il == 2 ? 128 : 0)) : n0;
    const int c = lane & 7;
#pragma unroll
    for (int j = 0; j < 4; ++j) { const int n = (lane >> 3) + 8 * j; const LAS float* s = scr + (8 * c) * 33 + n;
        v4u o; o.x = pk2(s[0 * 33], s[1 * 33]); o.y = pk2(s[2 * 33], s[3 * 33]); o.z = pk2(s[4 * 33], s[5 * 33]); o.w = pk2(s[6 * 33], s[7 * 33]);
        *(GAS v4u*)(WT + (size_t)(drow0 + n) * K + k0 + 8 * c) = o; }
    LDS_WAIT(); asm volatile("" ::: "memory");
}
constexpr int WI_GU = (D / 64) * (FF / 32), WI_DN = (FF / 64) * (D / 32), WI_IN = (D / 64) * (5376 / 32), WI_OA = (512 / 64) * (D / 32), WI_O = (D / 64) * (D / 32);
constexpr int WO3 = 2 * WI_GU + WI_DN, WO4 = WO3 + WI_IN, WO6 = WO4 + 2 * WI_GU, WO_END = WO6 + WI_DN + 2 * WI_OA + WI_O;
__device__ __forceinline__ void weights_copy(tab_t tab, LAS unsigned char* lds, int lane, int wave, int gw, int NGW, int lo, int hi) {
    asm volatile("" : "+v"(lane));
    GAS unsigned char* ws = WSP();
    LAS float* scr = (LAS float*)(lds + wave * 16384);
    for (int it = lo + gw; it < hi; it += NGW) {
        int r = it, wi, K, N, gi = -1, il = 0; size_t woff;
        if (r < WI_GU) { wi = 2; K = D; N = FF; woff = WS_W1GU; gi = 1; il = 1; }
        else if ((r -= WI_GU) < WI_GU) { wi = 3; K = D; N = FF; woff = WS_W1GU; gi = 1; il = 2; }
        else if ((r -= WI_GU) < WI_DN) { wi = 4; K = FF; N = D; woff = WS_W1D; }
        else if ((r -= WI_DN) < WI_IN) { wi = 6; K = D; N = 5376; woff = WS_WIN; gi = 5; }
        else if ((r -= WI_IN) < WI_GU) { wi = 23; K = D; N = FF; woff = WS_W2GU; gi = 22; il = 1; }
        else if ((r -= WI_GU) < WI_GU) { wi = 24; K = D; N = FF; woff = WS_W2GU; gi = 22; il = 2; }
        else if ((r -= WI_GU) < WI_DN) { wi = 25; K = FF; N = D; woff = WS_W2D; }
        else if ((r -= WI_DN) < WI_OA) { wi = 8; K = 512; N = D; woff = WS_WOA; }
        else if ((r -= WI_OA) < WI_OA) { wi = 20; K = 512; N = D; woff = WS_WOB; }
        else { r -= WI_OA; wi = 21; K = D; N = D; woff = WS_WO; }
        transpose_item(INP(wi), K, N, (GAS bf16*)(ws + woff), gi >= 0 ? INP(gi) : (const GAS float*)nullptr, il, scr, r, lane);
    }
}
__device__ __forceinline__ void phase_prologue(tab_t tab, LAS unsigned char* lds, int tid, int lane, int wave) {
    asm volatile("" : "+v"(lane), "+v"(tid));
    GAS unsigned char* ws = WSP();
    const int G = gridDim.x, gw = blockIdx.x * NWAVES + wave, NGW = G * NWAVES;
    weights_copy(tab, lds, lane, wave, gw, NGW, 0, WO3);
    { GAS bf16* WL = (GAS bf16*)(ws + WS_WL); const GAS float* wdu = INP(11); const GAS float* wiu = INP(13); const GAS float* wgu = INP(14);
      for (int idx = blockIdx.x * 512 + tid; idx < 1536 * 256; idx += G * 512) {
          const int n = idx >> 8, kc = idx & 255; float v = 0.f;
          if (n < 512) { if (kc < 64) v = wdu[kc * 512 + n]; }
          else if (n < 1024) { if (kc >= 64 && kc < 128) v = wiu[(kc - 64) * 512 + (n - 512)]; }
          else { if (kc >= 128) v = wgu[(kc - 128) * 512 + (n - 1024)]; }
          WL[idx] = (bf16)f2bf(v); } }
    { const GAS float* x = INP(0); GAS bf16* xb = (GAS bf16*)(ws + WS_XB); GAS float* ssq0 = (GAS float*)(ws + WS_SSQ0);
      for (int m = gw; m < M; m += 2 * NGW) {
          const int m2 = m + NGW; const bool has2 = m2 < M;
          const GAS f32x4* xr = (const GAS f32x4*)(x + (size_t)m * D) + lane; const GAS f32x4* xr2 = (const GAS f32x4*)(x + (size_t)(has2 ? m2 : m) * D) + lane;
          f32x4 v[4], w[4]; float s = 0.f, s2 = 0.f;
#pragma unroll
          for (int j = 0; j < 4; ++j) { v[j] = xr[64 * j]; w[j] = xr2[64 * j]; }
#pragma unroll
          for (int j = 0; j < 4; ++j) { s += (v[j][0] * v[j][0] + v[j][1] * v[j][1]) + (v[j][2] * v[j][2] + v[j][3] * v[j][3]); s2 += (w[j][0] * w[j][0] + w[j][1] * w[j][1]) + (w[j][2] * w[j][2] + w[j][3] * w[j][3]); }
          s = wave_sum(s); s2 = wave_sum(s2);
          GAS unsigned long long* o8 = (GAS unsigned long long*)(xb + (size_t)m * D) + lane;
#pragma unroll
          for (int j = 0; j < 4; ++j) o8[64 * j] = (unsigned long long)pk2(v[j][0], v[j][1]) | ((unsigned long long)pk2(v[j][2], v[j][3]) << 32);
          if (lane < 16) ssq0[(size_t)m * 16 + lane] = (lane == 0) ? s : 0.f;
          if (has2) {
              GAS unsigned long long* p8 = (GAS unsigned long long*)(xb + (size_t)m2 * D) + lane;
#pragma unroll
              for (int j = 0; j < 4; ++j) p8[64 * j] = (unsigned long long)pk2(w[j][0], w[j][1]) | ((unsigned long long)pk2(w[j][2], w[j][3]) << 32);
              if (lane < 16) ssq0[(size_t)m2 * 16 + lane] = (lane == 0) ? s2 : 0.f;
          }
      } }
}

__device__ __forceinline__ void ld8(const GAS bf16* p, float (&v)[8]) {
    const v4u w = *(const GAS v4u*)p;
    v[0] = __uint_as_float(w.x << 16); v[1] = __uint_as_float(w.x & 0xffff0000u); v[2] = __uint_as_float(w.y << 16); v[3] = __uint_as_float(w.y & 0xffff0000u);
    v[4] = __uint_as_float(w.z << 16); v[5] = __uint_as_float(w.z & 0xffff0000u); v[6] = __uint_as_float(w.w << 16); v[7] = __uint_as_float(w.w & 0xffff0000u);
}
__device__ __forceinline__ void st8(GAS bf16* p, const float (&v)[8]) {
    v4u w; w.x = pk2(v[0], v[1]); w.y = pk2(v[2], v[3]); w.z = pk2(v[4], v[5]); w.w = pk2(v[6], v[7]); *(GAS v4u*)p = w;
}
__device__ __forceinline__ void phase_prep(tab_t tab, int tid) {
    asm volatile("" : "+v"(tid));
    GAS unsigned char* ws = WSP();
    const GAS bf16* PA = (const GAS bf16*)(ws + WS_PA); const GAS bf16* PB = (const GAS bf16*)(ws + WS_PB);
    GAS bf16* ZA = (GAS bf16*)(ws + WS_ZA); GAS bf16* LIN = (GAS bf16*)(ws + WS_LIN);
    const GAS float* cw = INP(7); const GAS float* mu = INP(9);
    const int gt = blockIdx.x * 512 + tid, NT = gridDim.x * 512;
    for (int it = gt; it < M * 64; it += NT) {
        const int m = it >> 6, c0 = (it & 63) * 8, t = m & (T - 1);
        float bb[8], c_[8], u_[8], acc[8], w0[8], w1[8], w2[8];
#pragma unroll
        for (int j = 0; j < 8; ++j) { w0[j] = cw[c0 + j]; w1[j] = cw[512 + c0 + j]; w2[j] = cw[1024 + c0 + j]; }
        const GAS bf16* row = PA + (size_t)m * 1536;
        ld8(row + c0, bb); ld8(row + 512 + c0, c_); ld8(row + 1024 + c0, u_);
#pragma unroll
        for (int j = 0; j < 8; ++j) acc[j] = w2[j] * (c_[j] * u_[j]);
        if (t >= 1) { ld8(row - 1536 + 512 + c0, c_); ld8(row - 1536 + 1024 + c0, u_);
#pragma unroll
            for (int j = 0; j < 8; ++j) acc[j] += w1[j] * (c_[j] * u_[j]); }
        if (t >= 2) { ld8(row - 3072 + 512 + c0, c_); ld8(row - 3072 + 1024 + c0, u_);
#pragma unroll
            for (int j = 0; j < 8; ++j) acc[j] += w0[j] * (c_[j] * u_[j]); }
#pragma unroll
        for (int j = 0; j < 8; ++j) acc[j] *= bb[j];
        st8(ZA + (size_t)m * 512 + c0, acc);
    }
    for (int it = gt; it < M * 32; it += NT) {
        const int m = it >> 5, c0 = (it & 31) * 8, t = m & (T - 1);
        float x[8], xp[8];
        const GAS bf16* row = PB + (size_t)m * 1792 + 1536 + c0;
        ld8(row, x);
        if (t >= 1) ld8(row - 1792, xp); else {
#pragma unroll
            for (int j = 0; j < 8; ++j) xp[j] = 0.f; }
#pragma unroll
        for (int j = 0; j < 8; ++j) { float v = x[j] + (xp[j] - x[j]) * mu[1536 + c0 + j]; x[j] = (c0 < 64) ? tanhf_(v) : ((c0 < 128) ? v : sigmf(v)); }
        st8(LIN + (size_t)m * 256 + c0, x);
    }
}

struct ScanCtx {
    const GAS bf16* PB; const GAS bf16* LOGW; const GAS bf16* ICLR; const GAS bf16* GG; GAS bf16* ZB; GAS float* PC; GAS float* NS;
    const GAS float* mu; const GAS float* k_k; const GAS float* k_a; const GAS float* r_k; const GAS float* lnw; const GAS float* lnb;
    GAS bf16* Q0; GAS bf16* Q1; GAS float* BON;
};
template <int CTRL> __device__ __forceinline__ float dppx(float x) {
    const int xi = __builtin_bit_cast(int, x);
    return __builtin_bit_cast(float, __builtin_amdgcn_update_dpp(xi, xi, CTRL, 0xF, 0xF, false));
}
__device__ __forceinline__ float wave_sum_dpp(float v) {
    v += dppx<0xB1>(v); v += dppx<0x4E>(v); v += dppx<0x141>(v); v += dppx<0x140>(v);
    const int vi = __builtin_bit_cast(int, v);
    const float s0 = __builtin_bit_cast(float, __builtin_amdgcn_readlane(vi, 0)), s1 = __builtin_bit_cast(float, __builtin_amdgcn_readlane(vi, 16));
    const float s2 = __builtin_bit_cast(float, __builtin_amdgcn_readlane(vi, 32)), s3 = __builtin_bit_cast(float, __builtin_amdgcn_readlane(vi, 48));
    return (s0 + s1) + (s2 + s3);
}
typedef float f32x2 __attribute__((ext_vector_type(2)));
#define LBAR() do { asm volatile("s_waitcnt lgkmcnt(0)" ::: "memory"); __builtin_amdgcn_s_barrier(); asm volatile("" ::: "memory"); } while (0)
struct Raw4 { unsigned r[5], k[5], v[5], lw[4], ic[4]; };
__device__ __forceinline__ void load_raw4(const ScanCtx& X, int ms, bool prev_valid, int hc, Raw4& q) {
#pragma unroll
    for (int j = 0; j < 5; ++j) {
        const int m = (j == 0 && !prev_valid) ? ms : (ms - 1 + j);
        const GAS bf16* row = X.PB + (size_t)m * 1792;
        q.r[j] = row[hc]; q.k[j] = row[512 + hc]; q.v[j] = row[1024 + hc];
    }
    if (!prev_valid) { q.r[0] = 0u; q.k[0] = 0u; q.v[0] = 0u; }
#pragma unroll
    for (int j = 0; j < 4; ++j) { q.lw[j] = X.LOGW[(size_t)(ms + j) * 512 + hc]; q.ic[j] = X.ICLR[(size_t)(ms + j) * 512 + hc]; }
}
template <int PASS, int MODE>
__device__ __forceinline__ void scan_pair(const ScanCtx& X, int cid, bool active, int role, LAS float* pl, int lane) {
    asm volatile("" : "+v"(lane));
    constexpr int R = (PASS == 0) ? 4 : 2;
    const int bh = cid >> 6, c = cid & 63, b = bh >> 3, h = bh & 7;
    const int m0 = b * T + c * 128;
    const int rg = lane >> 2, ks = lane & 3;
    const int hc = h * 64 + lane;
    const int row0 = (PASS == 0) ? rg * 4 : role * 32 + rg * 2;
    f32x2 S[R][8];
#pragma unroll
    for (int i = 0; i < R; ++i)
#pragma unroll
        for (int j = 0; j < 8; ++j) { S[i][j].x = (MODE == 0 && (row0 + i) == (ks * 16 + 2 * j)) ? 1.f : 0.f; S[i][j].y = (MODE == 0 && (row0 + i) == (ks * 16 + 2 * j + 1)) ? 1.f : 0.f; }
    if (MODE == 2 && c > 0 && active) {
        const GAS float* src = X.NS + (size_t)(cid - 1) * 4096;
#pragma unroll
        for (int i = 0; i < R; ++i)
#pragma unroll
            for (int q = 0; q < 4; ++q) { const f32x4 v = *(const GAS f32x4*)(src + (row0 + i) * 64 + ks * 16 + q * 4); S[i][2 * q] = (f32x2){v[0], v[1]}; S[i][2 * q + 1] = (f32x2){v[2], v[3]}; }
    }
    const float mu_r = X.mu[hc], mu_k = X.mu[512 + hc], mu_v = X.mu[1024 + hc];
    const float kk_c = X.k_k[hc], ka_c = X.k_a[hc], rk_c = X.r_k[hc], lnw = X.lnw[hc], lnb = X.lnb[hc];
    LAS float* LY = pl + 6400;
    const int s0 = role * 4;
    Raw4 cur;
    if (active) load_raw4(X, m0 + s0, !(c == 0 && role == 0), hc, cur);
    for (int sub = 0; sub < 16; ++sub) {
        const int mb = m0 + sub * 8;
        LAS float* vb = pl + (sub & 1) * 3200;
        LAS float* LA = vb; LAS float* LW = vb + 512; LAS float* LB = vb + 1024; LAS float* LK = vb + 1536; LAS float* LR = vb + 2048; LAS float* LV = vb + 2560; LAS float* LBon = vb + 3072;
        unsigned gq[4];
        if (active) {
#pragma unroll
            for (int j = 0; j < 4; ++j) {
                const int s = s0 + j;
                const float rc = __uint_as_float(cur.r[j + 1] << 16), kc = __uint_as_float(cur.k[j + 1] << 16), vc = __uint_as_float(cur.v[j + 1] << 16);
                const float rp = __uint_as_float(cur.r[j] << 16), kp = __uint_as_float(cur.k[j] << 16), vp = __uint_as_float(cur.v[j] << 16);
                const float r = rc + (rp - rc) * mu_r, k = kc + (kp - kc) * mu_k, v = vc + (vp - vc) * mu_v;
                const float lw = __uint_as_float(cur.lw[j] << 16), ic = __uint_as_float(cur.ic[j] << 16);
                float kk = k * kk_c; const float n2 = wave_sum_dpp(kk * kk); kk = kk * rsqrtf(fmaxf(n2, 1e-24f));
                const float k2 = k * (1.0f + (ic - 1.0f) * ka_c);
                LA[s * 64 + lane] = -kk; LW[s * 64 + lane] = __expf(lw); LB[s * 64 + lane] = kk * ic; LK[s * 64 + lane] = k2; LV[s * 64 + lane] = v;
                if (MODE == 2) { LR[s * 64 + lane] = r; const float bon = wave_sum_dpp(r * k2 * rk_c); if (lane == 0) LBon[s] = bon; }
                if (PASS == 0) { LR[s * 64 + lane] = r; const float bon = wave_sum_dpp(r * k2 * rk_c); if (lane == 0) X.BON[(size_t)(mb + s) * 8 + h] = bon; }
            }
            if (sub < 15) load_raw4(X, mb + 8 + s0, true, hc, cur);
            if (MODE == 2) {
#pragma unroll
                for (int j = 0; j < 4; ++j) gq[j] = X.GG[(size_t)(mb + s0 + j) * 512 + hc];
            }
        }
        LBAR();
        if (active) {
#pragma unroll 2
            for (int s = 0; s < 8; ++s) {
                f32x2 a2[8], w2[8], b2[8], k2[8], r2[8]; float vv[R];
#pragma unroll
                for (int q = 0; q < 4; ++q) {
                    const f32x4 ta = *(const LAS f32x4*)(LA + s * 64 + ks * 16 + 4 * q), tw = *(const LAS f32x4*)(LW + s * 64 + ks * 16 + 4 * q), tb = *(const LAS f32x4*)(LB + s * 64 + ks * 16 + 4 * q);
                    a2[2 * q] = (f32x2){ta[0], ta[1]}; a2[2 * q + 1] = (f32x2){ta[2], ta[3]}; w2[2 * q] = (f32x2){tw[0], tw[1]}; w2[2 * q + 1] = (f32x2){tw[2], tw[3]}; b2[2 * q] = (f32x2){tb[0], tb[1]}; b2[2 * q + 1] = (f32x2){tb[2], tb[3]};
                }
                if (MODE >= 1) {
#pragma unroll
                    for (int q = 0; q < 4; ++q) { const f32x4 tk = *(const LAS f32x4*)(LK + s * 64 + ks * 16 + 4 * q); k2[2 * q] = (f32x2){tk[0], tk[1]}; k2[2 * q + 1] = (f32x2){tk[2], tk[3]}; }
                    if (R == 4) { const f32x4 t = *(const LAS f32x4*)(LV + s * 64 + row0); vv[0] = t[0]; vv[1] = t[1]; vv[R - 2] = t[2]; vv[R - 1] = t[3]; }
                    else { const f32x2 t = *(const LAS f32x2*)(LV + s * 64 + row0); vv[0] = t[0]; vv[1] = t[1]; }
                }
                if (MODE == 2 || PASS == 0) {
#pragma unroll
                    for (int q = 0; q < 4; ++q) { const f32x4 tr = *(const LAS f32x4*)(LR + s * 64 + ks * 16 + 4 * q); r2[2 * q] = (f32x2){tr[0], tr[1]}; r2[2 * q + 1] = (f32x2){tr[2], tr[3]}; }
                }
                float sa[R];
#pragma unroll
                for (int i = 0; i < R; ++i) {
                    f32x2 p0 = S[i][0] * a2[0], p1 = S[i][1] * a2[1];
#pragma unroll
                    for (int j = 2; j < 8; j += 2) { p0 = S[i][j] * a2[j] + p0; p1 = S[i][j + 1] * a2[j + 1] + p1; }
                    p0 = p0 + p1; sa[i] = quad_sum(p0.x + p0.y);
                }
#pragma unroll
                for (int i = 0; i < R; ++i) {
                    const f32x2 sa2 = (f32x2){sa[i], sa[i]};
#pragma unroll
                    for (int j = 0; j < 8; ++j) {
                        f32x2 t = sa2 * b2[j] + S[i][j] * w2[j];
                        if (MODE >= 1) { const f32x2 v2 = (f32x2){vv[i], vv[i]}; t = v2 * k2[j] + t; }
                        S[i][j] = t;
                    }
                }
                if (MODE == 2) {
                    f32x2 y;
#pragma unroll
                    for (int i = 0; i < R; ++i) {
                        f32x2 p0 = S[i][0] * r2[0], p1 = S[i][1] * r2[1];
#pragma unroll
                        for (int j = 2; j < 8; j += 2) { p0 = S[i][j] * r2[j] + p0; p1 = S[i][j + 1] * r2[j + 1] + p1; }
                        p0 = p0 + p1; y[i & 1] = quad_sum(p0.x + p0.y);
                    }
                    if (ks == 0) *(LAS f32x2*)(LY + s * 64 + row0) = y;
                }
                if (PASS == 0) {
                    f32x4 y;
#pragma unroll
                    for (int i = 0; i < R; ++i) {
                        f32x2 p0 = S[i][0] * r2[0], p1 = S[i][1] * r2[1];
#pragma unroll
                        for (int j = 2; j < 8; j += 2) { p0 = S[i][j] * r2[j] + p0; p1 = S[i][j + 1] * r2[j + 1] + p1; }
                        p0 = p0 + p1; y[i & 3] = quad_sum(p0.x + p0.y);
                    }
                    if (ks == 0) *(LAS f32x4*)(LY + role * 512 + s * 64 + row0) = y;
                }
            }
        }
        if (PASS == 0 && active) {
            asm volatile("s_waitcnt lgkmcnt(0)" ::: "memory"); __builtin_amdgcn_wave_barrier();
            GAS bf16* dst = (MODE == 0) ? ((b == 0 ? X.Q0 : X.Q1) + (size_t)((mb & (T - 1))) * 512 + hc) : (X.ZB + (size_t)mb * 512 + hc);
#pragma unroll
            for (int s = 0; s < 8; ++s) dst[(size_t)s * 512] = (bf16)f2bf(LY[role * 512 + s * 64 + lane]);
        }
        if (MODE == 2) LBAR();
        if (MODE == 2) {
            if (active) {
#pragma unroll
                for (int j = 0; j < 4; ++j) {
                    const int s = s0 + j, m = mb + s;
                    const float y = LY[s * 64 + lane];
                    const float mean = wave_sum_dpp(y) * (1.0f / 64.0f); const float d = y - mean; const float var = wave_sum_dpp(d * d) * (1.0f / 64.0f);
                    float yn = d * rsqrtf(var + 64e-5f) * lnw + lnb;
                    yn += LBon[s] * LV[s * 64 + lane];
                    const float g = __uint_as_float(gq[j] << 16);
                    X.ZB[(size_t)m * 512 + hc] = (bf16)f2bf(yn * g);
                }
            }
        }
    }
    if (MODE <= 1 && active) {
        GAS float* dst = (MODE == 0 ? X.PC : X.NS) + (size_t)cid * 4096;
#pragma unroll
        for (int i = 0; i < R; ++i)
#pragma unroll
            for (int q = 0; q < 4; ++q) *(GAS f32x4*)(dst + (row0 + i) * 64 + ks * 16 + q * 4) = (f32x4){S[i][2 * q].x, S[i][2 * q].y, S[i][2 * q + 1].x, S[i][2 * q + 1].y};
    }
}
#define MF4(a, b, c) __builtin_amdgcn_mfma_f32_16x16x4f32((a), (b), (c), 0, 0, 0)
struct RawB { unsigned r[9], k[9], v[9], ic[8], lw[16]; };
__device__ __forceinline__ void load_rawb(const ScanCtx& X, int mblk, int role, bool prev_valid, int hc, RawB& q) {
    const int ms = mblk + role * 8;
#pragma unroll
    for (int j = 0; j < 9; ++j) {
        const int m = (j == 0 && !prev_valid) ? ms : (ms - 1 + j);
        const GAS bf16* row = X.PB + (size_t)m * 1792;
        q.r[j] = row[hc]; q.k[j] = row[512 + hc]; q.v[j] = row[1024 + hc];
    }
    if (!prev_valid) { q.r[0] = 0u; q.k[0] = 0u; q.v[0] = 0u; }
#pragma unroll
    for (int j = 0; j < 8; ++j) q.ic[j] = X.ICLR[(size_t)(ms + j) * 512 + hc];
#pragma unroll
    for (int j = 0; j < 16; ++j) q.lw[j] = X.LOGW[(size_t)(mblk + j) * 512 + hc];
}
#ifndef DBG_STAGE
#define DBG_STAGE 3
#endif
template <int MODE>
__device__ __forceinline__ void scan_a_mfma(const ScanCtx& X, int cid, bool active, LAS float* pl, int lane) {
    asm volatile("" : "+v"(lane));
    constexpr int role = MODE;
    const int bh = cid >> 6, c = cid & 63, b = bh >> 3, h = bh & 7;
    const int m0 = b * T + c * 128;
    const int l16 = lane & 15, lq = lane >> 4, hc = h * 64 + lane;
    LAS float* AT = pl; LAS float* BT = pl + 1024; LAS float* KT = pl + 2048; LAS float* RT = pl + 3072; LAS float* VT = pl + 4096;
    LAS float* LI = pl + 5120; LAS float* GK = pl + 5376; LAS float* HB = pl + 5632; LAS float* HK = pl + 5888; LAS float* GAM = pl + 6144;
    f32x4 S[4][4];
#pragma unroll
    for (int mb = 0; mb < 4; ++mb)
#pragma unroll
        for (int nb = 0; nb < 4; ++nb)
#pragma unroll
            for (int rr = 0; rr < 4; ++rr) S[mb][nb][rr] = (MODE == 0 && (16 * mb + 4 * lq + rr) == (16 * nb + l16)) ? 1.f : 0.f;
    const float mu_r = X.mu[hc], mu_k = X.mu[512 + hc], mu_v = X.mu[1024 + hc];
    const float kk_c = X.k_k[hc], ka_c = X.k_a[hc], rk_c = X.r_k[hc];
    RawB cur;
    if (active) load_rawb(X, m0, role, !(c == 0 && role == 0), hc, cur);
    for (int blk = 0; blk < 8; ++blk) {
        const int mblk = m0 + blk * 16;
        if (active) {
            float cl[17]; cl[0] = 0.f;
#pragma unroll
            for (int t = 0; t < 16; ++t) cl[t + 1] = cl[t] + __uint_as_float(cur.lw[t] << 16);
#pragma unroll
            for (int j = 0; j < 8; ++j) {
                const int t = role * 8 + j;
                const float rc = __uint_as_float(cur.r[j + 1] << 16), kc = __uint_as_float(cur.k[j + 1] << 16), vc = __uint_as_float(cur.v[j + 1] << 16);
                const float rp = __uint_as_float(cur.r[j] << 16), kp = __uint_as_float(cur.k[j] << 16), vp = __uint_as_float(cur.v[j] << 16);
                const float rr_ = rc + (rp - rc) * mu_r, k = kc + (kp - kc) * mu_k, v = vc + (vp - vc) * mu_v;
                const float ic = __uint_as_float(cur.ic[j] << 16);
                float kk = k * kk_c; const float n2 = wave_sum_dpp(kk * kk); kk = kk * rsqrtf(fmaxf(n2, 1e-24f));
                const float k2 = k * (1.0f + (ic - 1.0f) * ka_c);
                const float e_prev = __expf(cl[t]), e_cur = __expf(cl[t + 1]), i_cur = __expf(-cl[t + 1]);
                AT[t * 64 + lane] = -kk * e_prev; BT[t * 64 + lane] = kk * ic * i_cur; KT[t * 64 + lane] = k2 * i_cur; RT[t * 64 + lane] = rr_ * e_cur; VT[t * 64 + lane] = v;
                const float bon = wave_sum_dpp(rr_ * k2 * rk_c); if (lane == 0) X.BON[(size_t)(mblk + t) * 8 + h] = bon;
                asm volatile("" ::: "memory");
            }
            if (MODE == 0) GAM[lane] = __expf(cl[16]);
            if (blk < 7) load_rawb(X, mblk + 16, role, true, hc, cur);
        }
        LBAR();
        if (active && DBG_STAGE >= 2) {
            f32x4 a4[4], b4[4];
            if (MODE == 0) {
                f32x4 g = (f32x4){0.f, 0.f, 0.f, 0.f};
#pragma unroll
                for (int q = 0; q < 4; ++q) { a4[q] = *(const LAS f32x4*)(AT + l16 * 64 + 16 * lq + 4 * q); b4[q] = *(const LAS f32x4*)(BT + l16 * 64 + 16 * lq + 4 * q); }
#pragma unroll
                for (int kk = 0; kk < 16; ++kk) g = MF4(a4[kk >> 2][kk & 3], b4[kk >> 2][kk & 3], g);
#pragma unroll
                for (int rr = 0; rr < 4; ++rr) LI[(4 * lq + rr) * 16 + l16] = (l16 < 4 * lq + rr) ? g[rr] : 0.f;
#define WSYNC() do { asm volatile("s_waitcnt lgkmcnt(0)" ::: "memory"); __builtin_amdgcn_wave_barrier(); } while (0)
#define MM16(Am, Bm, cacc) do { const f32x4 a_ = *(const LAS f32x4*)((Am) + l16 * 16 + 4 * lq); _Pragma("unroll") for (int r_ = 0; r_ < 4; ++r_) cacc = MF4(a_[r_], (Bm)[(4 * lq + r_) * 16 + l16], cacc); } while (0)
#define ST16(Dm, cacc) do { _Pragma("unroll") for (int r_ = 0; r_ < 4; ++r_) (Dm)[(4 * lq + r_) * 16 + l16] = cacc[r_]; } while (0)
                LAS float* M2 = pl + 6208; LAS float* M4 = pl + 6464; LAS float* M8 = pl + 6720; LAS float* TT = pl + 6976;
                const f32x4 z4 = (f32x4){0.f, 0.f, 0.f, 0.f};
                WSYNC();
                f32x4 c2 = z4; MM16(LI, LI, c2); ST16(M2, c2);
                f32x4 t1;
#pragma unroll
                for (int rr = 0; rr < 4; ++rr) t1[rr] = LI[(4 * lq + rr) * 16 + l16] + ((4 * lq + rr) == l16 ? 1.f : 0.f);
                ST16(TT, t1);
                WSYNC();
                f32x4 c4 = z4; MM16(M2, M2, c4); ST16(M4, c4);
                f32x4 t2 = t1; MM16(TT, M2, t2);
                WSYNC();
                ST16(TT, t2);
                WSYNC();
                f32x4 c8 = z4; MM16(M4, M4, c8); ST16(M8, c8);
                f32x4 t4 = t2; MM16(TT, M4, t4);
                WSYNC();
                ST16(TT, t4);
                WSYNC();
                f32x4 t8 = t4; MM16(TT, M8, t8);
                WSYNC();
                ST16(LI, t8);
            } else {
                f32x4 r4[4], k4[4];
#pragma unroll
                for (int q = 0; q < 4; ++q) { a4[q] = *(const LAS f32x4*)(AT + l16 * 64 + 16 * lq + 4 * q); b4[q] = *(const LAS f32x4*)(BT + l16 * 64 + 16 * lq + 4 * q);
                                              r4[q] = *(const LAS f32x4*)(RT + l16 * 64 + 16 * lq + 4 * q); k4[q] = *(const LAS f32x4*)(KT + l16 * 64 + 16 * lq + 4 * q); }
                f32x4 gk = (f32x4){0.f, 0.f, 0.f, 0.f}, hb = gk, hk = gk;
#pragma unroll
                for (int kk = 0; kk < 16; ++kk) { gk = MF4(a4[kk >> 2][kk & 3], k4[kk >> 2][kk & 3], gk); hb = MF4(r4[kk >> 2][kk & 3], b4[kk >> 2][kk & 3], hb); hk = MF4(r4[kk >> 2][kk & 3], k4[kk >> 2][kk & 3], hk); }
#pragma unroll
                for (int rr = 0; rr < 4; ++rr) { const int t = 4 * lq + rr; GK[t * 16 + l16] = (l16 < t) ? gk[rr] : 0.f; HB[t * 16 + l16] = (l16 <= t) ? hb[rr] : 0.f; HK[t * 16 + l16] = (l16 <= t) ? hk[rr] : 0.f; }
            }
        }
        LBAR();
        if (active && DBG_STAGE >= 3) {
            f32x4 Wt[4], Ut[4], Yt[4];
#pragma unroll
            for (int nb = 0; nb < 4; ++nb) { Wt[nb] = (f32x4){0.f, 0.f, 0.f, 0.f}; Ut[nb] = Wt[nb]; Yt[nb] = Wt[nb]; }
#pragma unroll
            for (int mb = 0; mb < 4; ++mb) {
                const f32x4 at = *(const LAS f32x4*)(AT + l16 * 64 + 16 * mb + 4 * lq);
#pragma unroll
                for (int rr = 0; rr < 4; ++rr)
#pragma unroll
                    for (int nb = 0; nb < 4; ++nb) Wt[nb] = MF4(at[rr], S[mb][nb][rr], Wt[nb]);
            }
            if (MODE == 1) {
                const f32x4 gk = *(const LAS f32x4*)(GK + l16 * 16 + 4 * lq);
#pragma unroll
                for (int nb = 0; nb < 4; ++nb) {
#pragma unroll
                    for (int rr = 0; rr < 4; ++rr) Wt[nb] = MF4(gk[rr], VT[(4 * lq + rr) * 64 + 16 * nb + l16], Wt[nb]);
                }
            }
            { const f32x4 li = *(const LAS f32x4*)(LI + l16 * 16 + 4 * lq);
#pragma unroll
              for (int rr = 0; rr < 4; ++rr)
#pragma unroll
                  for (int nb = 0; nb < 4; ++nb) Ut[nb] = MF4(li[rr], Wt[nb][rr], Ut[nb]); }
#pragma unroll
            for (int mb = 0; mb < 4; ++mb) {
                const f32x4 rt = *(const LAS f32x4*)(RT + l16 * 64 + 16 * mb + 4 * lq);
#pragma unroll
                for (int rr = 0; rr < 4; ++rr)
#pragma unroll
                    for (int nb = 0; nb < 4; ++nb) Yt[nb] = MF4(rt[rr], S[mb][nb][rr], Yt[nb]);
            }
            { const f32x4 hb = *(const LAS f32x4*)(HB + l16 * 16 + 4 * lq);
#pragma unroll
              for (int rr = 0; rr < 4; ++rr)
#pragma unroll
                  for (int nb = 0; nb < 4; ++nb) Yt[nb] = MF4(hb[rr], Ut[nb][rr], Yt[nb]); }
            if (MODE == 1) {
                const f32x4 hk = *(const LAS f32x4*)(HK + l16 * 16 + 4 * lq);
#pragma unroll
                for (int nb = 0; nb < 4; ++nb) {
#pragma unroll
                    for (int rr = 0; rr < 4; ++rr) Yt[nb] = MF4(hk[rr], VT[(4 * lq + rr) * 64 + 16 * nb + l16], Yt[nb]);
                }
            }
            { GAS bf16* dst = (MODE == 0) ? ((b == 0 ? X.Q0 : X.Q1) + (size_t)(mblk & (T - 1)) * 512 + h * 64) : (X.ZB + (size_t)mblk * 512 + h * 64);
#pragma unroll
              for (int nb = 0; nb < 4; ++nb)
#pragma unroll
                  for (int rr = 0; rr < 4; ++rr) dst[(size_t)(4 * lq + rr) * 512 + 16 * nb + l16] = (bf16)f2bf(Yt[nb][rr]); }
#pragma unroll
            for (int mb = 0; mb < 4; ++mb) {
#pragma unroll
                for (int rr = 0; rr < 4; ++rr) {
                    const float ab = BT[(4 * lq + rr) * 64 + 16 * mb + l16];
#pragma unroll
                    for (int nb = 0; nb < 4; ++nb) S[mb][nb] = MF4(ab, Ut[nb][rr], S[mb][nb]);
                }
                if (MODE == 1) {
#pragma unroll
                    for (int rr = 0; rr < 4; ++rr) {
                        const float ak = KT[(4 * lq + rr) * 64 + 16 * mb + l16];
#pragma unroll
                        for (int nb = 0; nb < 4; ++nb) S[mb][nb] = MF4(ak, VT[(4 * lq + rr) * 64 + 16 * nb + l16], S[mb][nb]);
                    }
                }
                const f32x4 g = *(const LAS f32x4*)(GAM + 16 * mb + 4 * lq);
#pragma unroll
                for (int nb = 0; nb < 4; ++nb) { S[mb][nb] = S[mb][nb] * g;
#pragma unroll
                    for (int e_ = 0; e_ < 4; ++e_) S[mb][nb][e_] = (S[mb][nb][e_] != S[mb][nb][e_]) ? 0.f : S[mb][nb][e_]; }
            }
        }
        LBAR();
    }
    if (active) {
        GAS float* dst = (MODE == 0 ? X.PC : X.NS) + (size_t)cid * 4096;
#pragma unroll
        for (int mb = 0; mb < 4; ++mb)
#pragma unroll
            for (int nb = 0; nb < 4; ++nb) *(GAS f32x4*)(dst + (16 * nb + l16) * 64 + 16 * mb + 4 * lq) = S[mb][nb];
    }
}
__device__ __forceinline__ void scan_c2(const ScanCtx& X, int cid, int half, LAS float* wl, int lane) {
    asm volatile("" : "+v"(lane));
    const int bh = cid >> 6, c = cid & 63, b = bh >> 3, h = bh & 7;
    const int m0 = b * T + c * 128 + half * 64;
    const int l16 = lane & 15, lq = lane >> 4, hc = h * 64 + lane;
    const GAS bf16* Qb = (b == 0 ? X.Q0 : X.Q1) + (size_t)(c * 128 + half * 64) * 512 + h * 64;
    float Bv[4][16];
#pragma unroll
    for (int vb = 0; vb < 4; ++vb)
#pragma unroll
        for (int j = 0; j < 16; ++j) Bv[vb][j] = 0.f;
    if (c > 0) {
        const GAS float* Sc = X.NS + (size_t)(cid - 1) * 4096;
#pragma unroll
        for (int vb = 0; vb < 4; ++vb)
#pragma unroll
            for (int j = 0; j < 4; ++j) { const f32x4 t = *(const GAS f32x4*)(Sc + (vb * 16 + l16) * 64 + 16 * lq + 4 * j); Bv[vb][4 * j] = t[0]; Bv[vb][4 * j + 1] = t[1]; Bv[vb][4 * j + 2] = t[2]; Bv[vb][4 * j + 3] = t[3]; }
    }
    const float mu_v = X.mu[1024 + hc], lnw = X.lnw[hc], lnb = X.lnb[hc];
    unsigned short y0r[16]; v4u qa, qb; unsigned vraw[17], graw[16]; float bon[16];
#define C2_LOAD(tbn) do { const int mt_ = m0 + (tbn) * 16; \
        _Pragma("unroll") for (int vb = 0; vb < 4; ++vb) _Pragma("unroll") for (int rr = 0; rr < 4; ++rr) y0r[vb * 4 + rr] = X.ZB[(size_t)(mt_ + 4 * lq + rr) * 512 + h * 64 + vb * 16 + l16]; \
        { const GAS bf16* qrow = Qb + (size_t)((tbn) * 16 + l16) * 512 + 16 * lq; qa = *(const GAS v4u*)qrow; qb = *(const GAS v4u*)(qrow + 8); } \
        { const int mp = (mt_ & (T - 1)) ? mt_ - 1 : mt_; vraw[0] = X.PB[(size_t)mp * 1792 + 1024 + hc]; if (!(mt_ & (T - 1))) vraw[0] = 0u; } \
        _Pragma("unroll") for (int tt = 0; tt < 16; ++tt) { vraw[tt + 1] = X.PB[(size_t)(mt_ + tt) * 1792 + 1024 + hc]; graw[tt] = X.GG[(size_t)(mt_ + tt) * 512 + hc]; bon[tt] = X.BON[(size_t)(mt_ + tt) * 8 + h]; } } while (0)
    C2_LOAD(0);
    for (int tb = 0; tb < 4; ++tb) {
        const int mt = m0 + tb * 16;
        f32x4 acc[4];
#pragma unroll
        for (int vb = 0; vb < 4; ++vb)
#pragma unroll
            for (int rr = 0; rr < 4; ++rr) acc[vb][rr] = __uint_as_float((unsigned)y0r[vb * 4 + rr] << 16);
        if (c > 0) {
            float Av[16];
            Av[0] = __uint_as_float(qa.x << 16); Av[1] = __uint_as_float(qa.x & 0xffff0000u); Av[2] = __uint_as_float(qa.y << 16); Av[3] = __uint_as_float(qa.y & 0xffff0000u);
            Av[4] = __uint_as_float(qa.z << 16); Av[5] = __uint_as_float(qa.z & 0xffff0000u); Av[6] = __uint_as_float(qa.w << 16); Av[7] = __uint_as_float(qa.w & 0xffff0000u);
            Av[8] = __uint_as_float(qb.x << 16); Av[9] = __uint_as_float(qb.x & 0xffff0000u); Av[10] = __uint_as_float(qb.y << 16); Av[11] = __uint_as_float(qb.y & 0xffff0000u);
            Av[12] = __uint_as_float(qb.z << 16); Av[13] = __uint_as_float(qb.z & 0xffff0000u); Av[14] = __uint_as_float(qb.w << 16); Av[15] = __uint_as_float(qb.w & 0xffff0000u);
#pragma unroll
            for (int kk = 0; kk < 16; ++kk)
#pragma unroll
                for (int vb = 0; vb < 4; ++vb) acc[vb] = __builtin_amdgcn_mfma_f32_16x16x4f32(Av[kk], Bv[vb][kk], acc[vb], 0, 0, 0);
        }
        unsigned vr[17], gr[16]; float bn[16];
#pragma unroll
        for (int tt = 0; tt < 16; ++tt) { vr[tt] = vraw[tt]; gr[tt] = graw[tt]; bn[tt] = bon[tt]; }
        vr[16] = vraw[16];
        if (tb < 3) C2_LOAD(tb + 1);
#pragma unroll
        for (int vb = 0; vb < 4; ++vb)
#pragma unroll
            for (int rr = 0; rr < 4; ++rr) wl[(4 * lq + rr) * 64 + vb * 16 + l16] = acc[vb][rr];
        asm volatile("s_waitcnt lgkmcnt(0)" ::: "memory"); __builtin_amdgcn_wave_barrier();
#pragma unroll
        for (int tt = 0; tt < 16; ++tt) {
            const float y = wl[tt * 64 + lane];
            const float mean = wave_sum_dpp(y) * (1.0f / 64.0f), ex2 = wave_sum_dpp(y * y) * (1.0f / 64.0f); const float d = y - mean; const float var = fmaxf(ex2 - mean * mean, 0.f);
            float yn = d * rsqrtf(var + 64e-5f) * lnw + lnb;
            const float vc = __uint_as_float(vr[tt + 1] << 16), vp = __uint_as_float(vr[tt] << 16);
            yn += bn[tt] * (vc + (vp - vc) * mu_v);
            X.ZB[(size_t)(mt + tt) * 512 + hc] = (bf16)f2bf(yn * __uint_as_float(gr[tt] << 16));
        }
        asm volatile("s_waitcnt lgkmcnt(0)" ::: "memory"); __builtin_amdgcn_wave_barrier();
    }
#undef C2_LOAD
}
struct PbBuf { float p[16]; float n[4]; };
__device__ __forceinline__ void pb_load(const ScanCtx& X, int bh, int c, int qr, int cb, int l16, int lq, PbBuf& q) {
    const GAS float* P = X.PC + (size_t)(bh * 64 + c) * 4096 + (16 * lq) * 64 + cb * 16 + l16; const GAS float* N = X.NS + (size_t)(bh * 64 + c) * 4096 + (16 * qr + 4 * lq) * 64 + cb * 16 + l16;
#pragma unroll
    for (int kk = 0; kk < 16; ++kk) q.p[kk] = P[kk * 64];
#pragma unroll
    for (int r = 0; r < 4; ++r) q.n[r] = N[r * 64];
}
__device__ __forceinline__ void pb_step(const ScanCtx& X, LAS float* Sr, LAS float* Sw, int bh, int c, int qr, int cb, int l16, int lq, const PbBuf& q, bool worker) {
    if (worker) {
        f32x4 acc = (f32x4){q.n[0], q.n[1], q.n[2], q.n[3]};
        f32x4 av[4];
#pragma unroll
        for (int j = 0; j < 4; ++j) av[j] = *(const LAS f32x4*)(Sr + l16 * 68 + 16 * lq + 4 * j);
        f32x4 acc1 = (f32x4){0.f, 0.f, 0.f, 0.f};
#pragma unroll
        for (int kk = 0; kk < 16; kk += 2) { acc = __builtin_amdgcn_mfma_f32_16x16x4f32(av[kk >> 2][kk & 3], q.p[kk], acc, 0, 0, 0); acc1 = __builtin_amdgcn_mfma_f32_16x16x4f32(av[(kk + 1) >> 2][(kk + 1) & 3], q.p[kk + 1], acc1, 0, 0, 0); }
        acc = acc + acc1;
        GAS float* N = X.NS + (size_t)(bh * 64 + c) * 4096 + (16 * qr + 4 * lq) * 64 + cb * 16 + l16;
#pragma unroll
        for (int r = 0; r < 4; ++r) { Sw[(4 * lq + r) * 68 + cb * 16 + l16] = acc[r]; N[r * 64] = acc[r]; }
    }
    asm volatile("s_waitcnt lgkmcnt(0)" ::: "memory"); __builtin_amdgcn_s_barrier(); asm volatile("" ::: "memory");
}
__device__ __forceinline__ void scan_pass_b(const ScanCtx& X, LAS unsigned char* lds, int wb, int tid, int lane, int wave) {
    asm volatile("" : "+v"(lane), "+v"(tid));
    LAS float* S0 = (LAS float*)lds; LAS float* S1 = S0 + 16 * 68;
    for (int i = tid; i < 16 * 68; i += 512) S0[i] = 0.f;
    __syncthreads();
    const int bh = wb >> 2, qr = wb & 3, cb = wave & 3, l16 = lane & 15, lq = lane >> 4; const bool wk = wave < 4;
    PbBuf q0, q1, q2, q3, q4, q5;
    if (wk) { pb_load(X, bh, 0, qr, cb, l16, lq, q0); pb_load(X, bh, 1, qr, cb, l16, lq, q1); pb_load(X, bh, 2, qr, cb, l16, lq, q2);
              pb_load(X, bh, 3, qr, cb, l16, lq, q3); pb_load(X, bh, 4, qr, cb, l16, lq, q4); pb_load(X, bh, 5, qr, cb, l16, lq, q5); }
    for (int c = 0; c < 60; c += 6) {
        pb_step(X, S0, S1, bh, c, qr, cb, l16, lq, q0, wk);     if (wk && c + 6 < 63) pb_load(X, bh, c + 6, qr, cb, l16, lq, q0);
        pb_step(X, S1, S0, bh, c + 1, qr, cb, l16, lq, q1, wk); if (wk && c + 7 < 63) pb_load(X, bh, c + 7, qr, cb, l16, lq, q1);
        pb_step(X, S0, S1, bh, c + 2, qr, cb, l16, lq, q2, wk); if (wk && c + 8 < 63) pb_load(X, bh, c + 8, qr, cb, l16, lq, q2);
        pb_step(X, S1, S0, bh, c + 3, qr, cb, l16, lq, q3, wk); if (wk && c + 9 < 63) pb_load(X, bh, c + 9, qr, cb, l16, lq, q3);
        pb_step(X, S0, S1, bh, c + 4, qr, cb, l16, lq, q4, wk); if (wk && c + 10 < 63) pb_load(X, bh, c + 10, qr, cb, l16, lq, q4);
        pb_step(X, S1, S0, bh, c + 5, qr, cb, l16, lq, q5, wk); if (wk && c + 11 < 63) pb_load(X, bh, c + 11, qr, cb, l16, lq, q5);
    }
    pb_step(X, S0, S1, bh, 60, qr, cb, l16, lq, q0, wk); pb_step(X, S1, S0, bh, 61, qr, cb, l16, lq, q1, wk); pb_step(X, S0, S1, bh, 62, qr, cb, l16, lq, q2, wk);
}

__device__ __forceinline__ void phase_final(tab_t tab, int lane, int wave) {
    asm volatile("" : "+v"(lane));
    GAS float* out = OUTP(); const GAS float* g = INP(26);
    const int gw = blockIdx.x * NWAVES + wave, NGW = gridDim.x * NWAVES;
    f32x4 gv[4];
#pragma unroll
    for (int j = 0; j < 4; ++j) gv[j] = ((const GAS f32x4*)g)[lane + 64 * j];
    for (int m = gw; m < M; m += 4 * NGW) {
        f32x4 v[4][4]; float s[4];
#pragma unroll
        for (int q = 0; q < 4; ++q) { const int mq = m + q * NGW; const GAS f32x4* xr = (const GAS f32x4*)(out + (size_t)(mq < M ? mq : m) * D) + lane;
#pragma unroll
            for (int j = 0; j < 4; ++j) v[q][j] = xr[64 * j]; }
#pragma unroll
        for (int q = 0; q < 4; ++q) { float t = 0.f;
#pragma unroll
            for (int j = 0; j < 4; ++j) t += (v[q][j][0] * v[q][j][0] + v[q][j][1] * v[q][j][1]) + (v[q][j][2] * v[q][j][2] + v[q][j][3] * v[q][j][3]);
            s[q] = rsqrtf(wave_sum_dpp(t) * (1.0f / D) + 1e-6f); }
#pragma unroll
        for (int q = 0; q < 4; ++q) { const int mq = m + q * NGW; if (mq < M) { GAS f32x4* xw = (GAS f32x4*)(out + (size_t)mq * D) + lane;
#pragma unroll
            for (int j = 0; j < 4; ++j) xw[64 * j] = v[q][j] * s[q] * gv[j]; } }
    }
}

#define RLX_AGENT __ATOMIC_RELAXED, __HIP_MEMORY_SCOPE_AGENT
#define XB_TMO      128
#define XB_XCNT(j)  (256  + 64 * (j))
#define XB_XSUB(j)  (1280 + 64 * (j))
#define XB_XGEN(j)  (2304 + 64 * (j))
#define XB_TOP      3328
#define XB_TOPGEN   3392
#define XCD_BAR_WORDS 3456
#define XB_SPIN_CAP (1u << 18)

__device__ __forceinline__ unsigned xb_ld(unsigned* p)              { return __hip_atomic_load(p, __ATOMIC_RELAXED, __HIP_MEMORY_SCOPE_AGENT); }
__device__ __forceinline__ unsigned xb_add(unsigned* p, unsigned v) { return __hip_atomic_fetch_add(p, v, __ATOMIC_RELAXED, __HIP_MEMORY_SCOPE_AGENT); }
__device__ __forceinline__ unsigned xb_xcc_id() { return (unsigned)__builtin_amdgcn_s_getreg((3 << 11) | 20) & 0xFu; }
#define XB_SPIN(cond, bar) do { unsigned _sp = 0; while (cond) { __builtin_amdgcn_s_sleep(1); \
    if ((++_sp & 255u) == 0u) { if (xb_ld(&(bar)[XB_TMO])) break; if (_sp > XB_SPIN_CAP) { atomicAdd(&(bar)[XB_TMO], 1u); break; } } } } while (0)

struct XcdBarrier {
    unsigned* bar; unsigned x;
    volatile LAS unsigned* st;
};

__device__ __forceinline__ XcdBarrier xcd_barrier_post(unsigned* bar, volatile LAS unsigned* st) {
    XcdBarrier b; b.bar = bar; b.x = xb_xcc_id(); b.st = st;
    if (threadIdx.x == 0) (void)xb_add(&bar[XB_XCNT(b.x)], 1u);
    return b;
}
__device__ __forceinline__ void xcd_barrier_complete(unsigned* bar, unsigned x, unsigned& nloc, unsigned& nx) {
    const unsigned G = gridDim.x * gridDim.y * gridDim.z;
    unsigned sum, cnt, mine, sp = 0u;
    for (;;) {
        sum = 0u; cnt = 0u; mine = 0u;
#pragma unroll
        for (unsigned j = 0; j < 16; ++j) { const unsigned c = xb_ld(&bar[XB_XCNT(j)]); sum += c; cnt += (c > 0u) ? 1u : 0u; mine = (j == x) ? c : mine; }
        if (sum == G) break;
        __builtin_amdgcn_s_sleep(1);
        if ((++sp & 255u) == 0u) { if (xb_ld(&bar[XB_TMO])) break; if (sp > XB_SPIN_CAP) { atomicAdd(&bar[XB_TMO], 1u); break; } }
    }
    nloc = mine > 0u ? mine : 1u; nx = cnt > 0u ? cnt : 1u;
}

__device__ __forceinline__ void xcd_barrier(const XcdBarrier& b) {
    asm volatile("s_waitcnt vmcnt(0)" ::: "memory");
    __syncthreads();
    if (threadIdx.x == 0) {
        unsigned* bar = b.bar;
        __builtin_amdgcn_s_waitcnt(0);
        unsigned nloc = b.st[0], nx = b.st[1];
        if (nloc == 0u) { xcd_barrier_complete(bar, b.x, nloc, nx); b.st[0] = nloc; b.st[1] = nx; }
        const unsigned old = xb_add(&bar[XB_XSUB(b.x)], 1u);
        const unsigned gen = old / nloc;
        if (old + 1u == (gen + 1u) * nloc) {
            __builtin_amdgcn_fence(__ATOMIC_RELEASE, "agent");
            asm volatile("s_waitcnt vmcnt(0)" ::: "memory");
            const unsigned og = xb_add(&bar[XB_TOP], 1u);
            const unsigned tg = og / nx;
            if (og + 1u == (tg + 1u) * nx) xb_add(&bar[XB_TOPGEN], 1u);
            else XB_SPIN(xb_ld(&bar[XB_TOPGEN]) == tg, bar);
            __builtin_amdgcn_fence(__ATOMIC_ACQUIRE, "agent");
            xb_add(&bar[XB_XGEN(b.x)], 1u);
            asm volatile("s_waitcnt vmcnt(0)" ::: "memory");
        } else {
            XB_SPIN(xb_ld(&bar[XB_XGEN(b.x)]) == gen, bar);
            __builtin_amdgcn_fence(__ATOMIC_ACQUIRE, "agent");
            asm volatile("s_waitcnt vmcnt(0)" ::: "memory");
        }
    }
    __syncthreads();
}

__device__ __forceinline__ ScanCtx make_scan_ctx(tab_t tab) {
    GAS unsigned char* ws = WSP();
    ScanCtx X; X.PB = (const GAS bf16*)(ws + WS_PB); X.LOGW = (const GAS bf16*)(ws + WS_LOGW); X.ICLR = (const GAS bf16*)(ws + WS_ICLR); X.GG = (const GAS bf16*)(ws + WS_GG); X.ZB = (GAS bf16*)(ws + WS_ZB);
    X.PC = (GAS float*)(ws + WS_PC); X.NS = (GAS float*)(ws + WS_NS); X.Q0 = (GAS bf16*)(ws + WS_Q0); X.Q1 = (GAS bf16*)(ws + WS_Q1); X.BON = (GAS float*)(ws + WS_BON); X.mu = INP(9); X.k_k = INP(15); X.k_a = INP(16); X.r_k = INP(17); X.lnw = INP(18); X.lnb = INP(19);
    return X;
}
__global__ void __launch_bounds__(NWAVES * 64, 2) fwd(Args a) {
    extern __shared__ __attribute__((aligned(16))) unsigned char lds_raw[];
    LAS unsigned char* lds = (LAS unsigned char*)lds_raw;
    const int tid = threadIdx.x, lane = tid & 63, wave = __builtin_amdgcn_readfirstlane(tid >> 6);
    const int G = gridDim.x;
    { LAS unsigned long long* tw = (LAS unsigned long long*)(lds + TAB_OFF);
      if (tid == 0) {
#pragma unroll
          for (int i = 0; i < 27; ++i) tw[i] = (unsigned long long)a.in[i];
          tw[27] = (unsigned long long)a.out; tw[28] = (unsigned long long)a.ws; }
      if (tid < 2) ((LAS unsigned*)(lds + MISC_OFF))[tid] = 0u;
      __syncthreads(); }
    (void)xcd_barrier_post((unsigned*)a.ws + CW_BAR, (volatile LAS unsigned*)(lds + MISC_OFF));
    const tab_t tab = (tab_t)(lds + TAB_OFF);
    const int ph_lo = a.ph_lo, ph_hi = a.ph_hi;

    unsigned long long tp0 = 0, tp1 = 0;
    for (int p = ph_lo; p < ph_hi; ++p) {
      if (PROBE_TIMEPH >= 0 && p == PROBE_TIMEPH) tp0 = __builtin_amdgcn_s_memrealtime();
      if (PROBE_TIMEPH >= 0 && p == PROBE_TIMEPH + 1) tp1 = __builtin_amdgcn_s_memrealtime();
      for (int rep = 0; rep <= ((PROBE_REPMASK >> p) & 1); ++rep) {
        pg8::Gemm g{nullptr, nullptr, M, 0, 0}; bool isg = false;
        switch (p) {
        case 0: phase_prologue(tab, lds, tid, lane, wave); break;
        case 4: phase_prep(tab, tid); break;
        case 6: { const ScanCtx X = make_scan_ctx(tab); const int pi = wave & 3, role = wave >> 2; LAS float* pl = (LAS float*)lds + pi * SCAN_WAVE_FLOATS;
                  for (int base = 0; base < 1024; base += 4 * G) { const int cid = base + pi * G + (int)blockIdx.x; const bool act = cid < 1024;
                      if (role == 0) scan_a_mfma<0>(X, act ? cid : 0, act, pl, lane); else scan_a_mfma<1>(X, act ? cid : 0, act, pl, lane); } } break;
        case 7: if (blockIdx.x < 64) { const ScanCtx X = make_scan_ctx(tab); if (PROBE_TIMEPH == 107) tp0 = __builtin_amdgcn_s_memrealtime(); scan_pass_b(X, lds, (int)blockIdx.x, tid, lane, wave); if (PROBE_TIMEPH == 107) tp1 = __builtin_amdgcn_s_memrealtime(); }
                else weights_copy(tab, lds, lane, wave, ((int)blockIdx.x - 64) * NWAVES + wave, (G - 64) * NWAVES, WO6, WO_END);
                break;
        case 8: { const ScanCtx X = make_scan_ctx(tab); LAS float* wl = (LAS float*)lds + wave * 1024;
                  for (int task = wave * G + (int)blockIdx.x; task < 2048; task += NWAVES * G) scan_c2(X, task >> 1, task & 1, wl, lane); } break;
        case 15: phase_final(tab, lane, wave); break;
        default: {
            GAS unsigned char* ws = WSP(); isg = true;
            const size_t aoff = (p == 2 || p == 14) ? WS_HID : (p == 5) ? WS_LIN : (p == 10) ? WS_ZA : (p == 11) ? WS_ZB : (p == 12) ? WS_MRG : WS_XB;
            const size_t boff = (p == 1) ? WS_W1GU : (p == 2) ? WS_W1D : (p == 3) ? WS_WIN : (p == 5) ? WS_WL : (p == 9) ? (WS_WIN + (size_t)3328 * D * 2) : (p == 10) ? WS_WOA : (p == 11) ? WS_WOB : (p == 12) ? WS_WO : (p == 13) ? WS_W2GU : WS_W2D;
            const int N = (p == 1 || p == 13) ? 2 * FF : (p == 3) ? 3328 : (p == 5) ? 1536 : (p == 9) ? 2048 : D;
            const int K = (p == 2 || p == 14) ? FF : (p == 5) ? 256 : (p == 10 || p == 11) ? 512 : D;
            typedef const unsigned short* gen_cbf16p; g = pg8::Gemm{(gen_cbf16p)(ws + aoff), (gen_cbf16p)(ws + boff), M, N, K}; } break;
        }
        if (isg) { pg8::Epi E{p, tab}; pg8::StaticOrder S; if (p == 9) S.init(M, D, G, (int)blockIdx.x, 4); else S.init(M, g.N, G, (int)blockIdx.x);     pg8::gemm_phase<pg8::Epi, pg8::StaticOrder, true, true>(lds, g, S, E); }
        if (p == 1 && (int)blockIdx.x >= G / 2) weights_copy(tab, lds, lane, wave, ((int)blockIdx.x - G / 2) * NWAVES + wave, (G - G / 2) * NWAVES, WO3, WO4);
        if (p == 3 && (int)blockIdx.x >= G / 4) weights_copy(tab, lds, lane, wave, ((int)blockIdx.x - G / 4) * NWAVES + wave, (G - G / 4) * NWAVES, WO4, WO6);
      }
        if (p + 1 < ph_hi && p != 9 && p != 10) { for (int sr = 0; sr < PROBE_SYNCREP; ++sr) {
            if (ph_hi > NPH) { __syncthreads(); cg::this_grid().sync(); }
            else { XcdBarrier bar; bar.bar = (unsigned*)WSP() + CW_BAR; bar.x = xb_xcc_id(); bar.st = (volatile LAS unsigned*)(lds + MISC_OFF); xcd_barrier(bar); } } }
    }
    if (PROBE_TIMEPH >= 0 && blockIdx.x == 0) { const unsigned long long span = (tp1 - tp0) * 9ull, t2 = __builtin_amdgcn_s_memrealtime(); while (__builtin_amdgcn_s_memrealtime() - t2 < span) __builtin_amdgcn_s_sleep(8); }
}

extern "C" void kernel_launch(void* const* d_in, const int* in_sizes, int n_in, void* d_out, int out_size, void* d_ws, size_t ws_size, hipStream_t stream) {
    static int grid = 0;
    if (grid == 0) {
        if (n_in != 27 || in_sizes[0] != M * D || out_size != M * D || ws_size < WS_END) { fprintf(stderr, "kernel_launch: unexpected shapes (n_in %d, in0 %d, out %d, ws %zu)\n", n_in, n_in > 0 ? in_sizes[0] : -1, out_size, ws_size); grid = -1; return; }
        int dev = 0, cus = 0, per_cu = 0;
        if (hipGetDevice(&dev) != hipSuccess || hipDeviceGetAttribute(&cus, hipDeviceAttributeMultiprocessorCount, dev) != hipSuccess) { grid = -1; return; }
        if (hipFuncSetAttribute((const void*)fwd, hipFuncAttributeMaxDynamicSharedMemorySize, LDS_BYTES) != hipSuccess) { fprintf(stderr, "kernel_launch: hipFuncSetAttribute failed\n"); grid = -1; return; }
        if (hipOccupancyMaxActiveBlocksPerMultiprocessor(&per_cu, (const void*)fwd, NWAVES * 64, LDS_BYTES) != hipSuccess || per_cu < 1) { fprintf(stderr, "kernel_launch: occupancy query says %d blocks per CU: this kernel cannot be resident, nothing launched\n", per_cu); (void)hipGetLastError(); grid = -1; return; }
        grid = cus * 1;
    }
    if (grid < 0) return;
    if (hipMemsetAsync(d_ws, 0, CTL_ZERO_BYTES, stream) != hipSuccess) { fprintf(stderr, "kernel_launch: hipMemsetAsync failed\n"); return; }
    Args a{};
    for (int i = 0; i < 27; ++i) a.in[i] = (const float*)d_in[i];
    a.out = (float*)d_out; a.ws = (unsigned char*)d_ws;
#if MK_PER_PHASE
    for (int p = 0; p < NPH; ++p) { a.ph_lo = p; a.ph_hi = p + 1; hipLaunchKernelGGL(fwd, dim3(grid), dim3(NWAVES * 64), LDS_BYTES, stream, a); }
#else
    a.ph_lo = 0; a.ph_hi = NPH;
    void* args[] = {&a};
    hipError_t e = hipLaunchCooperativeKernel((const void*)fwd, dim3(grid), dim3(NWAVES * 64), args, LDS_BYTES, stream);
    if (e != hipSuccess) fprintf(stderr, "kernel_launch: cooperative launch failed: %s (grid %d)\n", hipGetErrorString(e), grid);
#endif
}
```
